# Optimizing an MI355X kernel written in HIP

```python
import jax, jax.numpy as jnp
from jax import lax
import numpy as np

D_MODEL = 1024
BATCH = 4
SEQ = 8192
DEPTH = 4

HEAD_DIM = 64
N_HEADS_A = 8
N_HEADS_B = 8
N_HEADS = N_HEADS_A + N_HEADS_B
ROPE_THETA = 10000.0
DILATED_PATTERNS = ((128, 1), (512, 4), (2048, 16))
QBLK = 64
GRID_W = 64
NA_ROWS = 8
NA_COLS = 16
POOL_WINDOWS = (2, 4, 8, 16)
N_POOL = len(POOL_WINDOWS)
POOL_CH = D_MODEL // N_POOL
N_EXPERTS = 16
N_EXPERT_GROUPS = 4
EXPERTS_PER_GROUP = N_EXPERTS // N_EXPERT_GROUPS
TOP_K = 2
D_EXPERT = D_MODEL
EBLK = 256
N_EVEN = (DEPTH + 1) // 2
N_ODD = DEPTH // 2
DEEPNORM_ALPHA = (2.0 * DEPTH) ** 0.25
DEEPNORM_BETA = (8.0 * DEPTH) ** -0.25
LN_EPS = 1e-5
NEG_INF = -1e30

kernel_name = 'hybrid_dilated_neighbourhood_pool_moe_encoder'


def _layer_norm(x, g, b):
    xf = x.astype(jnp.float32)
    mu = jnp.mean(xf, axis=-1, keepdims=True)
    var = jnp.mean(jnp.square(xf - mu), axis=-1, keepdims=True)
    y = (xf - mu) * lax.rsqrt(var + LN_EPS) * g.astype(jnp.float32) + b.astype(jnp.float32)
    return y.astype(x.dtype)


def _rope_tables(seq):
    pos = jnp.arange(seq, dtype=jnp.float32)
    inv_freq = ROPE_THETA ** (-jnp.arange(0, HEAD_DIM, 2, dtype=jnp.float32) / HEAD_DIM)
    ang = pos[:, None] * inv_freq[None, :]
    return jnp.cos(ang), jnp.sin(ang)


def _rope(t, cos, sin):
    half = HEAD_DIM // 2
    c = cos[None, :, None, :].astype(t.dtype)
    s = sin[None, :, None, :].astype(t.dtype)
    t1, t2 = t[..., :half], t[..., half:]
    return jnp.concatenate([t1 * c - t2 * s, t2 * c + t1 * s], axis=-1)


def _band_attention(q, k, v, radius):
    n, length, h, hd = q.shape
    nb = -(-length // QBLK)
    lp = nb * QBLK
    kw = QBLK + 2 * radius
    qp = jnp.pad(q, ((0, 0), (0, lp - length), (0, 0), (0, 0)))
    kv_pad = ((0, 0), (radius, radius + lp - length), (0, 0), (0, 0))
    kp = jnp.pad(k, kv_pad)
    vp = jnp.pad(v, kv_pad)
    kidx = np.arange(nb)[:, None] * QBLK + np.arange(kw)[None, :]
    kpos = kidx - radius
    qpos = np.arange(lp).reshape(nb, QBLK)
    mask = ((np.abs(kpos[:, None, :] - qpos[:, :, None]) <= radius)
            & (kpos[:, None, :] >= 0) & (kpos[:, None, :] < length))
    kb = kp[:, kidx]
    vb = vp[:, kidx]
    s = jnp.einsum('nbqhd,nbkhd->nhbqk', qp.reshape(n, nb, QBLK, h, hd), kb).astype(jnp.float32)
    s = jnp.where(mask, s, NEG_INF)
    m = jnp.max(s, axis=-1, keepdims=True)
    p = jnp.exp(s - m)
    den = jnp.sum(p, axis=-1)
    o = jnp.einsum('nhbqk,nbkhd->nbqhd', p.astype(v.dtype), vb).astype(jnp.float32)
    o = o / jnp.moveaxis(den, 1, 3)[..., None]
    lse = jnp.moveaxis(m[..., 0] + jnp.log(den), 1, 3)
    o = o.reshape(n, lp, h, hd)[:, :length]
    lse = lse.reshape(n, lp, h)[:, :length]
    return o, lse


def _dilated_attention(q, k, v, window, dilation):
    b, s, h, hd = q.shape
    sub = s // dilation
    radius = window // (2 * dilation)

    def split(t):
        return t.reshape(b, sub, dilation, h, hd).transpose(0, 2, 1, 3, 4).reshape(b * dilation, sub, h, hd)

    o, lse = _band_attention(split(q), split(k), split(v), radius)
    o = o.reshape(b, dilation, sub, h, hd).transpose(0, 2, 1, 3, 4).reshape(b, s, h, hd)
    lse = lse.reshape(b, dilation, sub, h).transpose(0, 2, 1, 3).reshape(b, s, h)
    return o, lse


def _neighbourhood_attention(q, k, v, rpb):
    b, s, h, hd = q.shape
    rows = s // GRID_W
    wr = min(NA_ROWS, rows)
    r = np.arange(rows)
    ridx = np.clip(r - wr // 2, 0, rows - wr)[:, None] + np.arange(wr)[None, :]
    c = np.arange(GRID_W)
    cstart = np.clip(c - NA_COLS // 2, 0, GRID_W - NA_COLS)
    colmask = (c[None, :] >= cstart[:, None]) & (c[None, :] < cstart[:, None] + NA_COLS)
    mask = np.broadcast_to(colmask[:, None, :], (GRID_W, wr, GRID_W)).reshape(GRID_W, wr * GRID_W)
    roff = ridx - r[:, None] + (NA_ROWS - 1)
    coff = np.clip(c[None, :] - c[:, None], 1 - NA_COLS, NA_COLS - 1) + (NA_COLS - 1)
    bias = rpb[:, roff[:, None, :, None], coff[None, :, None, :]]
    bias = bias.reshape(h, rows, GRID_W, wr * GRID_W).astype(jnp.float32)
    qg = q.reshape(b, rows, GRID_W, h, hd)
    kg = k.reshape(b, rows, GRID_W, h, hd)[:, ridx].reshape(b, rows, wr * GRID_W, h, hd)
    vg = v.reshape(b, rows, GRID_W, h, hd)[:, ridx].reshape(b, rows, wr * GRID_W, h, hd)
    sc = jnp.einsum('brqhd,brkhd->bhrqk', qg, kg).astype(jnp.float32) + bias[None]
    sc = jnp.where(mask, sc, NEG_INF)
    p = jax.nn.softmax(sc, axis=-1)
    o = jnp.einsum('bhrqk,brkhd->brqhd', p.astype(v.dtype), vg)
    return o.reshape(b, s, h, hd)


def _attention_mixer(x, w_in, w_out, rpb, cos, sin):
    b, s, d = x.shape
    qkv = (x @ w_in).reshape(b, s, 3, N_HEADS, HEAD_DIM)
    q = qkv[:, :, 0] * (HEAD_DIM ** -0.5)
    k = qkv[:, :, 1]
    v = qkv[:, :, 2]
    qa = _rope(q[:, :, :N_HEADS_A], cos, sin)
    ka = _rope(k[:, :, :N_HEADS_A], cos, sin)
    va = v[:, :, :N_HEADS_A]
    outs, lses = [], []
    for window, dilation in DILATED_PATTERNS:
        o_i, l_i = _dilated_attention(qa, ka, va, window, dilation)
        outs.append(o_i)
        lses.append(l_i)
    wts = jax.nn.softmax(jnp.stack(lses), axis=0)
    oa = jnp.sum(wts[..., None] * jnp.stack(outs), axis=0).astype(x.dtype)
    ob = _neighbourhood_attention(q[:, :, N_HEADS_A:], k[:, :, N_HEADS_A:], v[:, :, N_HEADS_A:], rpb)
    o = jnp.concatenate([oa, ob], axis=2).reshape(b, s, d)
    return o @ w_out


def _pool_mixer(x, w, scale):
    b, s, d = x.shape
    xg = x.reshape(b, s, N_POOL, POOL_CH).astype(jnp.float32)
    cs = jnp.pad(jnp.cumsum(xg, axis=1), ((0, 0), (1, 0), (0, 0), (0, 0)))
    t = np.arange(s)[:, None]
    half = np.array(POOL_WINDOWS)[None, :] // 2
    lo = np.clip(t - half, 0, s)
    hi = np.clip(t + half, 0, s)
    gi = np.arange(N_POOL)[None, :]
    cnt = (hi - lo).astype(np.float32)[None, :, :, None]
    mean = (cs[:, hi, gi] - cs[:, lo, gi]) / cnt
    u = (mean - xg).astype(x.dtype)
    y = jnp.einsum('bsgc,gce->bsge', u, w).reshape(b, s, d)
    return y * scale


def _moe(xt, router_w, router_bias, w1, w3, w2):
    t_count, d = xt.shape
    aff = jax.nn.sigmoid(xt.astype(jnp.float32) @ router_w.astype(jnp.float32))
    sel = (aff + router_bias.astype(jnp.float32)).reshape(t_count, N_EXPERT_GROUPS, EXPERTS_PER_GROUP)
    gscore = jnp.sum(lax.top_k(sel, 2)[0], axis=-1)
    grp = jnp.argmax(gscore, axis=-1)
    sel_g = sel[jnp.arange(t_count), grp]
    _, local = lax.top_k(sel_g, TOP_K)
    eidx = grp[:, None] * EXPERTS_PER_GROUP + local
    gate = jnp.take_along_axis(aff, eidx, axis=1)
    gate = gate / jnp.sum(gate, axis=-1, keepdims=True)
    m = t_count * TOP_K
    flat_e = eidx.reshape(m)
    flat_t = jnp.arange(m, dtype=jnp.int32) // TOP_K
    order = jnp.argsort(flat_e)
    se = flat_e[order]
    st = flat_t[order]
    sg = gate.reshape(m)[order]
    counts = jnp.zeros((N_EXPERTS,), jnp.int32).at[flat_e].add(1)
    start = jnp.cumsum(counts) - counts
    padded = (counts + EBLK - 1) // EBLK * EBLK
    pend = jnp.cumsum(padded)
    pstart = pend - padded
    dest = pstart[se] + jnp.arange(m, dtype=jnp.int32) - start[se]
    p_rows = m + N_EXPERTS * EBLK
    nblk = p_rows // EBLK
    buf = jnp.zeros((p_rows, d), xt.dtype).at[dest].set(xt[st])
    blk_e = jnp.minimum(jnp.searchsorted(pend, jnp.arange(nblk, dtype=jnp.int32) * EBLK, side='right'), N_EXPERTS - 1)

    def expert_block(args):
        xb, e = args
        hb = jax.nn.silu(xb @ w1[e]) * (xb @ w3[e])
        return hb @ w2[e]

    yb = lax.map(expert_block, (buf.reshape(nblk, EBLK, d), blk_e)).reshape(p_rows, d)
    y = jnp.zeros((t_count, d), jnp.float32).at[st].add(yb[dest].astype(jnp.float32) * sg[:, None])
    return y.astype(xt.dtype)


def setup_inputs(seed: int = 0) -> dict:
    key = jax.random.key(seed)
    ks = jax.random.split(key, 13)
    d = D_MODEL
    x = jax.random.normal(ks[0], (BATCH, SEQ, d), jnp.float32)
    w_in = jax.random.normal(ks[1], (N_EVEN, d, 3 * d), jnp.float32) * d ** -0.5
    w_out = jax.random.normal(ks[2], (N_EVEN, d, d), jnp.float32) * (d ** -0.5 * DEEPNORM_BETA)
    rpb = jax.random.normal(ks[3], (N_EVEN, N_HEADS_B, 2 * NA_ROWS - 1, 2 * NA_COLS - 1), jnp.float32) * 0.1
    pool_w = jax.random.normal(ks[4], (N_ODD, N_POOL, POOL_CH, POOL_CH), jnp.float32) * (POOL_CH ** -0.5 * DEEPNORM_BETA)
    pool_scale = 1.0 + 0.1 * jax.random.normal(ks[5], (N_ODD, d), jnp.float32)
    router_w = jax.random.normal(ks[6], (d, N_EXPERTS), jnp.float32) * d ** -0.5
    router_bias = 0.01 * jax.random.normal(ks[7], (N_EXPERTS,), jnp.float32)
    moe_w1 = jax.random.normal(ks[8], (DEPTH, N_EXPERTS, d, D_EXPERT), jnp.float32) * d ** -0.5
    moe_w3 = jax.random.normal(ks[9], (DEPTH, N_EXPERTS, d, D_EXPERT), jnp.float32) * d ** -0.5
    moe_w2 = jax.random.normal(ks[10], (DEPTH, N_EXPERTS, D_EXPERT, d), jnp.float32) * (D_EXPERT ** -0.5 * DEEPNORM_BETA)
    ln_g = 1.0 + 0.05 * jax.random.normal(ks[11], (DEPTH, 2, d), jnp.float32)
    ln_b = 0.02 * jax.random.normal(ks[12], (DEPTH, 2, d), jnp.float32)
    return {'x': x, 'w_in': w_in, 'w_out': w_out, 'rpb': rpb, 'pool_w': pool_w,
            'pool_scale': pool_scale, 'router_w': router_w, 'router_bias': router_bias,
            'moe_w1': moe_w1, 'moe_w3': moe_w3, 'moe_w2': moe_w2, 'ln_g': ln_g, 'ln_b': ln_b}


def reference(x, w_in, w_out, rpb, pool_w, pool_scale, router_w, router_bias, moe_w1, moe_w3, moe_w2, ln_g, ln_b):
    b, s, d = x.shape
    cos, sin = _rope_tables(s)
    for layer in range(DEPTH):
        i = layer // 2
        if layer % 2 == 0:
            h = _attention_mixer(x, w_in[i], w_out[i], rpb[i], cos, sin)
        else:
            h = _pool_mixer(x, pool_w[i], pool_scale[i])
        x = _layer_norm(DEEPNORM_ALPHA * x + h, ln_g[layer, 0], ln_b[layer, 0])
        f = _moe(x.reshape(b * s, d), router_w, router_bias, moe_w1[layer], moe_w3[layer], moe_w2[layer]).reshape(b, s, d)
        x = _layer_norm(DEEPNORM_ALPHA * x + f, ln_g[layer, 1], ln_b[layer, 1])
    return x
```

```cpp
#include <hip/hip_runtime.h>
#include <cstdio>
#include <cstdint>
#include <cmath>

#ifndef MK_MULTI_LAUNCH
#define MK_MULTI_LAUNCH 1
#endif

namespace pg8 {
#define PG8_LAS __attribute__((address_space(3)))
typedef unsigned short bf16_t;
typedef short bf16x8 __attribute__((ext_vector_type(8)));
typedef float f32x4 __attribute__((ext_vector_type(4)));
typedef unsigned u32x4 __attribute__((ext_vector_type(4)));
constexpr int BM = 256, BK = 64, HALF = 128, HTB = HALF * BK * 2  , STAGE_BYTES = 8 * HTB, NXCD = 8, WGM = 8;

__host__ __device__ __forceinline__ int lds_byte(int r, int c) { const int st = (r >> 4) * 2 + (c >> 5), rr = r & 15, cc = c & 31, ob = rr * 64 + cc * 2; return st * 1024 + (ob ^ (((ob >> 9) & 1) << 5)); }
__host__ __device__ __forceinline__ void stage_rc(int b, int& R, int& C) { const int st = b / 1024, sb = b % 1024, swz = sb ^ (((sb >> 9) & 1) << 5); R = (st >> 1) * 16 + swz / 64; C = (st & 1) * 32 + (swz % 64) / 2; }
__host__ __device__ __forceinline__ int perm32(int rho) { const int n = rho >> 4, i = rho & 15; return 8 * (i >> 2) + 4 * n + (i & 3); }

struct Unit { int pm, pn; };
struct Gemm { int lda, ldb, K; };

__device__ __forceinline__ unsigned cvt_pk_bf16(float lo, float hi) { unsigned r; asm volatile("v_cvt_pk_bf16_f32 %0, %1, %2" : "=v"(r) : "v"(lo), "v"(hi)); return r; }

template <class Epi, class Sched, bool ALIGN_EPI>
__device__ __forceinline__ void gemm_phase(PG8_LAS unsigned char* lds, const Gemm g, const Sched& S, const Epi& E) {
    int tid_ = threadIdx.x; asm volatile("" : "+v"(tid_));
    const int tid = tid_, wid = __builtin_amdgcn_readfirstlane(tid >> 6), lane = tid & 63, wr = wid >> 2, wc = wid & 3, fr = lane & 15, fq = lane >> 4;
    const int K = g.K, nt = K / BK;
    unsigned voffA[2], voffB[2];
#pragma unroll
    for (int i = 0; i < 2; ++i) { int R, C; stage_rc(tid * 16 + i * 8192, R, C); const int Rb = 64 * (R >> 5) + perm32(R & 31);
        voffA[i] = (unsigned)(R * g.lda + C) * 2u; voffB[i] = (unsigned)(Rb * g.ldb + C) * 2u; }
    const size_t kstep = (size_t)(BK * 2);
    const size_t hstepA = (size_t)HALF * g.lda * 2;
    const size_t hstepB = (size_t)32 * g.ldb * 2;
    const unsigned ldsw = (unsigned)wid * 1024u;
    const int aoff = lds_byte(wr * 64 + fr, fq * 8), boff = lds_byte(wc * 32 + fr, fq * 8);
#define PG8_SA(b, h) (((b) * 2 + (h)) * HTB)
#define PG8_SB(b, h) ((4 + (b) * 2 + (h)) * HTB)
#define PG8_STAGE(bufoff, gbase, voff) do { _Pragma("unroll") for (int _i = 0; _i < 2; ++_i) \
        __builtin_amdgcn_global_load_lds((const unsigned*)((const char*)(gbase) + (voff)[_i]), (PG8_LAS unsigned*)(lds + (bufoff) + ldsw + _i * 8192), 16, 0, 0); } while (0)
#define PG8_LDA(dst, b, h) do { _Pragma("unroll") for (int m = 0; m < 4; ++m) _Pragma("unroll") for (int k = 0; k < 2; ++k) dst[m][k] = *(const PG8_LAS bf16x8*)(lds + PG8_SA(b, h) + aoff + m * 2048 + k * 1024); } while (0)
#define PG8_LDB(dst, b, h) do { _Pragma("unroll") for (int n = 0; n < 2; ++n) _Pragma("unroll") for (int k = 0; k < 2; ++k) dst[n][k] = *(const PG8_LAS bf16x8*)(lds + PG8_SB(b, h) + boff + n * 2048 + k * 1024); } while (0)
#define PG8_MMA(ai, bj, At, Bt) do { __builtin_amdgcn_s_setprio(1); _Pragma("unroll") for (int m = 0; m < 4; ++m) _Pragma("unroll") for (int n = 0; n < 2; ++n) _Pragma("unroll") for (int k = 0; k < 2; ++k) \
        acc[ai][bj][m][n] = __builtin_amdgcn_mfma_f32_16x16x32_bf16(Bt[n][k], At[m][k], acc[ai][bj][m][n], 0, 0, 0); __builtin_amdgcn_s_setprio(0); } while (0)
#define PG8_WAIT_V(n) asm volatile("s_waitcnt vmcnt(" #n ")" ::: "memory")
#define PG8_WAIT_L(n) asm volatile("s_waitcnt lgkmcnt(" #n ")" ::: "memory")
#define PG8_BAR __builtin_amdgcn_s_barrier()
#define PG8_SCHED __builtin_amdgcn_sched_barrier(0)
    Unit cur, nxt; int ui = 0;
    const char* cA; const char* cB; const char* nA; const char* nB;
    if (!S.next(0, cur.pm, cur.pn, cA, cB)) return;
    f32x4 acc[2][2][4][2];
#pragma unroll
    for (int a = 0; a < 2; ++a)
#pragma unroll
        for (int b = 0; b < 2; ++b)
#pragma unroll
            for (int m = 0; m < 4; ++m)
#pragma unroll
                for (int n = 0; n < 2; ++n) acc[a][b][m][n] = (f32x4){0.f, 0.f, 0.f, 0.f};
    bf16x8 At[4][2], B0[2][2], B1[2][2];
    PG8_STAGE(PG8_SB(0, 0), cB, voffB); PG8_STAGE(PG8_SB(0, 1), cB + hstepB, voffB); PG8_STAGE(PG8_SA(0, 0), cA, voffA); PG8_STAGE(PG8_SA(0, 1), cA + hstepA, voffA);
    if (wr == 1) PG8_BAR;
    PG8_WAIT_V(2); PG8_BAR;
    PG8_STAGE(PG8_SB(1, 0), cB + kstep, voffB); PG8_STAGE(PG8_SA(1, 0), cA + kstep, voffA); PG8_STAGE(PG8_SB(1, 1), cB + hstepB + kstep, voffB);
    PG8_WAIT_V(6); PG8_BAR;
    for (;;) {
        const bool has_next = S.next(ui + 1, nxt.pm, nxt.pn, nA, nB);
        if (!has_next) { nA = cA; nB = cB; }
        for (int t = 0; t < nt; t += 2) {
            const bool last = (t == nt - 2);
            const char* a1 = cA + (size_t)(t + 1) * kstep;
            const char* a2 = last ? nA : cA + (size_t)(t + 2) * kstep; const char* b2 = last ? nB : cB + (size_t)(t + 2) * kstep;
            const char* a3 = a2 + kstep; const char* b3 = b2 + kstep;
            PG8_LDB(B0, 0, 0); PG8_LDB(B1, 0, 1); PG8_SCHED; PG8_LDA(At, 0, 0); PG8_STAGE(PG8_SA(1, 1), a1 + hstepA, voffA);
            PG8_WAIT_V(8); PG8_WAIT_L(0); PG8_BAR; PG8_MMA(0, 0, At, B0); PG8_MMA(0, 1, At, B1); PG8_BAR; PG8_SCHED;
            PG8_LDA(At, 0, 1); PG8_STAGE(PG8_SB(0, 0), b2, voffB); PG8_STAGE(PG8_SB(0, 1), b2 + hstepB, voffB); PG8_STAGE(PG8_SA(0, 0), a2, voffA);
            PG8_WAIT_V(8); PG8_WAIT_L(0); PG8_BAR; PG8_MMA(1, 0, At, B0); PG8_MMA(1, 1, At, B1); PG8_BAR; PG8_SCHED;
            PG8_LDB(B0, 1, 0); PG8_LDB(B1, 1, 1); PG8_SCHED; PG8_LDA(At, 1, 0); PG8_STAGE(PG8_SA(0, 1), a2 + hstepA, voffA);
            PG8_WAIT_V(8); PG8_WAIT_L(0); PG8_BAR; PG8_MMA(0, 0, At, B0); PG8_MMA(0, 1, At, B1); PG8_BAR; PG8_SCHED;
            PG8_LDA(At, 1, 1); PG8_STAGE(PG8_SB(1, 0), b3, voffB); PG8_STAGE(PG8_SB(1, 1), b3 + hstepB, voffB); PG8_STAGE(PG8_SA(1, 0), a3, voffA);
            PG8_WAIT_V(8); PG8_WAIT_L(0); PG8_BAR; PG8_MMA(1, 0, At, B0); PG8_MMA(1, 1, At, B1); PG8_BAR; PG8_SCHED;
        }
        if constexpr (ALIGN_EPI) { if (wr == 0) PG8_BAR; }
        E(acc, cur, wr, wc, fr, fq);
        if (!has_next) break;
#pragma unroll
        for (int a = 0; a < 2; ++a)
#pragma unroll
            for (int b = 0; b < 2; ++b)
#pragma unroll
                for (int m = 0; m < 4; ++m)
#pragma unroll
                    for (int n = 0; n < 2; ++n) acc[a][b][m][n] = (f32x4){0.f, 0.f, 0.f, 0.f};
        cur.pm = nxt.pm; cur.pn = nxt.pn; cA = nA; cB = nB; ++ui;
        if constexpr (ALIGN_EPI) { if (wr == 1) PG8_BAR; }
    }
    PG8_WAIT_V(0);
    if constexpr (!ALIGN_EPI) { if (wr == 0) PG8_BAR; }
    PG8_BAR;
#undef PG8_SA
#undef PG8_SB
#undef PG8_STAGE
#undef PG8_LDA
#undef PG8_LDB
#undef PG8_MMA
#undef PG8_WAIT_V
#undef PG8_WAIT_L
#undef PG8_BAR
#undef PG8_SCHED
}
}

constexpr int NWAVES = 8;
constexpr int BATCH = 4, SEQ = 8192, DM = 1024, T = BATCH * SEQ, DEPTH = 4;
constexpr int NEXP = 16;
constexpr int PROWS = 2 * T + NEXP * 256;
constexpr float LN_EPS = 1e-5f;
constexpr float ALPHA = 1.681792830507429f;
constexpr float QSCALE = 0.125f * 1.4426950408889634f;
constexpr float LOG2E = 1.4426950408889634f;

constexpr size_t MiB = 1u << 20;
constexpr size_t WS_CTL = 0, CTL_ZERO_BYTES = 1 * MiB;
constexpr size_t WS_ROPE = 1 * MiB;
constexpr size_t WS_WQKV = 3 * MiB;
constexpr size_t WS_WO = 15 * MiB;
constexpr size_t WS_WP = 19 * MiB;
constexpr size_t WS_W13 = 20 * MiB;
constexpr size_t WS_W2 = 276 * MiB;
constexpr size_t WS_XB = 404 * MiB;
constexpr size_t WS_Y = 468 * MiB;
constexpr size_t WS_OP = WS_Y, WS_LSE = WS_Y + 96 * MiB;
constexpr size_t WS_R = 596 * MiB;
constexpr size_t WS_Q = WS_R, WS_K = WS_R + 64 * MiB, WS_V = WS_R + 128 * MiB, WS_O = WS_R + 192 * MiB;
constexpr size_t WS_U = WS_R;
constexpr size_t WS_XS = WS_R, WS_H = WS_R + 136 * MiB;
constexpr size_t WS_TOK = 868 * MiB;
constexpr size_t WS_SMALL = 869 * MiB;
constexpr int SM_RPB = 0, SM_PSC = 7440, SM_RW = 9488, SM_RB = 25872, SM_LNG = 25888, SM_LNB = 34080, SM_END = 42272;
constexpr size_t WS_END = 870 * MiB;
static_assert((size_t)PROWS * DM * 2 <= 136 * MiB && WS_H + 136 * MiB <= WS_TOK, "d_ws map");

constexpr int CW_BAR = 4096;
constexpr int CW_CNT = 16384;

constexpr int RING_BYTES = 131072;
constexpr int MISC_OFF = RING_BYTES + 320;
constexpr int LDS_BYTES = 147456;
constexpr int TEXP_OFF = RING_BYTES + 1024;

#define GAS __attribute__((address_space(1)))
#define LAS __attribute__((address_space(3)))
typedef unsigned short bf16;
typedef unsigned v4u __attribute__((ext_vector_type(4)));
typedef unsigned v2u __attribute__((ext_vector_type(2)));
typedef float f32x4 __attribute__((ext_vector_type(4)));
typedef float f32x16 __attribute__((ext_vector_type(16)));
typedef short bf16x8 __attribute__((ext_vector_type(8)));
typedef short s16x4 __attribute__((ext_vector_type(4)));
typedef GAS unsigned gu32;
#define RLX_AGENT __ATOMIC_RELAXED, __HIP_MEMORY_SCOPE_AGENT
#define LDS_WAIT() asm volatile("s_waitcnt lgkmcnt(0)" ::: "memory")
__device__ __forceinline__ unsigned f2bf(float f) { unsigned u = __builtin_bit_cast(unsigned, f); return (u + 0x7fffu + ((u >> 16) & 1u)) >> 16; }
__device__ __forceinline__ unsigned pk2(float lo, float hi) { return f2bf(lo) | (f2bf(hi) << 16); }
__device__ __forceinline__ float bf_lo(unsigned u) { return __builtin_bit_cast(float, u << 16); }
__device__ __forceinline__ float bf_hi(unsigned u) { return __builtin_bit_cast(float, u & 0xffff0000u); }

#define XB_TMO      128
#define XB_XCNT(j)  (256  + 64 * (j))
#define XB_XSUB(j)  (1280 + 64 * (j))
#define XB_XGEN(j)  (2304 + 64 * (j))
#define XB_TOP      3328
#define XB_TOPGEN   3392
#define XCD_BAR_WORDS 3456
#define XB_SPIN_CAP (1u << 18)

__device__ __forceinline__ unsigned xb_ld(unsigned* p)              { return __hip_atomic_load(p, __ATOMIC_RELAXED, __HIP_MEMORY_SCOPE_AGENT); }
__device__ __forceinline__ unsigned xb_add(unsigned* p, unsigned v) { return __hip_atomic_fetch_add(p, v, __ATOMIC_RELAXED, __HIP_MEMORY_SCOPE_AGENT); }
__device__ __forceinline__ unsigned xb_xcc_id() { return (unsigned)__builtin_amdgcn_s_getreg((3 << 11) | 20) & 0xFu; }
#define XB_SPIN(cond, bar) do { unsigned _sp = 0; while (cond) { __builtin_amdgcn_s_sleep(1); \
    if ((++_sp & 255u) == 0u) { if (xb_ld(&(bar)[XB_TMO])) break; if (_sp > XB_SPIN_CAP) { atomicAdd(&(bar)[XB_TMO], 1u); break; } } } } while (0)

struct XcdBarrier { unsigned* bar; unsigned x; volatile LAS unsigned* st; };

__device__ __forceinline__ XcdBarrier xcd_barrier_post(unsigned* bar, volatile LAS unsigned* st) {
    XcdBarrier b; b.bar = bar; b.x = xb_xcc_id(); b.st = st;
    if (threadIdx.x == 0) (void)xb_add(&bar[XB_XCNT(b.x)], 1u);
    return b;
}
__device__ __forceinline__ void xcd_barrier_complete(unsigned* bar, unsigned x, unsigned& nloc, unsigned& nx) {
    const unsigned G = gridDim.x * gridDim.y * gridDim.z;
    unsigned sum, cnt, mine, sp = 0u;
    for (;;) {
        sum = 0u; cnt = 0u; mine = 0u;
#pragma unroll
        for (unsigned j = 0; j < 16; ++j) { const unsigned c = xb_ld(&bar[XB_XCNT(j)]); sum += c; cnt += (c > 0u) ? 1u : 0u; mine = (j == x) ? c : mine; }
        if (sum == G) break;
        __builtin_amdgcn_s_sleep(1);
        if ((++sp & 255u) == 0u) { if (xb_ld(&bar[XB_TMO])) break; if (sp > XB_SPIN_CAP) { atomicAdd(&bar[XB_TMO], 1u); break; } }
    }
    nloc = mine > 0u ? mine : 1u; nx = cnt > 0u ? cnt : 1u;
}
__device__ __forceinline__ void xcd_barrier(const XcdBarrier& b) {
    asm volatile("s_waitcnt vmcnt(0)" ::: "memory");
    __syncthreads();
    int tid_ = threadIdx.x; asm volatile("" : "+v"(tid_));
    if (tid_ == 0) {
        unsigned* bar = b.bar; asm volatile("" : "+s"(bar));
        __builtin_amdgcn_s_waitcnt(0);
        unsigned nloc = b.st[0], nx = b.st[1];
        if (nloc == 0u) { xcd_barrier_complete(bar, b.x, nloc, nx); b.st[0] = nloc; b.st[1] = nx; }
        const unsigned old = xb_add(&bar[XB_XSUB(b.x)], 1u);
        const unsigned gen = old / nloc;
        if (old + 1u == (gen + 1u) * nloc) {
            __builtin_amdgcn_fence(__ATOMIC_RELEASE, "agent");
            asm volatile("s_waitcnt vmcnt(0)" ::: "memory");
            const unsigned og = xb_add(&bar[XB_TOP], 1u);
            const unsigned tg = og / nx;
            if (og + 1u == (tg + 1u) * nx) xb_add(&bar[XB_TOPGEN], 1u);
            else XB_SPIN(xb_ld(&bar[XB_TOPGEN]) == tg, bar);
            __builtin_amdgcn_fence(__ATOMIC_ACQUIRE, "agent");
            xb_add(&bar[XB_XGEN(b.x)], 1u);
            asm volatile("s_waitcnt vmcnt(0)" ::: "memory");
        } else {
            XB_SPIN(xb_ld(&bar[XB_XGEN(b.x)]) == gen, bar);
            __builtin_amdgcn_fence(__ATOMIC_ACQUIRE, "agent");
            asm volatile("s_waitcnt vmcnt(0)" ::: "memory");
        }
    }
    __syncthreads();
}

struct Sched {
    int nM, nN, nwg, G, c;
    const char* A; const char* B; size_t a_tile, a_pn, b_tile, e_bytes; const LAS unsigned char* texp;
    __device__ __forceinline__ bool next(int i, int& pm, int& pn, const char*& pa, const char*& pb) const {
        const long L = (long)i * G + c; if (L >= nwg) return false;
        int wgid = (int)L; { const int q = nwg / pg8::NXCD, r = nwg % pg8::NXCD, xcd = wgid % pg8::NXCD, off = wgid / pg8::NXCD; wgid = (xcd < r ? xcd * (q + 1) : r * (q + 1) + (xcd - r) * q) + off; }
        const int nig = pg8::WGM * nN, gid = wgid / nig, fm = gid * pg8::WGM, gsz = (nM - fm) < pg8::WGM ? (nM - fm) : pg8::WGM;
        pm = fm + ((wgid % nig) % gsz); pn = (wgid % nig) / gsz;
        pa = A + (size_t)pm * a_tile + (size_t)pn * a_pn;
        const char* bb = B + (size_t)pn * b_tile;
        if (texp) { const int e = __builtin_amdgcn_readfirstlane((int)texp[pm]); bb += (size_t)e * e_bytes; }
        pb = bb; return true;
    }
};

using pg8::f32x4;

struct EpiQKV {
    bf16* Q; size_t kv_stride; const float* cosT; const float* sinT;
    __device__ __forceinline__ void operator()(const f32x4 (&acc)[2][2][4][2], const pg8::Unit& u, int wr, int wc, int fr, int fq) const {
        const int sel = u.pn >> 2, head = 4 * (u.pn & 3) + wc;
        bf16* base = Q + (size_t)sel * kv_stride;
        const bool rope = (sel < 2) && ((u.pn & 3) < 2);
        const float sc = sel == 0 ? QSCALE : 1.f;
        const int col0 = 64 * head + 8 * fq;
#pragma unroll
        for (int ai = 0; ai < 2; ++ai)
#pragma unroll
            for (int m = 0; m < 4; ++m) {
                const int row = u.pm * 256 + ai * 128 + wr * 64 + m * 16 + fr;
                f32x4 a0 = acc[ai][0][m][0], a1 = acc[ai][0][m][1], b0 = acc[ai][1][m][0], b1 = acc[ai][1][m][1];
                if (rope) {
                    const int s = row & (SEQ - 1);
                    const f32x4 c0 = *(const f32x4*)(cosT + s * 32 + 8 * fq), c1 = *(const f32x4*)(cosT + s * 32 + 8 * fq + 4);
                    const f32x4 s0 = *(const f32x4*)(sinT + s * 32 + 8 * fq), s1 = *(const f32x4*)(sinT + s * 32 + 8 * fq + 4);
                    const f32x4 na0 = a0 * c0 - b0 * s0, nb0 = b0 * c0 + a0 * s0, na1 = a1 * c1 - b1 * s1, nb1 = b1 * c1 + a1 * s1;
                    a0 = na0; b0 = nb0; a1 = na1; b1 = nb1;
                }
                a0 = a0 * sc; a1 = a1 * sc; b0 = b0 * sc; b1 = b1 * sc;
                bf16* rowp = base + (size_t)row * DM + col0;
                v4u w; w.x = pg8::cvt_pk_bf16(a0[0], a0[1]); w.y = pg8::cvt_pk_bf16(a0[2], a0[3]); w.z = pg8::cvt_pk_bf16(a1[0], a1[1]); w.w = pg8::cvt_pk_bf16(a1[2], a1[3]);
                *(v4u*)rowp = w;
                v4u x; x.x = pg8::cvt_pk_bf16(b0[0], b0[1]); x.y = pg8::cvt_pk_bf16(b0[2], b0[3]); x.z = pg8::cvt_pk_bf16(b1[0], b1[1]); x.w = pg8::cvt_pk_bf16(b1[2], b1[3]);
                *(v4u*)(rowp + 32) = x;
                asm volatile("" ::: "memory");
            }
    }
};
struct EpiRes {
    const float* xres; float* Y; const float* csc;
    __device__ __forceinline__ void operator()(const f32x4 (&acc)[2][2][4][2], const pg8::Unit& u, int wr, int wc, int fr, int fq) const {
        const int col0 = u.pn * 256 + 64 * wc + 8 * fq;
#pragma unroll
        for (int ai = 0; ai < 2; ++ai)
#pragma unroll
            for (int m = 0; m < 4; ++m) {
                const size_t off = (size_t)(u.pm * 256 + ai * 128 + wr * 64 + m * 16 + fr) * DM + col0;
#pragma unroll
                for (int bj = 0; bj < 2; ++bj)
#pragma unroll
                    for (int n = 0; n < 2; ++n) {
                        const f32x4 xr = *(const f32x4*)(xres + off + 32 * bj + 4 * n);
                        f32x4 av = acc[ai][bj][m][n];
                        if (csc) av = av * *(const f32x4*)(csc + col0 + 32 * bj + 4 * n);
                        *(f32x4*)(Y + off + 32 * bj + 4 * n) = xr * ALPHA + av;
                    }
                asm volatile("" ::: "memory");
            }
    }
};
struct EpiSwiGLU {
    bf16* H;
    __device__ __forceinline__ void operator()(const f32x4 (&acc)[2][2][4][2], const pg8::Unit& u, int wr, int wc, int fr, int fq) const {
        const int col0 = u.pn * 128 + 32 * wc + 8 * fq;
#pragma unroll
        for (int ai = 0; ai < 2; ++ai)
#pragma unroll
            for (int m = 0; m < 4; ++m) {
                const size_t off = (size_t)(u.pm * 256 + ai * 128 + wr * 64 + m * 16 + fr) * DM + col0;
                float h[8];
#pragma unroll
                for (int n = 0; n < 2; ++n)
#pragma unroll
                    for (int e = 0; e < 4; ++e) {
                        const float gt = acc[ai][0][m][n][e], up = acc[ai][1][m][n][e];
                        const float sg = gt * __builtin_amdgcn_rcpf(1.f + __builtin_amdgcn_exp2f(-gt * LOG2E));
                        h[4 * n + e] = sg * up;
                    }
                v4u w; w.x = pg8::cvt_pk_bf16(h[0], h[1]); w.y = pg8::cvt_pk_bf16(h[2], h[3]); w.z = pg8::cvt_pk_bf16(h[4], h[5]); w.w = pg8::cvt_pk_bf16(h[6], h[7]);
                *(v4u*)(H + off) = w;
                asm volatile("" ::: "memory");
            }
    }
};
struct EpiBf16 {
    bf16* O;
    __device__ __forceinline__ void operator()(const f32x4 (&acc)[2][2][4][2], const pg8::Unit& u, int wr, int wc, int fr, int fq) const {
        const int col0 = u.pn * 256 + 64 * wc + 8 * fq;
#pragma unroll
        for (int ai = 0; ai < 2; ++ai)
#pragma unroll
            for (int m = 0; m < 4; ++m) {
                const size_t off = (size_t)(u.pm * 256 + ai * 128 + wr * 64 + m * 16 + fr) * DM + col0;
#pragma unroll
                for (int bj = 0; bj < 2; ++bj) {
                    const f32x4 v0 = acc[ai][bj][m][0], v1 = acc[ai][bj][m][1];
                    v4u w; w.x = pg8::cvt_pk_bf16(v0[0], v0[1]); w.y = pg8::cvt_pk_bf16(v0[2], v0[3]); w.z = pg8::cvt_pk_bf16(v1[0], v1[1]); w.w = pg8::cvt_pk_bf16(v1[2], v1[3]);
                    *(v4u*)(O + off + 32 * bj) = w;
                }
                asm volatile("" ::: "memory");
            }
    }
};

__device__ __forceinline__ float wave_sum(float v) {
#pragma unroll
    for (int o = 1; o < 64; o <<= 1) v += __shfl_xor(v, o);
    return v;
}
typedef float f32x2_t __attribute__((ext_vector_type(2))); typedef __bf16 bf16x2_t __attribute__((ext_vector_type(2)));
__device__ __forceinline__ unsigned cvtpk_s(float lo, float hi) { f32x2_t v = {lo, hi}; bf16x2_t b = __builtin_convertvector(v, bf16x2_t); return __builtin_bit_cast(unsigned, b); }

__device__ __forceinline__ void p0_transpose_item(const float* W, int K, int N, bf16* WT, int k0, int n0, int drow, LAS float* scr, int lane) {
#pragma unroll 8
    for (int i = 0; i < 32; ++i) { const int kk = 2 * i + (lane >> 5); scr[kk * 33 + (lane & 31)] = W[(size_t)(k0 + kk) * N + n0 + (lane & 31)]; }
    LDS_WAIT(); asm volatile("" ::: "memory");
    const int c = lane & 7;
#pragma unroll
    for (int j = 0; j < 4; ++j) { const int n = (lane >> 3) + 8 * j; const LAS float* s = scr + (8 * c) * 33 + n;
        v4u o; o.x = pk2(s[0 * 33], s[1 * 33]); o.y = pk2(s[2 * 33], s[3 * 33]); o.z = pk2(s[4 * 33], s[5 * 33]); o.w = pk2(s[6 * 33], s[7 * 33]);
        *(GAS v4u*)(WT + (size_t)(drow + n) * K + k0 + 8 * c) = o; }
    LDS_WAIT(); asm volatile("" ::: "memory");
}
struct InPtrs { const float *x, *w_in, *w_out, *rpb, *pool_w, *pool_scale, *router_w, *router_bias, *w1, *w3, *w2, *ln_g, *ln_b; };

__device__ __forceinline__ void sincos_d(double a, double& sn, double& cs) {
    const double n = __builtin_rint(a * 0.63661977236758134308);
    double r = __builtin_fma(-n, 1.57079632679489655800e+00, a); r = __builtin_fma(-n, 6.12323399573676603587e-17, r);
    const double z = r * r;
    const double sp = r + r * z * (-1.66666666666666324348e-01 + z * (8.33333333332248946124e-03 + z * (-1.98412698298579493134e-04 + z * (2.75573137070700676789e-06 + z * (-2.50507602534068634195e-08 + z * 1.58969099521155010221e-10)))));
    const double cp = 1.0 - 0.5 * z + z * z * (4.16666666666666019037e-02 + z * (-1.38888888888741095749e-03 + z * (2.48015872894767294178e-05 + z * (-2.75573143513906633035e-07 + z * (2.08757232129817482790e-09 + z * -1.13596475577881948265e-11)))));
    const int q = (int)((long long)n & 3);
    sn = (q == 0) ? sp : (q == 1) ? cp : (q == 2) ? -sp : -cp;
    cs = (q == 0) ? cp : (q == 1) ? -sp : (q == 2) ? -cp : sp;
}

__device__ __forceinline__ void phase_prologue(const InPtrs& in, unsigned char* ws, LAS unsigned char* lds, int gw, int NGW, int lane, int wave, int gtid, int NTH) {
    LAS float* scr = (LAS float*)(lds + wave * 16384);
    constexpr int MOE_ITEMS = DEPTH * NEXP * 3 * 512, IN_ITEMS = 2 * 1536, OUT_ITEMS = 2 * 512, POOL_ITEMS = 8 * 32;
    constexpr int NITEMS = MOE_ITEMS + IN_ITEMS + OUT_ITEMS + POOL_ITEMS;
    for (int it = gw; it < NITEMS; it += NGW) {
        int r = it;
        if (r < MOE_ITEMS) {
            const int mat = r >> 9, loc = r & 511, le = mat / 3, which = mat - 3 * le;
            const int kb = loc >> 5, nb = loc & 31;
            const float* src = (which == 0 ? in.w1 : which == 1 ? in.w3 : in.w2) + (size_t)le * DM * DM;
            if (which < 2) p0_transpose_item(src, DM, DM, (bf16*)(ws + WS_W13) + (size_t)le * 2048 * DM, 64 * kb, 32 * nb, 64 * nb + 32 * which, scr, lane);
            else           p0_transpose_item(src, DM, DM, (bf16*)(ws + WS_W2) + (size_t)le * DM * DM, 64 * kb, 32 * nb, 32 * nb, scr, lane);
            continue;
        }
        r -= MOE_ITEMS;
        if (r < IN_ITEMS) { const int i = r / 1536, loc = r - 1536 * i, kb = loc / 96, nb = loc - 96 * kb;
            p0_transpose_item(in.w_in + (size_t)i * DM * 3072, DM, 3072, (bf16*)(ws + WS_WQKV) + (size_t)i * 3072 * DM, 64 * kb, 32 * nb, 32 * nb, scr, lane); continue; }
        r -= IN_ITEMS;
        if (r < OUT_ITEMS) { const int i = r >> 9, loc = r & 511, kb = loc >> 5, nb = loc & 31;
            p0_transpose_item(in.w_out + (size_t)i * DM * DM, DM, DM, (bf16*)(ws + WS_WO) + (size_t)i * DM * DM, 64 * kb, 32 * nb, 32 * nb, scr, lane); continue; }
        r -= OUT_ITEMS;
        { const int mat = r >> 5, loc = r & 31, kb = loc >> 3, nb = loc & 7;
            p0_transpose_item(in.pool_w + (size_t)mat * 65536, 256, 256, (bf16*)(ws + WS_WP) + (size_t)mat * 65536, 64 * kb, 32 * nb, 32 * nb, scr, lane); }
    }
    bf16* XB = (bf16*)(ws + WS_XB);
    for (int m = gw; m < T; m += NGW) {
        const GAS f32x4* xr = (const GAS f32x4*)(in.x + (size_t)m * DM) + lane;
        GAS unsigned long long* o8 = (GAS unsigned long long*)(XB + (size_t)m * DM) + lane;
#pragma unroll
        for (int j = 0; j < 4; ++j) { const f32x4 v = xr[64 * j]; o8[64 * j] = (unsigned long long)pk2(v.x, v.y) | ((unsigned long long)pk2(v.z, v.w) << 32); }
    }
    { float* sm = (float*)(ws + WS_SMALL);
      for (int i = gtid; i < SM_END; i += NTH) {
          float v;
          if (i < SM_PSC) v = in.rpb[i]; else if (i < SM_RW) v = in.pool_scale[i - SM_PSC]; else if (i < SM_RB) v = in.router_w[i - SM_RW];
          else if (i < SM_LNG) v = in.router_bias[i - SM_RB]; else if (i < SM_LNB) v = in.ln_g[i - SM_LNG]; else v = in.ln_b[i - SM_LNB];
          sm[i] = v; } }
    float* cosT = (float*)(ws + WS_ROPE); float* sinT = cosT + SEQ * 32;
    for (int idx = gw * 64 + lane; idx < SEQ * 32; idx += NGW * 64) {
        const int s = idx >> 5, i = idx & 31;
        double invf = 1.0;
        if (i & 1) invf *= 0.7498942093324559; if (i & 2) invf *= 0.5623413251903491; if (i & 4) invf *= 0.31622776601683794; if (i & 8) invf *= 0.1; if (i & 16) invf *= 0.01;
        double sn, cs; sincos_d((double)s * invf, sn, cs);
        cosT[idx] = (float)cs; sinT[idx] = (float)sn;
    }
}

struct AttnP { const bf16* Q; const bf16* K; const bf16* V; bf16* O; bf16* OP; float* LSE; };
constexpr int V_RS = 144;
constexpr int V_TILE_BYTES = 32 * V_RS;
constexpr int RPB_OFF = 8 * V_TILE_BYTES;

template <bool NT>
__device__ __forceinline__ void attn_unit(const AttnP& P, int unit, LAS unsigned char* vbuf, const LAS float* rpbt, int lane) {
    const int q = lane & 31, hi = lane >> 5;
    int b, hcol, ntiles, qtok, sh = 0, ph = 0, i0 = 0, L = SEQ, br = 0, hD = 0;
    int r = 0, r0 = 0, qhalf = 0, c = 0, cs = 0, hN = 0;
    if (NT) { b = unit >> 11; hN = (unit >> 8) & 7; r = (unit & 255) >> 1; qhalf = unit & 1; r0 = min(max(r - 4, 0), 120); c = 32 * qhalf + q; cs = min(max(c - 8, 0), 48);
        qtok = b * SEQ + 64 * r + c; hcol = 64 * (8 + hN); ntiles = 12; }
    else { br = unit >> 13; const int rem = unit & 8191; b = rem >> 11; hD = (rem >> 8) & 7; const int qblk = rem & 255;
        sh = 2 * br; ph = qblk >> (8 - sh); const int ib = qblk & ((256 >> sh) - 1); i0 = 32 * ib; L = SEQ >> sh;
        qtok = b * SEQ + ((i0 + q) << sh) + ph; hcol = 64 * hD; ntiles = 5; }
    auto ktok = [&](int t, int key) -> int {
        if (NT) { const int rp = t / 3, cc = t - 3 * rp + qhalf; const int kr = 2 * rp + (key >> 4), kc = 16 * cc + (key & 15); return b * SEQ + 64 * (r0 + kr) + kc; }
        else { int j = i0 - 64 + 32 * t + key; j = min(max(j, 0), L - 1); return b * SEQ + (j << sh) + ph; }
    };
    bf16x8 qf[4];
#pragma unroll
    for (int d0 = 0; d0 < 4; ++d0) qf[d0] = *(const bf16x8*)(P.Q + (size_t)qtok * DM + hcol + 16 * d0 + 8 * hi);
    float m = -1e30f, lsum = 0.f; f32x16 o0 = {}, o1 = {};
    bf16x8 kf[4]; v4u vr[4];
    { const int tk = ktok(0, q);
#pragma unroll
      for (int d0 = 0; d0 < 4; ++d0) kf[d0] = *(const bf16x8*)(P.K + (size_t)tk * DM + hcol + 16 * d0 + 8 * hi);
#pragma unroll
      for (int ii = 0; ii < 4; ++ii) { const int tv = ktok(0, 8 * ii + (lane >> 3)); vr[ii] = *(const v4u*)(P.V + (size_t)tv * DM + hcol + 8 * (lane & 7)); } }
    const int qp = (lane & 15) >> 2, pp = lane & 3, blk = (lane >> 4) & 1;
    LAS unsigned char* trbase = vbuf + (4 * hi + qp) * V_RS + 32 * blk + 8 * pp;
    for (int t = 0; t < ntiles; ++t) {
        bf16x8 kn[4]; v4u vn[4];
        if (t + 1 < ntiles) { const int tk = ktok(t + 1, q);
#pragma unroll
            for (int d0 = 0; d0 < 4; ++d0) kn[d0] = *(const bf16x8*)(P.K + (size_t)tk * DM + hcol + 16 * d0 + 8 * hi);
#pragma unroll
            for (int ii = 0; ii < 4; ++ii) { const int tv = ktok(t + 1, 8 * ii + (lane >> 3)); vn[ii] = *(const v4u*)(P.V + (size_t)tv * DM + hcol + 8 * (lane & 7)); } }
        else {
#pragma unroll
            for (int d0 = 0; d0 < 4; ++d0) { kn[d0] = kf[d0]; vn[d0] = vr[d0]; } }
        f32x16 s = {};
#pragma unroll
        for (int d0 = 0; d0 < 4; ++d0) s = __builtin_amdgcn_mfma_f32_32x32x16_bf16(kf[d0], qf[d0], s, 0, 0, 0);
        float mx = -INFINITY;
#pragma unroll
        for (int rr = 0; rr < 16; ++rr) {
            const int key = (rr & 3) + 8 * (rr >> 2) + 4 * hi;
            bool valid; float bias = 0.f;
            if (NT) { const int rp = t / 3, cc = t - 3 * rp + qhalf; const int kr = 2 * rp + (key >> 4), kc = 16 * cc + (key & 15);
                valid = (kc >= cs) && (kc < cs + 16);
                const int co = min(max(kc - c + 15, 0), 30);
                bias = rpbt[hN * 465 + (r0 + kr - r + 7) * 31 + co]; }
            else { const int j = i0 - 64 + 32 * t + key, dlt = q + 64 - 32 * t - key;
                valid = (j >= 0) && (j < L) && (dlt <= 64) && (dlt >= -64); }
            const float sv = valid ? s[rr] + bias : -INFINITY;
            s[rr] = sv; mx = fmaxf(mx, sv);
        }
        mx = fmaxf(mx, __shfl_xor(mx, 32));
        const float mnew = fmaxf(m, mx), alpha = __builtin_amdgcn_exp2f(m - mnew);
        float psum = 0.f;
#pragma unroll
        for (int rr = 0; rr < 16; ++rr) { const float p = __builtin_amdgcn_exp2f(s[rr] - mnew); s[rr] = p; psum += p; }
        lsum = lsum * alpha + psum; m = mnew;
#pragma unroll
        for (int rr = 0; rr < 16; ++rr) { o0[rr] *= alpha; o1[rr] *= alpha; }
        v4u pw0, pw1;
        pw0.x = cvtpk_s(s[0], s[1]); pw0.y = cvtpk_s(s[2], s[3]); pw0.z = cvtpk_s(s[4], s[5]); pw0.w = cvtpk_s(s[6], s[7]);
        pw1.x = cvtpk_s(s[8], s[9]); pw1.y = cvtpk_s(s[10], s[11]); pw1.z = cvtpk_s(s[12], s[13]); pw1.w = cvtpk_s(s[14], s[15]);
        const bf16x8 pf0 = __builtin_bit_cast(bf16x8, pw0), pf1 = __builtin_bit_cast(bf16x8, pw1);
#pragma unroll
        for (int ii = 0; ii < 4; ++ii) *(LAS v4u*)(vbuf + (8 * ii + (lane >> 3)) * V_RS + 16 * (lane & 7)) = vr[ii];
#pragma unroll
        for (int dblk = 0; dblk < 2; ++dblk) {
#pragma unroll
            for (int s2 = 0; s2 < 2; ++s2) {
                const s16x4 lo = __builtin_bit_cast(s16x4, __builtin_amdgcn_ds_read_tr16_b64_v4i16((LAS s16x4*)(trbase + (16 * s2) * V_RS + 64 * dblk)));
                const s16x4 hh = __builtin_bit_cast(s16x4, __builtin_amdgcn_ds_read_tr16_b64_v4i16((LAS s16x4*)(trbase + (16 * s2 + 8) * V_RS + 64 * dblk)));
                const bf16x8 vf = (bf16x8){lo[0], lo[1], lo[2], lo[3], hh[0], hh[1], hh[2], hh[3]};
                if (dblk == 0) o0 = __builtin_amdgcn_mfma_f32_32x32x16_bf16(vf, s2 == 0 ? pf0 : pf1, o0, 0, 0, 0);
                else           o1 = __builtin_amdgcn_mfma_f32_32x32x16_bf16(vf, s2 == 0 ? pf0 : pf1, o1, 0, 0, 0);
            }
        }
#pragma unroll
        for (int d0 = 0; d0 < 4; ++d0) { kf[d0] = kn[d0]; vr[d0] = vn[d0]; }
    }
    lsum += __shfl_xor(lsum, 32);
    const float inv = 1.f / lsum;
    bf16* orow;
    if (NT) orow = P.O + (size_t)qtok * DM + hcol;
    else { orow = P.OP + ((size_t)br * T + qtok) * 512 + hcol; if (hi == 0) P.LSE[((size_t)br * T + qtok) * 8 + hD] = m + __builtin_amdgcn_logf(lsum); }
#pragma unroll
    for (int g = 0; g < 4; ++g) {
        v2u w0, w1;
        w0.x = cvtpk_s(o0[4 * g] * inv, o0[4 * g + 1] * inv); w0.y = cvtpk_s(o0[4 * g + 2] * inv, o0[4 * g + 3] * inv);
        w1.x = cvtpk_s(o1[4 * g] * inv, o1[4 * g + 1] * inv); w1.y = cvtpk_s(o1[4 * g + 2] * inv, o1[4 * g + 3] * inv);
        *(v2u*)(orow + 8 * g + 4 * hi) = w0;
        *(v2u*)(orow + 32 + 8 * g + 4 * hi) = w1;
    }
}

__device__ __forceinline__ void phase_attention(const AttnP& P, const float* rpb, LAS unsigned char* lds, int gw, int NGW, int tid, int lane, int wave) {
    LAS float* rpbt = (LAS float*)(lds + RPB_OFF);
    for (int i = tid; i < 8 * 465; i += NWAVES * 64) rpbt[i] = rpb[i] * LOG2E;
    __syncthreads();
    LAS unsigned char* vbuf = lds + wave * V_TILE_BYTES;
    constexpr int NUNITS_N = BATCH * 8 * 128 * 2, NUNITS_D = 3 * BATCH * 8 * 256;
    { const int ch = (NUNITS_N + NGW - 1) / NGW; const int u1 = min((gw + 1) * ch, NUNITS_N);
      for (int u = gw * ch; u < u1; ++u) attn_unit<true>(P, u, vbuf, rpbt, lane); }
    { const int ch = (NUNITS_D + NGW - 1) / NGW; const int u1 = min((gw + 1) * ch, NUNITS_D);
      for (int u = gw * ch; u < u1; ++u) attn_unit<false>(P, u, vbuf, rpbt, lane); }
}

__device__ __forceinline__ void phase_merge(const bf16* OP, const float* LSE, bf16* O, int gtid, int NT_) {
    for (int idx = gtid; idx < T * 64; idx += NT_) {
        const int tok = idx >> 6, h = (idx >> 3) & 7, ch = idx & 7;
        const float l0 = LSE[(size_t)tok * 8 + h], l1 = LSE[((size_t)T + tok) * 8 + h], l2 = LSE[((size_t)2 * T + tok) * 8 + h];
        const float mx = fmaxf(l0, fmaxf(l1, l2));
        float w0 = __builtin_amdgcn_exp2f(l0 - mx), w1 = __builtin_amdgcn_exp2f(l1 - mx), w2 = __builtin_amdgcn_exp2f(l2 - mx);
        const float inv = 1.f / (w0 + w1 + w2); w0 *= inv; w1 *= inv; w2 *= inv;
        const size_t po = (size_t)tok * 512 + 64 * h + 8 * ch;
        const v4u a = *(const v4u*)(OP + po), b = *(const v4u*)(OP + (size_t)T * 512 + po), c = *(const v4u*)(OP + (size_t)2 * T * 512 + po);
        v4u o;
#pragma unroll
        for (int k = 0; k < 4; ++k) {
            const float lo = w0 * bf_lo(a[k]) + w1 * bf_lo(b[k]) + w2 * bf_lo(c[k]);
            const float hi = w0 * bf_hi(a[k]) + w1 * bf_hi(b[k]) + w2 * bf_hi(c[k]);
            o[k] = cvtpk_s(lo, hi);
        }
        *(v4u*)(O + (size_t)tok * DM + 64 * h + 8 * ch) = o;
    }
}

__device__ __forceinline__ void phase_pool(const float* X, bf16* U, int gtid, int NT_) {
    for (int idx = gtid; idx < (T / 32) * 256; idx += NT_) {
        const int tch = idx >> 8, cc = idx & 255, b = tch >> 8, s0 = (tch & 255) * 32, half = 1 << (cc >> 6);
        const float* xb = X + (size_t)b * SEQ * DM + 4 * cc;
        bf16* ub = U + (size_t)b * SEQ * DM + 4 * cc;
        f32x4 sum = {0.f, 0.f, 0.f, 0.f};
        for (int u = s0 - half; u < s0 + half; ++u) if (u >= 0 && u < SEQ) sum += *(const f32x4*)(xb + (size_t)u * DM);
        for (int t = s0; t < s0 + 32; ++t) {
            const int lo = max(t - half, 0), hi = min(t + half, SEQ);
            const float rc = 1.f / (float)(hi - lo);
            const f32x4 xv = *(const f32x4*)(xb + (size_t)t * DM);
            const f32x4 uv = sum * rc - xv;
            v2u w; w.x = cvtpk_s(uv[0], uv[1]); w.y = cvtpk_s(uv[2], uv[3]);
            *(v2u*)(ub + (size_t)t * DM) = w;
            if (t + half < SEQ) sum += *(const f32x4*)(xb + (size_t)(t + half) * DM);
            if (t - half >= 0) sum -= *(const f32x4*)(xb + (size_t)(t - half) * DM);
        }
    }
}

__device__ __forceinline__ void ln_row(f32x4 (&v)[4], const float* g, const float* bta, int lane) {
    float s = 0.f;
#pragma unroll
    for (int j = 0; j < 4; ++j) s += (v[j][0] + v[j][1]) + (v[j][2] + v[j][3]);
    const float mean = wave_sum(s) * (1.f / DM); float s2 = 0.f;
#pragma unroll
    for (int j = 0; j < 4; ++j) { v[j] = v[j] - mean; s2 += (v[j][0] * v[j][0] + v[j][1] * v[j][1]) + (v[j][2] * v[j][2] + v[j][3] * v[j][3]); }
    const float rstd = 1.f / sqrtf(wave_sum(s2) * (1.f / DM) + LN_EPS);
#pragma unroll
    for (int j = 0; j < 4; ++j) { const f32x4 gg = *(const f32x4*)(g + 4 * lane + 256 * j), bb = *(const f32x4*)(bta + 4 * lane + 256 * j); v[j] = v[j] * rstd * gg + bb; }
}
__device__ __forceinline__ void store_row(const f32x4 (&v)[4], float* X, bf16* XB, size_t tok, int lane) {
    GAS f32x4* xo = (GAS f32x4*)(X + tok * DM) + lane;
    GAS unsigned long long* bo = (GAS unsigned long long*)(XB + tok * DM) + lane;
#pragma unroll
    for (int j = 0; j < 4; ++j) { xo[64 * j] = v[j]; bo[64 * j] = (unsigned long long)cvtpk_s(v[j][0], v[j][1]) | ((unsigned long long)cvtpk_s(v[j][2], v[j][3]) << 32); }
}

__device__ __forceinline__ float reduce16(float (&v)[16], int lane) {
#pragma unroll
    for (int i = 0; i < 8; ++i) { const bool up = lane & 32; const float send = up ? v[i] : v[i + 8], keep = up ? v[i + 8] : v[i]; v[i] = keep + __shfl_xor(send, 32); }
#pragma unroll
    for (int i = 0; i < 4; ++i) { const bool up = lane & 16; const float send = up ? v[i] : v[i + 4], keep = up ? v[i + 4] : v[i]; v[i] = keep + __shfl_xor(send, 16); }
#pragma unroll
    for (int i = 0; i < 2; ++i) { const bool up = lane & 8; const float send = up ? v[i] : v[i + 2], keep = up ? v[i + 2] : v[i]; v[i] = keep + __shfl_xor(send, 8); }
    { const bool up = lane & 4; const float send = up ? v[0] : v[1], keep = up ? v[1] : v[0]; v[0] = keep + __shfl_xor(send, 4); }
    v[0] += __shfl_xor(v[0], 2); v[0] += __shfl_xor(v[0], 1);
    return v[0];
}

struct TokTabs { int* e; float* g; int* rank; int* pos; };

__device__ __forceinline__ void route_token(const float (&lg)[16], const float* rbias, size_t tok, int tl, const TokTabs& TT, LAS int* lcnt, LAS int* tinfo, int lane) {
    float aff[16], sel[16];
#pragma unroll
    for (int e = 0; e < 16; ++e) { aff[e] = 1.f / (1.f + expf(-lg[e])); sel[e] = aff[e] + rbias[e]; }
    float gs[4];
#pragma unroll
    for (int g = 0; g < 4; ++g) { const float a = sel[4 * g], b = sel[4 * g + 1], c = sel[4 * g + 2], d = sel[4 * g + 3];
        const float h1 = fmaxf(a, b), l1 = fminf(a, b), h2 = fmaxf(c, d), l2 = fminf(c, d);
        gs[g] = fmaxf(h1, h2) + fmaxf(fminf(h1, h2), fmaxf(l1, l2)); }
    int grp = 0; float best = gs[0];
#pragma unroll
    for (int g = 1; g < 4; ++g) if (gs[g] > best) { best = gs[g]; grp = g; }
    float sg[4], ag[4];
#pragma unroll
    for (int k = 0; k < 4; ++k) { sg[k] = grp == 0 ? sel[k] : grp == 1 ? sel[4 + k] : grp == 2 ? sel[8 + k] : sel[12 + k]; ag[k] = grp == 0 ? aff[k] : grp == 1 ? aff[4 + k] : grp == 2 ? aff[8 + k] : aff[12 + k]; }
    int i1 = 0; float b1 = sg[0];
#pragma unroll
    for (int k = 1; k < 4; ++k) if (sg[k] > b1) { b1 = sg[k]; i1 = k; }
    int i2 = -1; float b2 = -INFINITY;
#pragma unroll
    for (int k = 0; k < 4; ++k) if (k != i1 && (i2 < 0 || sg[k] > b2)) { b2 = sg[k]; i2 = k; }
    const float a1 = i1 == 0 ? ag[0] : i1 == 1 ? ag[1] : i1 == 2 ? ag[2] : ag[3];
    const float a2 = i2 == 0 ? ag[0] : i2 == 1 ? ag[1] : i2 == 2 ? ag[2] : ag[3];
    const float den = a1 + a2;
    if (lane == 0) {
        const int e1 = grp * 4 + i1, e2 = grp * 4 + i2;
        const int r1 = __hip_atomic_fetch_add(lcnt + e1, 1, __ATOMIC_RELAXED, __HIP_MEMORY_SCOPE_WORKGROUP);
        const int r2 = __hip_atomic_fetch_add(lcnt + e2, 1, __ATOMIC_RELAXED, __HIP_MEMORY_SCOPE_WORKGROUP);
        tinfo[tl * 4 + 0] = e1; tinfo[tl * 4 + 1] = r1; tinfo[tl * 4 + 2] = e2; tinfo[tl * 4 + 3] = r2;
        TT.e[tok * 2] = e1; TT.e[tok * 2 + 1] = e2; TT.g[tok * 2] = a1 / den; TT.g[tok * 2 + 1] = a2 / den;
    }
}

__device__ __forceinline__ void phase_lnr(const float* Y, float* X, bf16* XB, const float* g, const float* bta, const float* router_w, const float* rbias_g,
                                          const TokTabs& TT, gu32* cnt, LAS unsigned char* lds, int tid, int lane, int wave) {
    LAS float* rw = (LAS float*)lds;
    LAS int* lcnt = (LAS int*)(lds + 65536); LAS int* lbase = lcnt + 16; LAS int* tinfo = lcnt + 32;
    for (int idx = tid; idx < DM * 16; idx += NWAVES * 64) { const int col = idx >> 4, e = idx & 15, j = col >> 8, l = (col & 255) >> 2, c = col & 3;
        rw[((((j * 4 + c) * 4 + (e >> 2)) * 64 + l) << 2) + (e & 3)] = router_w[idx]; }
    float rbias[16];
#pragma unroll
    for (int e = 0; e < 16; ++e) rbias[e] = rbias_g[e];
    for (int chunk = blockIdx.x; chunk < T / 128; chunk += gridDim.x) {
        __syncthreads();
        if (tid < 16) lcnt[tid] = 0;
        __syncthreads();
        for (int pass = 0; pass < 8; ++pass) {
            const int tl0 = wave * 16 + 2 * pass; const size_t tok0 = (size_t)chunk * 128 + tl0;
            f32x4 va[4], vb[4];
#pragma unroll
            for (int j = 0; j < 4; ++j) { va[j] = *((const GAS f32x4*)(Y + tok0 * DM) + lane + 64 * j); vb[j] = *((const GAS f32x4*)(Y + (tok0 + 1) * DM) + lane + 64 * j); }
            ln_row(va, g, bta, lane); ln_row(vb, g, bta, lane);
            store_row(va, X, XB, tok0, lane); store_row(vb, X, XB, tok0 + 1, lane);
            float pa[16], pb[16];
#pragma unroll
            for (int e = 0; e < 16; ++e) { pa[e] = 0.f; pb[e] = 0.f; }
#pragma unroll
            for (int j = 0; j < 4; ++j)
#pragma unroll
                for (int c = 0; c < 4; ++c)
#pragma unroll
                    for (int e4 = 0; e4 < 4; ++e4) {
                        const f32x4 w = *(const LAS f32x4*)(rw + ((((j * 4 + c) * 4 + e4) * 64 + lane) << 2));
                        const float xa = va[j][c], xb = vb[j][c];
#pragma unroll
                        for (int ee = 0; ee < 4; ++ee) { pa[4 * e4 + ee] += xa * w[ee]; pb[4 * e4 + ee] += xb * w[ee]; }
                    }
            const float ra = reduce16(pa, lane), rb = reduce16(pb, lane);
            float lga[16], lgb[16];
#pragma unroll
            for (int e = 0; e < 16; ++e) { lga[e] = __builtin_bit_cast(float, __builtin_amdgcn_readlane(__builtin_bit_cast(int, ra), 4 * e)); lgb[e] = __builtin_bit_cast(float, __builtin_amdgcn_readlane(__builtin_bit_cast(int, rb), 4 * e)); }
            route_token(lga, rbias, tok0, tl0, TT, lcnt, tinfo, lane);
            route_token(lgb, rbias, tok0 + 1, tl0 + 1, TT, lcnt, tinfo, lane);
        }
        __syncthreads();
        if (tid < 16) lbase[tid] = (int)__hip_atomic_fetch_add(cnt + 64 * tid, (unsigned)lcnt[tid], RLX_AGENT);
        __syncthreads();
        if (tid < 256) { const int tl = tid >> 1, k = tid & 1; const int e = tinfo[tl * 4 + 2 * k], lr = tinfo[tl * 4 + 2 * k + 1];
            TT.rank[((size_t)chunk * 128 + tl) * 2 + k] = lbase[e] + lr; }
    }
    __syncthreads();
}

__device__ __forceinline__ int build_expert_tables(const gu32* cnt, LAS int* pstart, LAS unsigned char* texp, LAS int* ntl, int tid) {
    __syncthreads();
    if (tid == 0) {
        int acc = 0;
        for (int e = 0; e < NEXP; ++e) { const int c = (int)__hip_atomic_load(cnt + 64 * e, RLX_AGENT); const int nt = (c + 255) >> 8; pstart[e] = acc * 256; for (int i = 0; i < nt; ++i) texp[acc + i] = (unsigned char)e; acc += nt; }
        *ntl = acc;
    }
    __syncthreads();
    return *ntl;
}

__device__ __forceinline__ void phase_scatter(const bf16* XB, bf16* XS, const TokTabs& TT, const LAS int* pstart, int gw, int NGW, int lane) {
    for (int tok = gw; tok < T; tok += NGW) {
        const int e0 = TT.e[tok * 2], e1 = TT.e[tok * 2 + 1];
        const int p0 = pstart[e0] + TT.rank[tok * 2], p1 = pstart[e1] + TT.rank[tok * 2 + 1];
        const GAS v4u* src = (const GAS v4u*)(XB + (size_t)tok * DM) + lane;
        const v4u a = src[0], b = src[64];
        GAS v4u* d0 = (GAS v4u*)(XS + (size_t)p0 * DM) + lane; GAS v4u* d1 = (GAS v4u*)(XS + (size_t)p1 * DM) + lane;
        d0[0] = a; d0[64] = b; d1[0] = a; d1[64] = b;
        if (lane == 0) { TT.pos[tok * 2] = p0; TT.pos[tok * 2 + 1] = p1; }
    }
}

__device__ __forceinline__ void phase_combine(float* X, bf16* XB, const bf16* YB, const TokTabs& TT, const float* g, const float* bta, int gw, int NGW, int lane) {
    for (int tok = gw; tok < T; tok += NGW) {
        const int p0 = TT.pos[tok * 2], p1 = TT.pos[tok * 2 + 1]; const float g0 = TT.g[tok * 2], g1 = TT.g[tok * 2 + 1];
        const GAS f32x4* xr = (const GAS f32x4*)(X + (size_t)tok * DM) + lane;
        const GAS v2u* y0 = (const GAS v2u*)(YB + (size_t)p0 * DM) + lane; const GAS v2u* y1 = (const GAS v2u*)(YB + (size_t)p1 * DM) + lane;
        f32x4 v[4];
#pragma unroll
        for (int j = 0; j < 4; ++j) { const f32x4 xv = xr[64 * j]; const v2u a = y0[64 * j], b = y1[64 * j];
            v[j][0] = xv[0] * ALPHA + g0 * bf_lo(a.x) + g1 * bf_lo(b.x); v[j][1] = xv[1] * ALPHA + g0 * bf_hi(a.x) + g1 * bf_hi(b.x);
            v[j][2] = xv[2] * ALPHA + g0 * bf_lo(a.y) + g1 * bf_lo(b.y); v[j][3] = xv[3] * ALPHA + g0 * bf_hi(a.y) + g1 * bf_hi(b.y); }
        ln_row(v, g, bta, lane);
        store_row(v, X, XB, (size_t)tok, lane);
    }
}

constexpr int PSTART_OFF = RING_BYTES + 1536, NTL_OFF = RING_BYTES + 1600;
struct Args { InPtrs in; float* out; unsigned char* ws; int layer, pad; };

template <int SLOT>
__device__ __forceinline__ void do_slot(const Args& args, int layer, LAS unsigned char* lds) {
    int tidL = threadIdx.x; asm volatile("" : "+v"(tidL));
    const int tid = tidL, lane = tidL & 63, wave = __builtin_amdgcn_readfirstlane(tidL >> 6);
    const int G = gridDim.x, gw = blockIdx.x * NWAVES + wave, NGW = G * NWAVES, gtid = blockIdx.x * (NWAVES * 64) + tidL, NTH = G * NWAVES * 64;
    unsigned char* ws = args.ws; asm volatile("" : "+s"(ws));
    float* X = args.out; asm volatile("" : "+s"(X));
    const int i2 = layer >> 1;
    TokTabs TT; TT.e = (int*)(ws + WS_TOK); TT.g = (float*)(ws + WS_TOK + 262144); TT.rank = (int*)(ws + WS_TOK + 2 * 262144); TT.pos = (int*)(ws + WS_TOK + 3 * 262144);
    gu32* cnt = (gu32*)(ws + WS_CTL) + CW_CNT + layer * 16 * 64;
    bf16* XB = (bf16*)(ws + WS_XB); float* Y = (float*)(ws + WS_Y);
    bf16* Qb = (bf16*)(ws + WS_Q); bf16* Kb = (bf16*)(ws + WS_K); bf16* Vb = (bf16*)(ws + WS_V); bf16* Ob = (bf16*)(ws + WS_O);
    bf16* OP = (bf16*)(ws + WS_OP); float* LSE = (float*)(ws + WS_LSE);
    bf16* Ub = (bf16*)(ws + WS_U); bf16* XS = (bf16*)(ws + WS_XS); bf16* Hb = (bf16*)(ws + WS_H);
    const float* cosT = (const float*)(ws + WS_ROPE); const float* sinT = cosT + SEQ * 32;
    const float* SMp = (const float*)(ws + WS_SMALL);
    LAS int* pstart = (LAS int*)(lds + PSTART_OFF); LAS unsigned char* texp = lds + TEXP_OFF; LAS int* ntl = (LAS int*)(lds + NTL_OFF);
    (void)tid; (void)lane; (void)gw; (void)NGW; (void)gtid; (void)NTH; (void)i2; (void)TT; (void)cnt; (void)XB; (void)Y; (void)Qb; (void)Kb; (void)Vb; (void)Ob; (void)OP; (void)LSE; (void)Ub; (void)XS; (void)Hb;
    (void)cosT; (void)sinT; (void)SMp; (void)pstart; (void)texp; (void)ntl; (void)X;

    if constexpr (SLOT == 0) { phase_prologue(args.in, ws, lds, gw, NGW, lane, wave, gtid, NTH); }
    if constexpr (SLOT == 1) {
        Sched S{T / 256, 12, (T / 256) * 12, G, (int)blockIdx.x, (const char*)XB, (const char*)(ws + WS_WQKV) + (size_t)i2 * 3072 * DM * 2, (size_t)256 * DM * 2, 0, (size_t)256 * DM * 2, 0, nullptr};
        EpiQKV E{Qb, (size_t)(WS_K - WS_Q) / 2, cosT, sinT};
        pg8::gemm_phase<EpiQKV, Sched, true>(lds, pg8::Gemm{DM, DM, DM}, S, E);
    }
    if constexpr (SLOT == 2) {
        AttnP P{Qb, Kb, Vb, Ob, OP, LSE};
        phase_attention(P, SMp + SM_RPB + (size_t)i2 * 8 * 465, lds, gw, NGW, tid, lane, wave);
    }
    if constexpr (SLOT == 3) { phase_merge(OP, LSE, Ob, gtid, NTH); }
    if constexpr (SLOT == 4) {
        Sched S{T / 256, 4, (T / 256) * 4, G, (int)blockIdx.x, (const char*)Ob, (const char*)(ws + WS_WO) + (size_t)i2 * DM * DM * 2, (size_t)256 * DM * 2, 0, (size_t)256 * DM * 2, 0, nullptr};
        EpiRes E{layer == 0 ? args.in.x : (const float*)X, Y, nullptr};
        pg8::gemm_phase<EpiRes, Sched, true>(lds, pg8::Gemm{DM, DM, DM}, S, E);
    }
    if constexpr (SLOT == 5) { phase_pool(X, Ub, gtid, NTH); }
    if constexpr (SLOT == 6) {
        Sched S{T / 256, 4, (T / 256) * 4, G, (int)blockIdx.x, (const char*)Ub, (const char*)(ws + WS_WP) + (size_t)i2 * 4 * 65536 * 2, (size_t)256 * DM * 2, (size_t)512, (size_t)65536 * 2, 0, nullptr};
        EpiRes E{(const float*)X, Y, SMp + SM_PSC + (size_t)i2 * DM};
        pg8::gemm_phase<EpiRes, Sched, true>(lds, pg8::Gemm{DM, 256, 256}, S, E);
    }
    if constexpr (SLOT == 7) {
        phase_lnr(Y, X, XB, SMp + SM_LNG + (size_t)(layer * 2) * DM, SMp + SM_LNB + (size_t)(layer * 2) * DM, SMp + SM_RW, SMp + SM_RB, TT, cnt, lds, tid, lane, wave);
    }
    if constexpr (SLOT == 8) {
        (void)build_expert_tables(cnt, pstart, texp, ntl, tid);
        phase_scatter(XB, XS, TT, pstart, gw, NGW, lane);
    }
    if constexpr (SLOT == 9) {
        const int ntiles = build_expert_tables(cnt, pstart, texp, ntl, tid);
        Sched S{ntiles, 8, ntiles * 8, G, (int)blockIdx.x, (const char*)XS, (const char*)(ws + WS_W13) + (size_t)layer * NEXP * 2048 * DM * 2, (size_t)256 * DM * 2, 0, (size_t)256 * DM * 2, (size_t)2048 * DM * 2, texp};
        EpiSwiGLU E{Hb};
        pg8::gemm_phase<EpiSwiGLU, Sched, true>(lds, pg8::Gemm{DM, DM, DM}, S, E);
    }
    if constexpr (SLOT == 10) {
        const int ntiles = build_expert_tables(cnt, pstart, texp, ntl, tid);
        Sched S{ntiles, 4, ntiles * 4, G, (int)blockIdx.x, (const char*)Hb, (const char*)(ws + WS_W2) + (size_t)layer * NEXP * DM * DM * 2, (size_t)256 * DM * 2, 0, (size_t)256 * DM * 2, (size_t)DM * DM * 2, texp};
        EpiBf16 E{XS};
        pg8::gemm_phase<EpiBf16, Sched, true>(lds, pg8::Gemm{DM, DM, DM}, S, E);
    }
    if constexpr (SLOT == 11) {
        phase_combine(X, XB, XS, TT, SMp + SM_LNG + (size_t)(layer * 2 + 1) * DM, SMp + SM_LNB + (size_t)(layer * 2 + 1) * DM, gw, NGW, lane);
    }
}

#if MK_MULTI_LAUNCH
template <int SLOT>
__global__ void __launch_bounds__(NWAVES * 64, 2) k_slot(Args args) {
    extern __shared__ __attribute__((aligned(16))) unsigned char lds_raw[];
    LAS unsigned char* lds = (LAS unsigned char*)lds_raw;
    for (int u = threadIdx.x; u < (LDS_BYTES - RING_BYTES) / 4; u += NWAVES * 64) ((LAS unsigned*)(lds + RING_BYTES))[u] = 0u;
    __syncthreads();
    do_slot<SLOT>(args, args.layer, lds);
}
template <int SLOT> static void launch_slot(const Args& a, int grid, hipStream_t stream) {
    static bool attr_set = false;
    if (!attr_set) { (void)hipFuncSetAttribute((const void*)k_slot<SLOT>, hipFuncAttributeMaxDynamicSharedMemorySize, LDS_BYTES); attr_set = true; }
    hipLaunchKernelGGL(k_slot<SLOT>, dim3(grid), dim3(NWAVES * 64), LDS_BYTES, stream, a);
}
#else
__global__ void __launch_bounds__(NWAVES * 64, 2) fwd(Args args) {
    extern __shared__ __attribute__((aligned(16))) unsigned char lds_raw[];
    LAS unsigned char* lds = (LAS unsigned char*)lds_raw;
    volatile LAS unsigned* MISC = (volatile LAS unsigned*)(lds + MISC_OFF);
    for (int u = threadIdx.x; u < (LDS_BYTES - RING_BYTES) / 4; u += NWAVES * 64) ((LAS unsigned*)(lds + RING_BYTES))[u] = 0u;
    __syncthreads();
    const XcdBarrier bar = xcd_barrier_post((unsigned*)((gu32*)(args.ws + WS_CTL) + CW_BAR), MISC + 8);
    do_slot<0>(args, 0, lds);
    for (int layer = 0; layer < DEPTH; ++layer) {
        if ((layer & 1) == 0) {
            xcd_barrier(bar); do_slot<1>(args, layer, lds);
            xcd_barrier(bar); do_slot<2>(args, layer, lds);
            xcd_barrier(bar); do_slot<3>(args, layer, lds);
            xcd_barrier(bar); do_slot<4>(args, layer, lds);
        } else {
            xcd_barrier(bar); do_slot<5>(args, layer, lds);
            xcd_barrier(bar); do_slot<6>(args, layer, lds);
        }
        xcd_barrier(bar); do_slot<7>(args, layer, lds);
        xcd_barrier(bar); do_slot<8>(args, layer, lds);
        xcd_barrier(bar); do_slot<9>(args, layer, lds);
        xcd_barrier(bar); do_slot<10>(args, layer, lds);
        xcd_barrier(bar); do_slot<11>(args, layer, lds);
    }
}
#endif

extern "C" void kernel_launch(void* const* d_in, const int* in_sizes, int n_in, void* d_out, int out_size, void* d_ws, size_t ws_size, hipStream_t stream) {
    static int grid = 0;
    if (grid == 0) {
        if (n_in != 13 || in_sizes[0] != T * DM || out_size != T * DM || ws_size < WS_END) {
            fprintf(stderr, "kernel_launch: unexpected shapes (n_in %d, in0 %d, out %d, ws %zu; need ws >= %zu); nothing launched\n", n_in, n_in > 0 ? in_sizes[0] : -1, out_size, ws_size, (size_t)WS_END); grid = -1; return; }
        int dev = 0, cus = 0;
        if (hipGetDevice(&dev) != hipSuccess || hipDeviceGetAttribute(&cus, hipDeviceAttributeMultiprocessorCount, dev) != hipSuccess) { fprintf(stderr, "kernel_launch: device query failed\n"); grid = -1; return; }
#if !MK_MULTI_LAUNCH
        int per_cu = 0;
        if (hipFuncSetAttribute((const void*)fwd, hipFuncAttributeMaxDynamicSharedMemorySize, LDS_BYTES) != hipSuccess) { fprintf(stderr, "kernel_launch: hipFuncSetAttribute failed\n"); grid = -1; return; }
        if (hipOccupancyMaxActiveBlocksPerMultiprocessor(&per_cu, (const void*)fwd, NWAVES * 64, LDS_BYTES) != hipSuccess || per_cu < 1)
            fprintf(stderr, "kernel_launch: note: occupancy query reports %d workgroups per CU\n", per_cu);
        (void)hipGetLastError();
#endif
        grid = cus;
    }
    if (grid < 0) return;
    if (hipMemsetAsync((char*)d_ws + WS_CTL, 0, CTL_ZERO_BYTES, stream) != hipSuccess) { fprintf(stderr, "kernel_launch: memset failed\n"); return; }
    Args a{};
    const float** ip = (const float**)&a.in;
    for (int i = 0; i < 13; ++i) ip[i] = (const float*)d_in[i];
    a.out = (float*)d_out; a.ws = (unsigned char*)d_ws; a.layer = 0; a.pad = 0;
#if MK_MULTI_LAUNCH
    launch_slot<0>(a, grid, stream);
    for (int layer = 0; layer < DEPTH; ++layer) {
        a.layer = layer;
        if ((layer & 1) == 0) { launch_slot<1>(a, grid, stream); launch_slot<2>(a, grid, stream); launch_slot<3>(a, grid, stream); launch_slot<4>(a, grid, stream); }
        else { launch_slot<5>(a, grid, stream); launch_slot<6>(a, grid, stream); }
        launch_slot<7>(a, grid, stream); launch_slot<8>(a, grid, stream); launch_slot<9>(a, grid, stream); launch_slot<10>(a, grid, stream); launch_slot<11>(a, grid, stream);
    }
#else
    hipLaunchKernelGGL(fwd, dim3(grid), dim3(NWAVES * 64), LDS_BYTES, stream, a);
#endif
    const hipError_t le = hipPeekAtLastError();
    if (le != hipSuccess) fprintf(stderr, "kernel_launch: launch failed: %s\n", hipGetErrorName(le));
}
```

```cpp
#include <hip/hip_runtime.h>
#include <cstdio>
#include <cstdint>
#include <cmath>

#ifndef MK_MULTI_LAUNCH
#define MK_MULTI_LAUNCH 0
#endif

namespace pg8 {
#define PG8_LAS __attribute__((address_space(3)))
typedef unsigned short bf16_t;
typedef short bf16x8 __attribute__((ext_vector_type(8)));
typedef float f32x4 __attribute__((ext_vector_type(4)));
typedef unsigned u32x4 __attribute__((ext_vector_type(4)));
constexpr int BM = 256, BK = 64, HALF = 128, HTB = HALF * BK * 2  , STAGE_BYTES = 8 * HTB, NXCD = 8, WGM = 8;

__host__ __device__ __forceinline__ int lds_byte(int r, int c) { const int st = (r >> 4) * 2 + (c >> 5), rr = r & 15, cc = c & 31, ob = rr * 64 + cc * 2; return st * 1024 + (ob ^ (((ob >> 9) & 1) << 5)); }
__host__ __device__ __forceinline__ void stage_rc(int b, int& R, int& C) { const int st = b / 1024, sb = b % 1024, swz = sb ^ (((sb >> 9) & 1) << 5); R = (st >> 1) * 16 + swz / 64; C = (st & 1) * 32 + (swz % 64) / 2; }
__host__ __device__ __forceinline__ int perm32(int rho) { const int n = rho >> 4, i = rho & 15; return 8 * (i >> 2) + 4 * n + (i & 3); }

struct Unit { int pm, pn; };
struct Gemm { int lda, ldb, K; };

__device__ __forceinline__ unsigned cvt_pk_bf16(float lo, float hi) { unsigned r; asm volatile("v_cvt_pk_bf16_f32 %0, %1, %2" : "=v"(r) : "v"(lo), "v"(hi)); return r; }

template <class Epi, class Sched, bool ALIGN_EPI>
__device__ __forceinline__ void gemm_phase(PG8_LAS unsigned char* lds, const Gemm g, const Sched& S, const Epi& E) {
    int tid_ = threadIdx.x; asm volatile("" : "+v"(tid_));
    const int tid = tid_, wid = __builtin_amdgcn_readfirstlane(tid >> 6), lane = tid & 63, wr = wid >> 2, wc = wid & 3, fr = lane & 15, fq = lane >> 4;
    const int K = g.K, nt = K / BK;
    unsigned voffA[2], voffB[2];
#pragma unroll
    for (int i = 0; i < 2; ++i) { int R, C; stage_rc(tid * 16 + i * 8192, R, C); const int Rb = 64 * (R >> 5) + perm32(R & 31);
        voffA[i] = (unsigned)(R * g.lda + C) * 2u; voffB[i] = (unsigned)(Rb * g.ldb + C) * 2u; }
    const size_t kstep = (size_t)(BK * 2);
    const size_t hstepA = (size_t)HALF * g.lda * 2;
    const size_t hstepB = (size_t)32 * g.ldb * 2;
    const unsigned ldsw = (unsigned)wid * 1024u;
    const int aoff = lds_byte(wr * 64 + fr, fq * 8), boff = lds_byte(wc * 32 + fr, fq * 8);
#define PG8_SA(b, h) (((b) * 2 + (h)) * HTB)
#define PG8_SB(b, h) ((4 + (b) * 2 + (h)) * HTB)
#define PG8_STAGE(bufoff, gbase, voff) do { _Pragma("unroll") for (int _i = 0; _i < 2; ++_i) \
        __builtin_amdgcn_global_load_lds((const unsigned*)((const char*)(gbase) + (voff)[_i]), (PG8_LAS unsigned*)(lds + (bufoff) + ldsw + _i * 8192), 16, 0, 0); } while (0)
#define PG8_LDA(dst, b, h) do { _Pragma("unroll") for (int m = 0; m < 4; ++m) _Pragma("unroll") for (int k = 0; k < 2; ++k) dst[m][k] = *(const PG8_LAS bf16x8*)(lds + PG8_SA(b, h) + aoff + m * 2048 + k * 1024); } while (0)
#define PG8_LDB(dst, b, h) do { _Pragma("unroll") for (int n = 0; n < 2; ++n) _Pragma("unroll") for (int k = 0; k < 2; ++k) dst[n][k] = *(const PG8_LAS bf16x8*)(lds + PG8_SB(b, h) + boff + n * 2048 + k * 1024); } while (0)
#define PG8_MMA(ai, bj, At, Bt) do { __builtin_amdgcn_s_setprio(1); _Pragma("unroll") for (int m = 0; m < 4; ++m) _Pragma("unroll") for (int n = 0; n < 2; ++n) _Pragma("unroll") for (int k = 0; k < 2; ++k) \
        acc[ai][bj][m][n] = __builtin_amdgcn_mfma_f32_16x16x32_bf16(Bt[n][k], At[m][k], acc[ai][bj][m][n], 0, 0, 0); __builtin_amdgcn_s_setprio(0); } while (0)
#define PG8_WAIT_V(n) asm volatile("s_waitcnt vmcnt(" #n ")" ::: "memory")
#define PG8_WAIT_L(n) asm volatile("s_waitcnt lgkmcnt(" #n ")" ::: "memory")
#define PG8_BAR __builtin_amdgcn_s_barrier()
#define PG8_SCHED __builtin_amdgcn_sched_barrier(0)
    Unit cur, nxt; int ui = 0;
    const char* cA; const char* cB; const char* nA; const char* nB;
    if (!S.next(0, cur.pm, cur.pn, cA, cB)) return;
    f32x4 acc[2][2][4][2];
#pragma unroll
    for (int a = 0; a < 2; ++a)
#pragma unroll
        for (int b = 0; b < 2; ++b)
#pragma unroll
            for (int m = 0; m < 4; ++m)
#pragma unroll
                for (int n = 0; n < 2; ++n) acc[a][b][m][n] = (f32x4){0.f, 0.f, 0.f, 0.f};
    bf16x8 At[4][2], B0[2][2], B1[2][2];
    PG8_STAGE(PG8_SB(0, 0), cB, voffB); PG8_STAGE(PG8_SB(0, 1), cB + hstepB, voffB); PG8_STAGE(PG8_SA(0, 0), cA, voffA); PG8_STAGE(PG8_SA(0, 1), cA + hstepA, voffA);
    if (wr == 1) PG8_BAR;
    PG8_WAIT_V(2); PG8_BAR;
    PG8_STAGE(PG8_SB(1, 0), cB + kstep, voffB); PG8_STAGE(PG8_SA(1, 0), cA + kstep, voffA); PG8_STAGE(PG8_SB(1, 1), cB + hstepB + kstep, voffB);
    PG8_WAIT_V(6); PG8_BAR;
    for (;;) {
        const bool has_next = S.next(ui + 1, nxt.pm, nxt.pn, nA, nB);
        if (!has_next) { nA = cA; nB = cB; }
        for (int t = 0; t < nt; t += 2) {
            const bool last = (t == nt - 2);
            const char* a1 = cA + (size_t)(t + 1) * kstep;
            const char* a2 = last ? nA : cA + (size_t)(t + 2) * kstep; const char* b2 = last ? nB : cB + (size_t)(t + 2) * kstep;
            const char* a3 = a2 + kstep; const char* b3 = b2 + kstep;
            PG8_LDB(B0, 0, 0); PG8_LDB(B1, 0, 1); PG8_SCHED; PG8_LDA(At, 0, 0); PG8_STAGE(PG8_SA(1, 1), a1 + hstepA, voffA);
            PG8_WAIT_V(8); PG8_WAIT_L(0); PG8_BAR; PG8_MMA(0, 0, At, B0); PG8_MMA(0, 1, At, B1); PG8_BAR; PG8_SCHED;
            PG8_LDA(At, 0, 1); PG8_STAGE(PG8_SB(0, 0), b2, voffB); PG8_STAGE(PG8_SB(0, 1), b2 + hstepB, voffB); PG8_STAGE(PG8_SA(0, 0), a2, voffA);
            PG8_WAIT_V(8); PG8_WAIT_L(0); PG8_BAR; PG8_MMA(1, 0, At, B0); PG8_MMA(1, 1, At, B1); PG8_BAR; PG8_SCHED;
            PG8_LDB(B0, 1, 0); PG8_LDB(B1, 1, 1); PG8_SCHED; PG8_LDA(At, 1, 0); PG8_STAGE(PG8_SA(0, 1), a2 + hstepA, voffA);
            PG8_WAIT_V(8); PG8_WAIT_L(0); PG8_BAR; PG8_MMA(0, 0, At, B0); PG8_MMA(0, 1, At, B1); PG8_BAR; PG8_SCHED;
            PG8_LDA(At, 1, 1); PG8_STAGE(PG8_SB(1, 0), b3, voffB); PG8_STAGE(PG8_SB(1, 1), b3 + hstepB, voffB); PG8_STAGE(PG8_SA(1, 0), a3, voffA);
            PG8_WAIT_V(8); PG8_WAIT_L(0); PG8_BAR; PG8_MMA(1, 0, At, B0); PG8_MMA(1, 1, At, B1); PG8_BAR; PG8_SCHED;
        }
        if constexpr (ALIGN_EPI) { if (wr == 0) PG8_BAR; }
        E(acc, cur, wr, wc, fr, fq);
        if (!has_next) break;
#pragma unroll
        for (int a = 0; a < 2; ++a)
#pragma unroll
            for (int b = 0; b < 2; ++b)
#pragma unroll
                for (int m = 0; m < 4; ++m)
#pragma unroll
                    for (int n = 0; n < 2; ++n) acc[a][b][m][n] = (f32x4){0.f, 0.f, 0.f, 0.f};
        cur.pm = nxt.pm; cur.pn = nxt.pn; cA = nA; cB = nB; ++ui;
        if constexpr (ALIGN_EPI) { if (wr == 1) PG8_BAR; }
    }
    PG8_WAIT_V(0);
    if constexpr (!ALIGN_EPI) { if (wr == 0) PG8_BAR; }
    PG8_BAR;
#undef PG8_SA
#undef PG8_SB
#undef PG8_STAGE
#undef PG8_LDA
#undef PG8_LDB
#undef PG8_MMA
#undef PG8_WAIT_V
#undef PG8_WAIT_L
#undef PG8_BAR
#undef PG8_SCHED
}
}

constexpr int NWAVES = 8;
constexpr int BATCH = 4, SEQ = 8192, DM = 1024, T = BATCH * SEQ, DEPTH = 4;
constexpr int NEXP = 16;
constexpr int PROWS = 2 * T + NEXP * 256;
constexpr float LN_EPS = 1e-5f;
constexpr float ALPHA = 1.681792830507429f;
constexpr float QSCALE = 0.125f * 1.4426950408889634f;
constexpr float LOG2E = 1.4426950408889634f;

constexpr size_t MiB = 1u << 20;
constexpr size_t WS_CTL = 0, CTL_ZERO_BYTES = 1 * MiB;
constexpr size_t WS_ROPE = 1 * MiB;
constexpr size_t WS_WQKV = 3 * MiB;
constexpr size_t WS_WO = 15 * MiB;
constexpr size_t WS_WP = 19 * MiB;
constexpr size_t WS_W13 = 20 * MiB;
constexpr size_t WS_W2 = 276 * MiB;
constexpr size_t WS_XB = 404 * MiB;
constexpr size_t WS_Y = 468 * MiB;
constexpr size_t WS_OP = WS_Y, WS_LSE = WS_Y + 96 * MiB;
constexpr size_t WS_R = 596 * MiB;
constexpr size_t WS_Q = WS_R, WS_K = WS_R + 64 * MiB, WS_V = WS_R + 128 * MiB, WS_O = WS_R + 192 * MiB;
constexpr size_t WS_U = WS_R;
constexpr size_t WS_XS = WS_R, WS_H = WS_R + 136 * MiB;
constexpr size_t WS_TOK = 868 * MiB;
constexpr size_t WS_SMALL = 869 * MiB;
constexpr int SM_RPB = 0, SM_PSC = 7440, SM_RW = 9488, SM_RB = 25872, SM_LNG = 25888, SM_LNB = 34080, SM_END = 42272;
constexpr size_t WS_END = 870 * MiB;
static_assert((size_t)PROWS * DM * 2 <= 136 * MiB && WS_H + 136 * MiB <= WS_TOK, "d_ws map");

constexpr int CW_BAR = 4096;
constexpr int CW_CNT = 16384;

constexpr int RING_BYTES = 131072;
constexpr int MISC_OFF = RING_BYTES + 320;
constexpr int LDS_BYTES = 147456;
constexpr int TEXP_OFF = RING_BYTES + 1024;

#define GAS __attribute__((address_space(1)))
#define LAS __attribute__((address_space(3)))
typedef unsigned short bf16;
typedef unsigned v4u __attribute__((ext_vector_type(4)));
typedef unsigned v2u __attribute__((ext_vector_type(2)));
typedef float f32x4 __attribute__((ext_vector_type(4)));
typedef float f32x16 __attribute__((ext_vector_type(16)));
typedef short bf16x8 __attribute__((ext_vector_type(8)));
typedef short s16x4 __attribute__((ext_vector_type(4)));
typedef GAS unsigned gu32;
#define RLX_AGENT __ATOMIC_RELAXED, __HIP_MEMORY_SCOPE_AGENT
#define LDS_WAIT() asm volatile("s_waitcnt lgkmcnt(0)" ::: "memory")
__device__ __forceinline__ unsigned f2bf(float f) { unsigned u = __builtin_bit_cast(unsigned, f); return (u + 0x7fffu + ((u >> 16) & 1u)) >> 16; }
__device__ __forceinline__ unsigned pk2(float lo, float hi) { return f2bf(lo) | (f2bf(hi) << 16); }
__device__ __forceinline__ float bf_lo(unsigned u) { return __builtin_bit_cast(float, u << 16); }
__device__ __forceinline__ float bf_hi(unsigned u) { return __builtin_bit_cast(float, u & 0xffff0000u); }

#define XB_TMO      128
#define XB_XCNT(j)  (256  + 64 * (j))
#define XB_XSUB(j)  (1280 + 64 * (j))
#define XB_XGEN(j)  (2304 + 64 * (j))
#define XB_TOP      3328
#define XB_TOPGEN   3392
#define XCD_BAR_WORDS 3456
#define XB_SPIN_CAP (1u << 18)

__device__ __forceinline__ unsigned xb_ld(unsigned* p)              { return __hip_atomic_load(p, __ATOMIC_RELAXED, __HIP_MEMORY_SCOPE_AGENT); }
__device__ __forceinline__ unsigned xb_add(unsigned* p, unsigned v) { return __hip_atomic_fetch_add(p, v, __ATOMIC_RELAXED, __HIP_MEMORY_SCOPE_AGENT); }
__device__ __forceinline__ unsigned xb_xcc_id() { return (unsigned)__builtin_amdgcn_s_getreg((3 << 11) | 20) & 0xFu; }
#define XB_SPIN(cond, bar) do { unsigned _sp = 0; while (cond) { __builtin_amdgcn_s_sleep(1); \
    if ((++_sp & 255u) == 0u) { if (xb_ld(&(bar)[XB_TMO])) break; if (_sp > XB_SPIN_CAP) { atomicAdd(&(bar)[XB_TMO], 1u); break; } } } } while (0)

struct XcdBarrier { unsigned* bar; unsigned x; volatile LAS unsigned* st; };

__device__ __forceinline__ XcdBarrier xcd_barrier_post(unsigned* bar, volatile LAS unsigned* st) {
    XcdBarrier b; b.bar = bar; b.x = xb_xcc_id(); b.st = st;
    if (threadIdx.x == 0) (void)xb_add(&bar[XB_XCNT(b.x)], 1u);
    return b;
}
__device__ __forceinline__ void xcd_barrier_complete(unsigned* bar, unsigned x, unsigned& nloc, unsigned& nx) {
    const unsigned G = gridDim.x * gridDim.y * gridDim.z;
    unsigned sum, cnt, mine, sp = 0u;
    for (;;) {
        sum = 0u; cnt = 0u; mine = 0u;
#pragma unroll
        for (unsigned j = 0; j < 16; ++j) { const unsigned c = xb_ld(&bar[XB_XCNT(j)]); sum += c; cnt += (c > 0u) ? 1u : 0u; mine = (j == x) ? c : mine; }
        if (sum == G) break;
        __builtin_amdgcn_s_sleep(1);
        if ((++sp & 255u) == 0u) { if (xb_ld(&bar[XB_TMO])) break; if (sp > XB_SPIN_CAP) { atomicAdd(&bar[XB_TMO], 1u); break; } }
    }
    nloc = mine > 0u ? mine : 1u; nx = cnt > 0u ? cnt : 1u;
}
__device__ __forceinline__ void xcd_barrier(const XcdBarrier& b) {
    asm volatile("s_waitcnt vmcnt(0)" ::: "memory");
    __syncthreads();
    int tid_ = threadIdx.x; asm volatile("" : "+v"(tid_));
    if (tid_ == 0) {
        unsigned* bar = b.bar; asm volatile("" : "+s"(bar));
        __builtin_amdgcn_s_waitcnt(0);
        unsigned nloc = b.st[0], nx = b.st[1];
        if (nloc == 0u) { xcd_barrier_complete(bar, b.x, nloc, nx); b.st[0] = nloc; b.st[1] = nx; }
        const unsigned old = xb_add(&bar[XB_XSUB(b.x)], 1u);
        const unsigned gen = old / nloc;
        if (old + 1u == (gen + 1u) * nloc) {
            __builtin_amdgcn_fence(__ATOMIC_RELEASE, "agent");
            asm volatile("s_waitcnt vmcnt(0)" ::: "memory");
            const unsigned og = xb_add(&bar[XB_TOP], 1u);
            const unsigned tg = og / nx;
            if (og + 1u == (tg + 1u) * nx) xb_add(&bar[XB_TOPGEN], 1u);
            else XB_SPIN(xb_ld(&bar[XB_TOPGEN]) == tg, bar);
            __builtin_amdgcn_fence(__ATOMIC_ACQUIRE, "agent");
            xb_add(&bar[XB_XGEN(b.x)], 1u);
            asm volatile("s_waitcnt vmcnt(0)" ::: "memory");
        } else {
            XB_SPIN(xb_ld(&bar[XB_XGEN(b.x)]) == gen, bar);
            __builtin_amdgcn_fence(__ATOMIC_ACQUIRE, "agent");
            asm volatile("s_waitcnt vmcnt(0)" ::: "memory");
        }
    }
    __syncthreads();
}

struct Sched {
    int nM, nN, nwg, G, c;
    const char* A; const char* B; size_t a_tile, a_pn, b_tile, e_bytes; const LAS unsigned char* texp;
    __device__ __forceinline__ bool next(int i, int& pm, int& pn, const char*& pa, const char*& pb) const {
        const long L = (long)i * G + c; if (L >= nwg) return false;
        int wgid = (int)L; { const int q = nwg / pg8::NXCD, r = nwg % pg8::NXCD, xcd = wgid % pg8::NXCD, off = wgid / pg8::NXCD; wgid = (xcd < r ? xcd * (q + 1) : r * (q + 1) + (xcd - r) * q) + off; }
        const int nig = pg8::WGM * nN, gid = wgid / nig, fm = gid * pg8::WGM, gsz = (nM - fm) < pg8::WGM ? (nM - fm) : pg8::WGM;
        pm = fm + ((wgid % nig) % gsz); pn = (wgid % nig) / gsz;
        pa = A + (size_t)pm * a_tile + (size_t)pn * a_pn;
        const char* bb = B + (size_t)pn * b_tile;
        if (texp) { const int e = __builtin_amdgcn_readfirstlane((int)texp[pm]); bb += (size_t)e * e_bytes; }
        pb = bb; return true;
    }
};

using pg8::f32x4;

struct EpiQKV {
    bf16* Q; size_t kv_stride; const float* cosT; const float* sinT;
    __device__ __forceinline__ void operator()(const f32x4 (&acc)[2][2][4][2], const pg8::Unit& u, int wr, int wc, int fr, int fq) const {
        const int sel = u.pn >> 2, head = 4 * (u.pn & 3) + wc;
        bf16* base = Q + (size_t)sel * kv_stride;
        const bool rope = (sel < 2) && ((u.pn & 3) < 2);
        const float sc = sel == 0 ? QSCALE : 1.f;
        const int col0 = 64 * head + 8 * fq;
#pragma unroll
        for (int ai = 0; ai < 2; ++ai)
#pragma unroll
            for (int m = 0; m < 4; ++m) {
                const int row = u.pm * 256 + ai * 128 + wr * 64 + m * 16 + fr;
                f32x4 a0 = acc[ai][0][m][0], a1 = acc[ai][0][m][1], b0 = acc[ai][1][m][0], b1 = acc[ai][1][m][1];
                if (rope) {
                    const int s = row & (SEQ - 1);
                    const f32x4 c0 = *(const f32x4*)(cosT + s * 32 + 8 * fq), c1 = *(const f32x4*)(cosT + s * 32 + 8 * fq + 4);
                    const f32x4 s0 = *(const f32x4*)(sinT + s * 32 + 8 * fq), s1 = *(const f32x4*)(sinT + s * 32 + 8 * fq + 4);
                    const f32x4 na0 = a0 * c0 - b0 * s0, nb0 = b0 * c0 + a0 * s0, na1 = a1 * c1 - b1 * s1, nb1 = b1 * c1 + a1 * s1;
                    a0 = na0; b0 = nb0; a1 = na1; b1 = nb1;
                }
                a0 = a0 * sc; a1 = a1 * sc; b0 = b0 * sc; b1 = b1 * sc;
                bf16* rowp = base + (size_t)row * DM + col0;
                v4u w; w.x = pg8::cvt_pk_bf16(a0[0], a0[1]); w.y = pg8::cvt_pk_bf16(a0[2], a0[3]); w.z = pg8::cvt_pk_bf16(a1[0], a1[1]); w.w = pg8::cvt_pk_bf16(a1[2], a1[3]);
                *(v4u*)rowp = w;
                v4u x; x.x = pg8::cvt_pk_bf16(b0[0], b0[1]); x.y = pg8::cvt_pk_bf16(b0[2], b0[3]); x.z = pg8::cvt_pk_bf16(b1[0], b1[1]); x.w = pg8::cvt_pk_bf16(b1[2], b1[3]);
                *(v4u*)(rowp + 32) = x;
                asm volatile("" ::: "memory");
            }
    }
};
struct EpiRes {
    const float* xres; float* Y; const float* csc;
    __device__ __forceinline__ void operator()(const f32x4 (&acc)[2][2][4][2], const pg8::Unit& u, int wr, int wc, int fr, int fq) const {
        const int col0 = u.pn * 256 + 64 * wc + 8 * fq;
#pragma unroll
        for (int ai = 0; ai < 2; ++ai)
#pragma unroll
            for (int m = 0; m < 4; ++m) {
                const size_t off = (size_t)(u.pm * 256 + ai * 128 + wr * 64 + m * 16 + fr) * DM + col0;
#pragma unroll
                for (int bj = 0; bj < 2; ++bj)
#pragma unroll
                    for (int n = 0; n < 2; ++n) {
                        const f32x4 xr = *(const f32x4*)(xres + off + 32 * bj + 4 * n);
                        f32x4 av = acc[ai][bj][m][n];
                        if (csc) av = av * *(const f32x4*)(csc + col0 + 32 * bj + 4 * n);
                        *(f32x4*)(Y + off + 32 * bj + 4 * n) = xr * ALPHA + av;
                    }
                asm volatile("" ::: "memory");
            }
    }
};
struct EpiSwiGLU {
    bf16* H;
    __device__ __forceinline__ void operator()(const f32x4 (&acc)[2][2][4][2], const pg8::Unit& u, int wr, int wc, int fr, int fq) const {
        const int col0 = u.pn * 128 + 32 * wc + 8 * fq;
#pragma unroll
        for (int ai = 0; ai < 2; ++ai)
#pragma unroll
            for (int m = 0; m < 4; ++m) {
                const size_t off = (size_t)(u.pm * 256 + ai * 128 + wr * 64 + m * 16 + fr) * DM + col0;
                float h[8];
#pragma unroll
                for (int n = 0; n < 2; ++n)
#pragma unroll
                    for (int e = 0; e < 4; ++e) {
                        const float gt = acc[ai][0][m][n][e], up = acc[ai][1][m][n][e];
                        const float sg = gt * __builtin_amdgcn_rcpf(1.f + __builtin_amdgcn_exp2f(-gt * LOG2E));
                        h[4 * n + e] = sg * up;
                    }
                v4u w; w.x = pg8::cvt_pk_bf16(h[0], h[1]); w.y = pg8::cvt_pk_bf16(h[2], h[3]); w.z = pg8::cvt_pk_bf16(h[4], h[5]); w.w = pg8::cvt_pk_bf16(h[6], h[7]);
                *(v4u*)(H + off) = w;
                asm volatile("" ::: "memory");
            }
    }
};
struct EpiBf16 {
    bf16* O;
    __device__ __forceinline__ void operator()(const f32x4 (&acc)[2][2][4][2], const pg8::Unit& u, int wr, int wc, int fr, int fq) const {
        const int col0 = u.pn * 256 + 64 * wc + 8 * fq;
#pragma unroll
        for (int ai = 0; ai < 2; ++ai)
#pragma unroll
            for (int m = 0; m < 4; ++m) {
                const size_t off = (size_t)(u.pm * 256 + ai * 128 + wr * 64 + m * 16 + fr) * DM + col0;
#pragma unroll
                for (int bj = 0; bj < 2; ++bj) {
                    const f32x4 v0 = acc[ai][bj][m][0], v1 = acc[ai][bj][m][1];
                    v4u w; w.x = pg8::cvt_pk_bf16(v0[0], v0[1]); w.y = pg8::cvt_pk_bf16(v0[2], v0[3]); w.z = pg8::cvt_pk_bf16(v1[0], v1[1]); w.w = pg8::cvt_pk_bf16(v1[2], v1[3]);
                    *(v4u*)(O + off + 32 * bj) = w;
                }
                asm volatile("" ::: "memory");
            }
    }
};

__device__ __forceinline__ float wave_sum(float v) {
#pragma unroll
    for (int o = 1; o < 64; o <<= 1) v += __shfl_xor(v, o);
    return v;
}
typedef float f32x2_t __attribute__((ext_vector_type(2))); typedef __bf16 bf16x2_t __attribute__((ext_vector_type(2)));
__device__ __forceinline__ unsigned cvtpk_s(float lo, float hi) { f32x2_t v = {lo, hi}; bf16x2_t b = __builtin_convertvector(v, bf16x2_t); return __builtin_bit_cast(unsigned, b); }

__device__ __forceinline__ void p0_transpose_item(const float* W, int K, int N, bf16* WT, int k0, int n0, int drow, LAS float* scr, int lane) {
#pragma unroll 8
    for (int i = 0; i < 32; ++i) { const int kk = 2 * i + (lane >> 5); scr[kk * 33 + (lane & 31)] = W[(size_t)(k0 + kk) * N + n0 + (lane & 31)]; }
    LDS_WAIT(); asm volatile("" ::: "memory");
    const int c = lane & 7;
#pragma unroll
    for (int j = 0; j < 4; ++j) { const int n = (lane >> 3) + 8 * j; const LAS float* s = scr + (8 * c) * 33 + n;
        v4u o; o.x = pk2(s[0 * 33], s[1 * 33]); o.y = pk2(s[2 * 33], s[3 * 33]); o.z = pk2(s[4 * 33], s[5 * 33]); o.w = pk2(s[6 * 33], s[7 * 33]);
        *(GAS v4u*)(WT + (size_t)(drow + n) * K + k0 + 8 * c) = o; }
    LDS_WAIT(); asm volatile("" ::: "memory");
}
struct InPtrs { const float *x, *w_in, *w_out, *rpb, *pool_w, *pool_scale, *router_w, *router_bias, *w1, *w3, *w2, *ln_g, *ln_b; };

__device__ __forceinline__ void sincos_d(double a, double& sn, double& cs) {
    const double n = __builtin_rint(a * 0.63661977236758134308);
    double r = __builtin_fma(-n, 1.57079632679489655800e+00, a); r = __builtin_fma(-n, 6.12323399573676603587e-17, r);
    const double z = r * r;
    const double sp = r + r * z * (-1.66666666666666324348e-01 + z * (8.33333333332248946124e-03 + z * (-1.98412698298579493134e-04 + z * (2.75573137070700676789e-06 + z * (-2.50507602534068634195e-08 + z * 1.58969099521155010221e-10)))));
    const double cp = 1.0 - 0.5 * z + z * z * (4.16666666666666019037e-02 + z * (-1.38888888888741095749e-03 + z * (2.48015872894767294178e-05 + z * (-2.75573143513906633035e-07 + z * (2.08757232129817482790e-09 + z * -1.13596475577881948265e-11)))));
    const int q = (int)((long long)n & 3);
    sn = (q == 0) ? sp : (q == 1) ? cp : (q == 2) ? -sp : -cp;
    cs = (q == 0) ? cp : (q == 1) ? -sp : (q == 2) ? -cp : sp;
}

__device__ __forceinline__ void phase_prologue(const InPtrs& in, unsigned char* ws, LAS unsigned char* lds, int gw, int NGW, int lane, int wave, int gtid, int NTH) {
    LAS float* scr = (LAS float*)(lds + wave * 16384);
    constexpr int MOE_ITEMS = DEPTH * NEXP * 3 * 512, IN_ITEMS = 2 * 1536, OUT_ITEMS = 2 * 512, POOL_ITEMS = 8 * 32;
    constexpr int NITEMS = MOE_ITEMS + IN_ITEMS + OUT_ITEMS + POOL_ITEMS;
    for (int it = gw; it < NITEMS; it += NGW) {
        int r = it;
        if (r < MOE_ITEMS) {
            const int mat = r >> 9, loc = r & 511, le = mat / 3, which = mat - 3 * le;
            const int kb = loc >> 5, nb = loc & 31;
            const float* src = (which == 0 ? in.w1 : which == 1 ? in.w3 : in.w2) + (size_t)le * DM * DM;
            if (which < 2) p0_transpose_item(src, DM, DM, (bf16*)(ws + WS_W13) + (size_t)le * 2048 * DM, 64 * kb, 32 * nb, 64 * nb + 32 * which, scr, lane);
            else           p0_transpose_item(src, DM, DM, (bf16*)(ws + WS_W2) + (size_t)le * DM * DM, 64 * kb, 32 * nb, 32 * nb, scr, lane);
            continue;
        }
        r -= MOE_ITEMS;
        if (r < IN_ITEMS) { const int i = r / 1536, loc = r - 1536 * i, kb = loc / 96, nb = loc - 96 * kb;
            p0_transpose_item(in.w_in + (size_t)i * DM * 3072, DM, 3072, (bf16*)(ws + WS_WQKV) + (size_t)i * 3072 * DM, 64 * kb, 32 * nb, 32 * nb, scr, lane); continue; }
        r -= IN_ITEMS;
        if (r < OUT_ITEMS) { const int i = r >> 9, loc = r & 511, kb = loc >> 5, nb = loc & 31;
            p0_transpose_item(in.w_out + (size_t)i * DM * DM, DM, DM, (bf16*)(ws + WS_WO) + (size_t)i * DM * DM, 64 * kb, 32 * nb, 32 * nb, scr, lane); continue; }
        r -= OUT_ITEMS;
        { const int mat = r >> 5, loc = r & 31, kb = loc >> 3, nb = loc & 7;
            p0_transpose_item(in.pool_w + (size_t)mat * 65536, 256, 256, (bf16*)(ws + WS_WP) + (size_t)mat * 65536, 64 * kb, 32 * nb, 32 * nb, scr, lane); }
    }
    bf16* XB = (bf16*)(ws + WS_XB);
    for (int m = gw; m < T; m += NGW) {
        const GAS f32x4* xr = (const GAS f32x4*)(in.x + (size_t)m * DM) + lane;
        GAS unsigned long long* o8 = (GAS unsigned long long*)(XB + (size_t)m * DM) + lane;
#pragma unroll
        for (int j = 0; j < 4; ++j) { const f32x4 v = xr[64 * j]; o8[64 * j] = (unsigned long long)pk2(v.x, v.y) | ((unsigned long long)pk2(v.z, v.w) << 32); }
    }
    { float* sm = (float*)(ws + WS_SMALL);
      for (int i = gtid; i < SM_END; i += NTH) {
          float v;
          if (i < SM_PSC) v = in.rpb[i]; else if (i < SM_RW) v = in.pool_scale[i - SM_PSC]; else if (i < SM_RB) v = in.router_w[i - SM_RW];
          else if (i < SM_LNG) v = in.router_bias[i - SM_RB]; else if (i < SM_LNB) v = in.ln_g[i - SM_LNG]; else v = in.ln_b[i - SM_LNB];
          sm[i] = v; } }
    float* cosT = (float*)(ws + WS_ROPE); float* sinT = cosT + SEQ * 32;
    for (int idx = gw * 64 + lane; idx < SEQ * 32; idx += NGW * 64) {
        const int s = idx >> 5, i = idx & 31;
        double invf = 1.0;
        if (i & 1) invf *= 0.7498942093324559; if (i & 2) invf *= 0.5623413251903491; if (i & 4) invf *= 0.31622776601683794; if (i & 8) invf *= 0.1; if (i & 16) invf *= 0.01;
        double sn, cs; sincos_d((double)s * invf, sn, cs);
        cosT[idx] = (float)cs; sinT[idx] = (float)sn;
    }
}

struct AttnP { const bf16* Q; const bf16* K; const bf16* V; bf16* O; bf16* OP; float* LSE; };
constexpr int V_RS = 144;
constexpr int V_TILE_BYTES = 32 * V_RS;
constexpr int RPB_OFF = 8 * V_TILE_BYTES;

template <bool NT>
__device__ __forceinline__ void attn_unit(const AttnP& P, int unit, LAS unsigned char* vbuf, const LAS float* rpbt, int lane) {
    const int q = lane & 31, hi = lane >> 5;
    int b, hcol, ntiles, qtok, sh = 0, ph = 0, i0 = 0, L = SEQ, br = 0, hD = 0;
    int r = 0, r0 = 0, qhalf = 0, c = 0, cs = 0, hN = 0;
    if (NT) { b = unit >> 11; hN = (unit >> 8) & 7; r = (unit & 255) >> 1; qhalf = unit & 1; r0 = min(max(r - 4, 0), 120); c = 32 * qhalf + q; cs = min(max(c - 8, 0), 48);
        qtok = b * SEQ + 64 * r + c; hcol = 64 * (8 + hN); ntiles = 12; }
    else { br = unit >> 13; const int rem = unit & 8191; b = rem >> 11; hD = (rem >> 8) & 7; const int qblk = rem & 255;
        sh = 2 * br; ph = qblk >> (8 - sh); const int ib = qblk & ((256 >> sh) - 1); i0 = 32 * ib; L = SEQ >> sh;
        qtok = b * SEQ + ((i0 + q) << sh) + ph; hcol = 64 * hD; ntiles = 5; }
    auto ktok = [&](int t, int key) -> int {
        if (NT) { const int rp = t / 3, cc = t - 3 * rp + qhalf; const int kr = 2 * rp + (key >> 4), kc = 16 * cc + (key & 15); return b * SEQ + 64 * (r0 + kr) + kc; }
        else { int j = i0 - 64 + 32 * t + key; j = min(max(j, 0), L - 1); return b * SEQ + (j << sh) + ph; }
    };
    bf16x8 qf[4];
#pragma unroll
    for (int d0 = 0; d0 < 4; ++d0) qf[d0] = *(const bf16x8*)(P.Q + (size_t)qtok * DM + hcol + 16 * d0 + 8 * hi);
    float m = -1e30f, lsum = 0.f; f32x16 o0 = {}, o1 = {};
    bf16x8 kf[4]; v4u vr[4];
    { const int tk = ktok(0, q);
#pragma unroll
      for (int d0 = 0; d0 < 4; ++d0) kf[d0] = *(const bf16x8*)(P.K + (size_t)tk * DM + hcol + 16 * d0 + 8 * hi);
#pragma unroll
      for (int ii = 0; ii < 4; ++ii) { const int tv = ktok(0, 8 * ii + (lane >> 3)); vr[ii] = *(const v4u*)(P.V + (size_t)tv * DM + hcol + 8 * (lane & 7)); } }
    const int qp = (lane & 15) >> 2, pp = lane & 3, blk = (lane >> 4) & 1;
    LAS unsigned char* trbase = vbuf + (4 * hi + qp) * V_RS + 32 * blk + 8 * pp;
    for (int t = 0; t < ntiles; ++t) {
        bf16x8 kn[4]; v4u vn[4];
        if (t + 1 < ntiles) { const int tk = ktok(t + 1, q);
#pragma unroll
            for (int d0 = 0; d0 < 4; ++d0) kn[d0] = *(const bf16x8*)(P.K + (size_t)tk * DM + hcol + 16 * d0 + 8 * hi);
#pragma unroll
            for (int ii = 0; ii < 4; ++ii) { const int tv = ktok(t + 1, 8 * ii + (lane >> 3)); vn[ii] = *(const v4u*)(P.V + (size_t)tv * DM + hcol + 8 * (lane & 7)); } }
        else {
#pragma unroll
            for (int d0 = 0; d0 < 4; ++d0) { kn[d0] = kf[d0]; vn[d0] = vr[d0]; } }
        f32x16 s = {};
#pragma unroll
        for (int d0 = 0; d0 < 4; ++d0) s = __builtin_amdgcn_mfma_f32_32x32x16_bf16(kf[d0], qf[d0], s, 0, 0, 0);
        float mx = -INFINITY;
#pragma unroll
        for (int rr = 0; rr < 16; ++rr) {
            const int key = (rr & 3) + 8 * (rr >> 2) + 4 * hi;
            bool valid; float bias = 0.f;
            if (NT) { const int rp = t / 3, cc = t - 3 * rp + qhalf; const int kr = 2 * rp + (key >> 4), kc = 16 * cc + (key & 15);
                valid = (kc >= cs) && (kc < cs + 16);
                const int co = min(max(kc - c + 15, 0), 30);
                bias = rpbt[hN * 465 + (r0 + kr - r + 7) * 31 + co]; }
            else { const int j = i0 - 64 + 32 * t + key, dlt = q + 64 - 32 * t - key;
                valid = (j >= 0) && (j < L) && (dlt <= 64) && (dlt >= -64); }
            const float sv = valid ? s[rr] + bias : -INFINITY;
            s[rr] = sv; mx = fmaxf(mx, sv);
        }
        mx = fmaxf(mx, __shfl_xor(mx, 32));
        const float mnew = fmaxf(m, mx), alpha = __builtin_amdgcn_exp2f(m - mnew);
        float psum = 0.f;
#pragma unroll
        for (int rr = 0; rr < 16; ++rr) { const float p = __builtin_amdgcn_exp2f(s[rr] - mnew); s[rr] = p; psum += p; }
        lsum = lsum * alpha + psum; m = mnew;
#pragma unroll
        for (int rr = 0; rr < 16; ++rr) { o0[rr] *= alpha; o1[rr] *= alpha; }
        v4u pw0, pw1;
        pw0.x = cvtpk_s(s[0], s[1]); pw0.y = cvtpk_s(s[2], s[3]); pw0.z = cvtpk_s(s[4], s[5]); pw0.w = cvtpk_s(s[6], s[7]);
        pw1.x = cvtpk_s(s[8], s[9]); pw1.y = cvtpk_s(s[10], s[11]); pw1.z = cvtpk_s(s[12], s[13]); pw1.w = cvtpk_s(s[14], s[15]);
        const bf16x8 pf0 = __builtin_bit_cast(bf16x8, pw0), pf1 = __builtin_bit_cast(bf16x8, pw1);
#pragma unroll
        for (int ii = 0; ii < 4; ++ii) *(LAS v4u*)(vbuf + (8 * ii + (lane >> 3)) * V_RS + 16 * (lane & 7)) = vr[ii];
#pragma unroll
        for (int dblk = 0; dblk < 2; ++dblk) {
#pragma unroll
            for (int s2 = 0; s2 < 2; ++s2) {
                const s16x4 lo = __builtin_bit_cast(s16x4, __builtin_amdgcn_ds_read_tr16_b64_v4i16((LAS s16x4*)(trbase + (16 * s2) * V_RS + 64 * dblk)));
                const s16x4 hh = __builtin_bit_cast(s16x4, __builtin_amdgcn_ds_read_tr16_b64_v4i16((LAS s16x4*)(trbase + (16 * s2 + 8) * V_RS + 64 * dblk)));
                const bf16x8 vf = (bf16x8){lo[0], lo[1], lo[2], lo[3], hh[0], hh[1], hh[2], hh[3]};
                if (dblk == 0) o0 = __builtin_amdgcn_mfma_f32_32x32x16_bf16(vf, s2 == 0 ? pf0 : pf1, o0, 0, 0, 0);
                else           o1 = __builtin_amdgcn_mfma_f32_32x32x16_bf16(vf, s2 == 0 ? pf0 : pf1, o1, 0, 0, 0);
            }
        }
#pragma unroll
        for (int d0 = 0; d0 < 4; ++d0) { kf[d0] = kn[d0]; vr[d0] = vn[d0]; }
    }
    lsum += __shfl_xor(lsum, 32);
    const float inv = 1.f / lsum;
    bf16* orow;
    if (NT) orow = P.O + (size_t)qtok * DM + hcol;
    else { orow = P.OP + ((size_t)br * T + qtok) * 512 + hcol; if (hi == 0) P.LSE[((size_t)br * T + qtok) * 8 + hD] = m + __builtin_amdgcn_logf(lsum); }
#pragma unroll
    for (int g = 0; g < 4; ++g) {
        v2u w0, w1;
        w0.x = cvtpk_s(o0[4 * g] * inv, o0[4 * g + 1] * inv); w0.y = cvtpk_s(o0[4 * g + 2] * inv, o0[4 * g + 3] * inv);
        w1.x = cvtpk_s(o1[4 * g] * inv, o1[4 * g + 1] * inv); w1.y = cvtpk_s(o1[4 * g + 2] * inv, o1[4 * g + 3] * inv);
        *(v2u*)(orow + 8 * g + 4 * hi) = w0;
        *(v2u*)(orow + 32 + 8 * g + 4 * hi) = w1;
    }
}

__device__ __forceinline__ void phase_attention(const AttnP& P, const float* rpb, LAS unsigned char* lds, int gw, int NGW, int tid, int lane, int wave) {
    LAS float* rpbt = (LAS float*)(lds + RPB_OFF);
    for (int i = tid; i < 8 * 465; i += NWAVES * 64) rpbt[i] = rpb[i] * LOG2E;
    __syncthreads();
    LAS unsigned char* vbuf = lds + wave * V_TILE_BYTES;
    constexpr int NUNITS_N = BATCH * 8 * 128 * 2, NUNITS_D = 3 * BATCH * 8 * 256;
    { const int ch = (NUNITS_N + NGW - 1) / NGW; const int u1 = min((gw + 1) * ch, NUNITS_N);
      for (int u = gw * ch; u < u1; ++u) attn_unit<true>(P, u, vbuf, rpbt, lane); }
    { const int ch = (NUNITS_D + NGW - 1) / NGW; const int u1 = min((gw + 1) * ch, NUNITS_D);
      for (int u = gw * ch; u < u1; ++u) attn_unit<false>(P, u, vbuf, rpbt, lane); }
}

__device__ __forceinline__ void phase_merge(const bf16* OP, const float* LSE, bf16* O, int gtid, int NT_) {
    for (int idx = gtid; idx < T * 64; idx += NT_) {
        const int tok = idx >> 6, h = (idx >> 3) & 7, ch = idx & 7;
        const float l0 = LSE[(size_t)tok * 8 + h], l1 = LSE[((size_t)T + tok) * 8 + h], l2 = LSE[((size_t)2 * T + tok) * 8 + h];
        const float mx = fmaxf(l0, fmaxf(l1, l2));
        float w0 = __builtin_amdgcn_exp2f(l0 - mx), w1 = __builtin_amdgcn_exp2f(l1 - mx), w2 = __builtin_amdgcn_exp2f(l2 - mx);
        const float inv = 1.f / (w0 + w1 + w2); w0 *= inv; w1 *= inv; w2 *= inv;
        const size_t po = (size_t)tok * 512 + 64 * h + 8 * ch;
        const v4u a = *(const v4u*)(OP + po), b = *(const v4u*)(OP + (size_t)T * 512 + po), c = *(const v4u*)(OP + (size_t)2 * T * 512 + po);
        v4u o;
#pragma unroll
        for (int k = 0; k < 4; ++k) {
            const float lo = w0 * bf_lo(a[k]) + w1 * bf_lo(b[k]) + w2 * bf_lo(c[k]);
            const float hi = w0 * bf_hi(a[k]) + w1 * bf_hi(b[k]) + w2 * bf_hi(c[k]);
            o[k] = cvtpk_s(lo, hi);
        }
        *(v4u*)(O + (size_t)tok * DM + 64 * h + 8 * ch) = o;
    }
}

__device__ __forceinline__ void phase_pool(const float* X, bf16* U, int gtid, int NT_) {
    for (int idx = gtid; idx < (T / 32) * 256; idx += NT_) {
        const int tch = idx >> 8, cc = idx & 255, b = tch >> 8, s0 = (tch & 255) * 32, half = 1 << (cc >> 6);
        const float* xb = X + (size_t)b * SEQ * DM + 4 * cc;
        bf16* ub = U + (size_t)b * SEQ * DM + 4 * cc;
        f32x4 sum = {0.f, 0.f, 0.f, 0.f};
        for (int u = s0 - half; u < s0 + half; ++u) if (u >= 0 && u < SEQ) sum += *(const f32x4*)(xb + (size_t)u * DM);
        for (int t = s0; t < s0 + 32; ++t) {
            const int lo = max(t - half, 0), hi = min(t + half, SEQ);
            const float rc = 1.f / (float)(hi - lo);
            const f32x4 xv = *(const f32x4*)(xb + (size_t)t * DM);
            const f32x4 uv = sum * rc - xv;
            v2u w; w.x = cvtpk_s(uv[0], uv[1]); w.y = cvtpk_s(uv[2], uv[3]);
            *(v2u*)(ub + (size_t)t * DM) = w;
            if (t + half < SEQ) sum += *(const f32x4*)(xb + (size_t)(t + half) * DM);
            if (t - half >= 0) sum -= *(const f32x4*)(xb + (size_t)(t - half) * DM);
        }
    }
}

__device__ __forceinline__ void ln_row(f32x4 (&v)[4], const float* g, const float* bta, int lane) {
    float s = 0.f;
#pragma unroll
    for (int j = 0; j < 4; ++j) s += (v[j][0] + v[j][1]) + (v[j][2] + v[j][3]);
    const float mean = wave_sum(s) * (1.f / DM); float s2 = 0.f;
#pragma unroll
    for (int j = 0; j < 4; ++j) { v[j] = v[j] - mean; s2 += (v[j][0] * v[j][0] + v[j][1] * v[j][1]) + (v[j][2] * v[j][2] + v[j][3] * v[j][3]); }
    const float rstd = 1.f / sqrtf(wave_sum(s2) * (1.f / DM) + LN_EPS);
#pragma unroll
    for (int j = 0; j < 4; ++j) { const f32x4 gg = *(const f32x4*)(g + 4 * lane + 256 * j), bb = *(const f32x4*)(bta + 4 * lane + 256 * j); v[j] = v[j] * rstd * gg + bb; }
}
__device__ __forceinline__ void store_row(const f32x4 (&v)[4], float* X, bf16* XB, size_t tok, int lane) {
    GAS f32x4* xo = (GAS f32x4*)(X + tok * DM) + lane;
    GAS unsigned long long* bo = (GAS unsigned long long*)(XB + tok * DM) + lane;
#pragma unroll
    for (int j = 0; j < 4; ++j) { xo[64 * j] = v[j]; bo[64 * j] = (unsigned long long)cvtpk_s(v[j][0], v[j][1]) | ((unsigned long long)cvtpk_s(v[j][2], v[j][3]) << 32); }
}

__device__ __forceinline__ float reduce16(float (&v)[16], int lane) {
#pragma unroll
    for (int i = 0; i < 8; ++i) { const bool up = lane & 32; const float send = up ? v[i] : v[i + 8], keep = up ? v[i + 8] : v[i]; v[i] = keep + __shfl_xor(send, 32); }
#pragma unroll
    for (int i = 0; i < 4; ++i) { const bool up = lane & 16; const float send = up ? v[i] : v[i + 4], keep = up ? v[i + 4] : v[i]; v[i] = keep + __shfl_xor(send, 16); }
#pragma unroll
    for (int i = 0; i < 2; ++i) { const bool up = lane & 8; const float send = up ? v[i] : v[i + 2], keep = up ? v[i + 2] : v[i]; v[i] = keep + __shfl_xor(send, 8); }
    { const bool up = lane & 4; const float send = up ? v[0] : v[1], keep = up ? v[1] : v[0]; v[0] = keep + __shfl_xor(send, 4); }
    v[0] += __shfl_xor(v[0], 2); v[0] += __shfl_xor(v[0], 1);
    return v[0];
}

struct TokTabs { int* e; float* g; int* rank; int* pos; };

__device__ __forceinline__ void route_token(const float (&lg)[16], const float* rbias, size_t tok, int tl, const TokTabs& TT, LAS int* lcnt, LAS int* tinfo, int lane) {
    float aff[16], sel[16];
#pragma unroll
    for (int e = 0; e < 16; ++e) { aff[e] = 1.f / (1.f + expf(-lg[e])); sel[e] = aff[e] + rbias[e]; }
    float gs[4];
#pragma unroll
    for (int g = 0; g < 4; ++g) { const float a = sel[4 * g], b = sel[4 * g + 1], c = sel[4 * g + 2], d = sel[4 * g + 3];
        const float h1 = fmaxf(a, b), l1 = fminf(a, b), h2 = fmaxf(c, d), l2 = fminf(c, d);
        gs[g] = fmaxf(h1, h2) + fmaxf(fminf(h1, h2), fmaxf(l1, l2)); }
    int grp = 0; float best = gs[0];
#pragma unroll
    for (int g = 1; g < 4; ++g) if (gs[g] > best) { best = gs[g]; grp = g; }
    float sg[4], ag[4];
#pragma unroll
    for (int k = 0; k < 4; ++k) { sg[k] = grp == 0 ? sel[k] : grp == 1 ? sel[4 + k] : grp == 2 ? sel[8 + k] : sel[12 + k]; ag[k] = grp == 0 ? aff[k] : grp == 1 ? aff[4 + k] : grp == 2 ? aff[8 + k] : aff[12 + k]; }
    int i1 = 0; float b1 = sg[0];
#pragma unroll
    for (int k = 1; k < 4; ++k) if (sg[k] > b1) { b1 = sg[k]; i1 = k; }
    int i2 = -1; float b2 = -INFINITY;
#pragma unroll
    for (int k = 0; k < 4; ++k) if (k != i1 && (i2 < 0 || sg[k] > b2)) { b2 = sg[k]; i2 = k; }
    const float a1 = i1 == 0 ? ag[0] : i1 == 1 ? ag[1] : i1 == 2 ? ag[2] : ag[3];
    const float a2 = i2 == 0 ? ag[0] : i2 == 1 ? ag[1] : i2 == 2 ? ag[2] : ag[3];
    const float den = a1 + a2;
    if (lane == 0) {
        const int e1 = grp * 4 + i1, e2 = grp * 4 + i2;
        const int r1 = __hip_atomic_fetch_add(lcnt + e1, 1, __ATOMIC_RELAXED, __HIP_MEMORY_SCOPE_WORKGROUP);
        const int r2 = __hip_atomic_fetch_add(lcnt + e2, 1, __ATOMIC_RELAXED, __HIP_MEMORY_SCOPE_WORKGROUP);
        tinfo[tl * 4 + 0] = e1; tinfo[tl * 4 + 1] = r1; tinfo[tl * 4 + 2] = e2; tinfo[tl * 4 + 3] = r2;
        TT.e[tok * 2] = e1; TT.e[tok * 2 + 1] = e2; TT.g[tok * 2] = a1 / den; TT.g[tok * 2 + 1] = a2 / den;
    }
}

__device__ __forceinline__ void phase_lnr(const float* Y, float* X, bf16* XB, const float* g, const float* bta, const float* router_w, const float* rbias_g,
                                          const TokTabs& TT, gu32* cnt, LAS unsigned char* lds, int tid, int lane, int wave) {
    LAS float* rw = (LAS float*)lds;
    LAS int* lcnt = (LAS int*)(lds + 65536); LAS int* lbase = lcnt + 16; LAS int* tinfo = lcnt + 32;
    for (int idx = tid; idx < DM * 16; idx += NWAVES * 64) { const int col = idx >> 4, e = idx & 15, j = col >> 8, l = (col & 255) >> 2, c = col & 3;
        rw[((((j * 4 + c) * 4 + (e >> 2)) * 64 + l) << 2) + (e & 3)] = router_w[idx]; }
    float rbias[16];
#pragma unroll
    for (int e = 0; e < 16; ++e) rbias[e] = rbias_g[e];
    for (int chunk = blockIdx.x; chunk < T / 128; chunk += gridDim.x) {
        __syncthreads();
        if (tid < 16) lcnt[tid] = 0;
        __syncthreads();
        for (int pass = 0; pass < 8; ++pass) {
            const int tl0 = wave * 16 + 2 * pass; const size_t tok0 = (size_t)chunk * 128 + tl0;
            f32x4 va[4], vb[4];
#pragma unroll
            for (int j = 0; j < 4; ++j) { va[j] = *((const GAS f32x4*)(Y + tok0 * DM) + lane + 64 * j); vb[j] = *((const GAS f32x4*)(Y + (tok0 + 1) * DM) + lane + 64 * j); }
            ln_row(va, g, bta, lane); ln_row(vb, g, bta, lane);
            store_row(va, X, XB, tok0, lane); store_row(vb, X, XB, tok0 + 1, lane);
            float pa[16], pb[16];
#pragma unroll
            for (int e = 0; e < 16; ++e) { pa[e] = 0.f; pb[e] = 0.f; }
#pragma unroll
            for (int j = 0; j < 4; ++j)
#pragma unroll
                for (int c = 0; c < 4; ++c)
#pragma unroll
                    for (int e4 = 0; e4 < 4; ++e4) {
                        const f32x4 w = *(const LAS f32x4*)(rw + ((((j * 4 + c) * 4 + e4) * 64 + lane) << 2));
                        const float xa = va[j][c], xb = vb[j][c];
#pragma unroll
                        for (int ee = 0; ee < 4; ++ee) { pa[4 * e4 + ee] += xa * w[ee]; pb[4 * e4 + ee] += xb * w[ee]; }
                    }
            const float ra = reduce16(pa, lane), rb = reduce16(pb, lane);
            float lga[16], lgb[16];
#pragma unroll
            for (int e = 0; e < 16; ++e) { lga[e] = __builtin_bit_cast(float, __builtin_amdgcn_readlane(__builtin_bit_cast(int, ra), 4 * e)); lgb[e] = __builtin_bit_cast(float, __builtin_amdgcn_readlane(__builtin_bit_cast(int, rb), 4 * e)); }
            route_token(lga, rbias, tok0, tl0, TT, lcnt, tinfo, lane);
            route_token(lgb, rbias, tok0 + 1, tl0 + 1, TT, lcnt, tinfo, lane);
        }
        __syncthreads();
        if (tid < 16) lbase[tid] = (int)__hip_atomic_fetch_add(cnt + 64 * tid, (unsigned)lcnt[tid], RLX_AGENT);
        __syncthreads();
        if (tid < 256) { const int tl = tid >> 1, k = tid & 1; const int e = tinfo[tl * 4 + 2 * k], lr = tinfo[tl * 4 + 2 * k + 1];
            TT.rank[((size_t)chunk * 128 + tl) * 2 + k] = lbase[e] + lr; }
    }
    __syncthreads();
}

__device__ __forceinline__ int build_expert_tables(const gu32* cnt, LAS int* pstart, LAS unsigned char* texp, LAS int* ntl, int tid) {
    __syncthreads();
    if (tid == 0) {
        int acc = 0;
        for (int e = 0; e < NEXP; ++e) { const int c = (int)__hip_atomic_load(cnt + 64 * e, RLX_AGENT); const int nt = (c + 255) >> 8; pstart[e] = acc * 256; for (int i = 0; i < nt; ++i) texp[acc + i] = (unsigned char)e; acc += nt; }
        *ntl = acc;
    }
    __syncthreads();
    return *ntl;
}

__device__ __forceinline__ void phase_scatter(const bf16* XB, bf16* XS, const TokTabs& TT, const LAS int* pstart, int gw, int NGW, int lane) {
    for (int tok = gw; tok < T; tok += NGW) {
        const int e0 = TT.e[tok * 2], e1 = TT.e[tok * 2 + 1];
        const int p0 = pstart[e0] + TT.rank[tok * 2], p1 = pstart[e1] + TT.rank[tok * 2 + 1];
        const GAS v4u* src = (const GAS v4u*)(XB + (size_t)tok * DM) + lane;
        const v4u a = src[0], b = src[64];
        GAS v4u* d0 = (GAS v4u*)(XS + (size_t)p0 * DM) + lane; GAS v4u* d1 = (GAS v4u*)(XS + (size_t)p1 * DM) + lane;
        d0[0] = a; d0[64] = b; d1[0] = a; d1[64] = b;
        if (lane == 0) { TT.pos[tok * 2] = p0; TT.pos[tok * 2 + 1] = p1; }
    }
}

__device__ __forceinline__ void phase_combine(float* X, bf16* XB, const bf16* YB, const TokTabs& TT, const float* g, const float* bta, int gw, int NGW, int lane) {
    for (int tok = gw; tok < T; tok += NGW) {
        const int p0 = TT.pos[tok * 2], p1 = TT.pos[tok * 2 + 1]; const float g0 = TT.g[tok * 2], g1 = TT.g[tok * 2 + 1];
        const GAS f32x4* xr = (const GAS f32x4*)(X + (size_t)tok * DM) + lane;
        const GAS v2u* y0 = (const GAS v2u*)(YB + (size_t)p0 * DM) + lane; const GAS v2u* y1 = (const GAS v2u*)(YB + (size_t)p1 * DM) + lane;
        f32x4 v[4];
#pragma unroll
        for (int j = 0; j < 4; ++j) { const f32x4 xv = xr[64 * j]; const v2u a = y0[64 * j], b = y1[64 * j];
            v[j][0] = xv[0] * ALPHA + g0 * bf_lo(a.x) + g1 * bf_lo(b.x); v[j][1] = xv[1] * ALPHA + g0 * bf_hi(a.x) + g1 * bf_hi(b.x);
            v[j][2] = xv[2] * ALPHA + g0 * bf_lo(a.y) + g1 * bf_lo(b.y); v[j][3] = xv[3] * ALPHA + g0 * bf_hi(a.y) + g1 * bf_hi(b.y); }
        ln_row(v, g, bta, lane);
        store_row(v, X, XB, (size_t)tok, lane);
    }
}

constexpr int PSTART_OFF = RING_BYTES + 1536, NTL_OFF = RING_BYTES + 1600;
struct Args { InPtrs in; float* out; unsigned char* ws; int layer, pad; };

template <int SLOT>
__device__ __forceinline__ void do_slot(const Args& args, int layer, LAS unsigned char* lds) {
    int tidL = threadIdx.x; asm volatile("" : "+v"(tidL));
    const int tid = tidL, lane = tidL & 63, wave = __builtin_amdgcn_readfirstlane(tidL >> 6);
    const int G = gridDim.x, gw = blockIdx.x * NWAVES + wave, NGW = G * NWAVES, gtid = blockIdx.x * (NWAVES * 64) + tidL, NTH = G * NWAVES * 64;
    unsigned char* ws = args.ws; asm volatile("" : "+s"(ws));
    float* X = args.out; asm volatile("" : "+s"(X));
    const int i2 = layer >> 1;
    TokTabs TT; TT.e = (int*)(ws + WS_TOK); TT.g = (float*)(ws + WS_TOK + 262144); TT.rank = (int*)(ws + WS_TOK + 2 * 262144); TT.pos = (int*)(ws + WS_TOK + 3 * 262144);
    gu32* cnt = (gu32*)(ws + WS_CTL) + CW_CNT + layer * 16 * 64;
    bf16* XB = (bf16*)(ws + WS_XB); float* Y = (float*)(ws + WS_Y);
    bf16* Qb = (bf16*)(ws + WS_Q); bf16* Kb = (bf16*)(ws + WS_K); bf16* Vb = (bf16*)(ws + WS_V); bf16* Ob = (bf16*)(ws + WS_O);
    bf16* OP = (bf16*)(ws + WS_OP); float* LSE = (float*)(ws + WS_LSE);
    bf16* Ub = (bf16*)(ws + WS_U); bf16* XS = (bf16*)(ws + WS_XS); bf16* Hb = (bf16*)(ws + WS_H);
    const float* cosT = (const float*)(ws + WS_ROPE); const float* sinT = cosT + SEQ * 32;
    const float* SMp = (const float*)(ws + WS_SMALL);
    LAS int* pstart = (LAS int*)(lds + PSTART_OFF); LAS unsigned char* texp = lds + TEXP_OFF; LAS int* ntl = (LAS int*)(lds + NTL_OFF);
    (void)tid; (void)lane; (void)gw; (void)NGW; (void)gtid; (void)NTH; (void)i2; (void)TT; (void)cnt; (void)XB; (void)Y; (void)Qb; (void)Kb; (void)Vb; (void)Ob; (void)OP; (void)LSE; (void)Ub; (void)XS; (void)Hb;
    (void)cosT; (void)sinT; (void)SMp; (void)pstart; (void)texp; (void)ntl; (void)X;

    if constexpr (SLOT == 0) { phase_prologue(args.in, ws, lds, gw, NGW, lane, wave, gtid, NTH); }
    if constexpr (SLOT == 1) {
        Sched S{T / 256, 12, (T / 256) * 12, G, (int)blockIdx.x, (const char*)XB, (const char*)(ws + WS_WQKV) + (size_t)i2 * 3072 * DM * 2, (size_t)256 * DM * 2, 0, (size_t)256 * DM * 2, 0, nullptr};
        EpiQKV E{Qb, (size_t)(WS_K - WS_Q) / 2, cosT, sinT};
        pg8::gemm_phase<EpiQKV, Sched, true>(lds, pg8::Gemm{DM, DM, DM}, S, E);
    }
    if constexpr (SLOT == 2) {
        AttnP P{Qb, Kb, Vb, Ob, OP, LSE};
        phase_attention(P, SMp + SM_RPB + (size_t)i2 * 8 * 465, lds, gw, NGW, tid, lane, wave);
    }
    if constexpr (SLOT == 3) { phase_merge(OP, LSE, Ob, gtid, NTH); }
    if constexpr (SLOT == 4) {
        Sched S{T / 256, 4, (T / 256) * 4, G, (int)blockIdx.x, (const char*)Ob, (const char*)(ws + WS_WO) + (size_t)i2 * DM * DM * 2, (size_t)256 * DM * 2, 0, (size_t)256 * DM * 2, 0, nullptr};
        EpiRes E{layer == 0 ? args.in.x : (const float*)X, Y, nullptr};
        pg8::gemm_phase<EpiRes, Sched, true>(lds, pg8::Gemm{DM, DM, DM}, S, E);
    }
    if constexpr (SLOT == 5) { phase_pool(X, Ub, gtid, NTH); }
    if constexpr (SLOT == 6) {
        Sched S{T / 256, 4, (T / 256) * 4, G, (int)blockIdx.x, (const char*)Ub, (const char*)(ws + WS_WP) + (size_t)i2 * 4 * 65536 * 2, (size_t)256 * DM * 2, (size_t)512, (size_t)65536 * 2, 0, nullptr};
        EpiRes E{(const float*)X, Y, SMp + SM_PSC + (size_t)i2 * DM};
        pg8::gemm_phase<EpiRes, Sched, true>(lds, pg8::Gemm{DM, 256, 256}, S, E);
    }
    if constexpr (SLOT == 7) {
        phase_lnr(Y, X, XB, SMp + SM_LNG + (size_t)(layer * 2) * DM, SMp + SM_LNB + (size_t)(layer * 2) * DM, SMp + SM_RW, SMp + SM_RB, TT, cnt, lds, tid, lane, wave);
    }
    if constexpr (SLOT == 8) {
        (void)build_expert_tables(cnt, pstart, texp, ntl, tid);
        phase_scatter(XB, XS, TT, pstart, gw, NGW, lane);
    }
    if constexpr (SLOT == 9) {
        const int ntiles = build_expert_tables(cnt, pstart, texp, ntl, tid);
        Sched S{ntiles, 8, ntiles * 8, G, (int)blockIdx.x, (const char*)XS, (const char*)(ws + WS_W13) + (size_t)layer * NEXP * 2048 * DM * 2, (size_t)256 * DM * 2, 0, (size_t)256 * DM * 2, (size_t)2048 * DM * 2, texp};
        EpiSwiGLU E{Hb};
        pg8::gemm_phase<EpiSwiGLU, Sched, true>(lds, pg8::Gemm{DM, DM, DM}, S, E);
    }
    if constexpr (SLOT == 10) {
        const int ntiles = build_expert_tables(cnt, pstart, texp, ntl, tid);
        Sched S{ntiles, 4, ntiles * 4, G, (int)blockIdx.x, (const char*)Hb, (const char*)(ws + WS_W2) + (size_t)layer * NEXP * DM * DM * 2, (size_t)256 * DM * 2, 0, (size_t)256 * DM * 2, (size_t)DM * DM * 2, texp};
        EpiBf16 E{XS};
        pg8::gemm_phase<EpiBf16, Sched, true>(lds, pg8::Gemm{DM, DM, DM}, S, E);
    }
    if constexpr (SLOT == 11) {
        phase_combine(X, XB, XS, TT, SMp + SM_LNG + (size_t)(layer * 2 + 1) * DM, SMp + SM_LNB + (size_t)(layer * 2 + 1) * DM, gw, NGW, lane);
    }
}

#if MK_MULTI_LAUNCH
template <int SLOT>
__global__ void __launch_bounds__(NWAVES * 64, 2) k_slot(Args args) {
    extern __shared__ __attribute__((aligned(16))) unsigned char lds_raw[];
    LAS unsigned char* lds = (LAS unsigned char*)lds_raw;
    for (int u = threadIdx.x; u < (LDS_BYTES - RING_BYTES) / 4; u += NWAVES * 64) ((LAS unsigned*)(lds + RING_BYTES))[u] = 0u;
    __syncthreads();
    do_slot<SLOT>(args, args.layer, lds);
}
template <int SLOT> static void launch_slot(const Args& a, int grid, hipStream_t stream) {
    static bool attr_set = false;
    if (!attr_set) { (void)hipFuncSetAttribute((const void*)k_slot<SLOT>, hipFuncAttributeMaxDynamicSharedMemorySize, LDS_BYTES); attr_set = true; }
    hipLaunchKernelGGL(k_slot<SLOT>, dim3(grid), dim3(NWAVES * 64), LDS_BYTES, stream, a);
}
#else
__global__ void __launch_bounds__(NWAVES * 64, 2) fwd(Args args) {
    extern __shared__ __attribute__((aligned(16))) unsigned char lds_raw[];
    LAS unsigned char* lds = (LAS unsigned char*)lds_raw;
    volatile LAS unsigned* MISC = (volatile LAS unsigned*)(lds + MISC_OFF);
    for (int u = threadIdx.x; u < (LDS_BYTES - RING_BYTES) / 4; u += NWAVES * 64) ((LAS unsigned*)(lds + RING_BYTES))[u] = 0u;
    __syncthreads();
    const XcdBarrier bar = xcd_barrier_post((unsigned*)((gu32*)(args.ws + WS_CTL) + CW_BAR), MISC + 8);
    do_slot<0>(args, 0, lds);
#define MOE_SLOTS(L) xcd_barrier(bar); do_slot<7>(args, L, lds); xcd_barrier(bar); do_slot<8>(args, L, lds); xcd_barrier(bar); do_slot<9>(args, L, lds); \
                     xcd_barrier(bar); do_slot<10>(args, L, lds); xcd_barrier(bar); do_slot<11>(args, L, lds);
#define LAYER_ATT(L) xcd_barrier(bar); do_slot<1>(args, L, lds); xcd_barrier(bar); do_slot<2>(args, L, lds); xcd_barrier(bar); do_slot<3>(args, L, lds); xcd_barrier(bar); do_slot<4>(args, L, lds); MOE_SLOTS(L)
#define LAYER_POOL(L) xcd_barrier(bar); do_slot<5>(args, L, lds); xcd_barrier(bar); do_slot<6>(args, L, lds); MOE_SLOTS(L)
    LAYER_ATT(0) LAYER_POOL(1) LAYER_ATT(2) LAYER_POOL(3)
#undef MOE_SLOTS
#undef LAYER_ATT
#undef LAYER_POOL
}
#endif

extern "C" void kernel_launch(void* const* d_in, const int* in_sizes, int n_in, void* d_out, int out_size, void* d_ws, size_t ws_size, hipStream_t stream) {
    static int grid = 0;
    if (grid == 0) {
        if (n_in != 13 || in_sizes[0] != T * DM || out_size != T * DM || ws_size < WS_END) {
            fprintf(stderr, "kernel_launch: unexpected shapes (n_in %d, in0 %d, out %d, ws %zu; need ws >= %zu); nothing launched\n", n_in, n_in > 0 ? in_sizes[0] : -1, out_size, ws_size, (size_t)WS_END); grid = -1; return; }
        int dev = 0, cus = 0;
        if (hipGetDevice(&dev) != hipSuccess || hipDeviceGetAttribute(&cus, hipDeviceAttributeMultiprocessorCount, dev) != hipSuccess) { fprintf(stderr, "kernel_launch: device query failed\n"); grid = -1; return; }
#if !MK_MULTI_LAUNCH
        int per_cu = 0;
        if (hipFuncSetAttribute((const void*)fwd, hipFuncAttributeMaxDynamicSharedMemorySize, LDS_BYTES) != hipSuccess) { fprintf(stderr, "kernel_launch: hipFuncSetAttribute failed\n"); grid = -1; return; }
        if (hipOccupancyMaxActiveBlocksPerMultiprocessor(&per_cu, (const void*)fwd, NWAVES * 64, LDS_BYTES) != hipSuccess || per_cu < 1)
            fprintf(stderr, "kernel_launch: note: occupancy query reports %d workgroups per CU\n", per_cu);
        (void)hipGetLastError();
#endif
        grid = cus;
    }
    if (grid < 0) return;
    if (hipMemsetAsync((char*)d_ws + WS_CTL, 0, CTL_ZERO_BYTES, stream) != hipSuccess) { fprintf(stderr, "kernel_launch: memset failed\n"); return; }
    Args a{};
    const float** ip = (const float**)&a.in;
    for (int i = 0; i < 13; ++i) ip[i] = (const float*)d_in[i];
    a.out = (float*)d_out; a.ws = (unsigned char*)d_ws; a.layer = 0; a.pad = 0;
#if MK_MULTI_LAUNCH
    launch_slot<0>(a, grid, stream);
    for (int layer = 0; layer < DEPTH; ++layer) {
        a.layer = layer;
        if ((layer & 1) == 0) { launch_slot<1>(a, grid, stream); launch_slot<2>(a, grid, stream); launch_slot<3>(a, grid, stream); launch_slot<4>(a, grid, stream); }
        else { launch_slot<5>(a, grid, stream); launch_slot<6>(a, grid, stream); }
        launch_slot<7>(a, grid, stream); launch_slot<8>(a, grid, stream); launch_slot<9>(a, grid, stream); launch_slot<10>(a, grid, stream); launch_slot<11>(a, grid, stream);
    }
#else
    hipLaunchKernelGGL(fwd, dim3(grid), dim3(NWAVES * 64), LDS_BYTES, stream, a);
#endif
    const hipError_t le = hipPeekAtLastError();
    if (le != hipSuccess) fprintf(stderr, "kernel_launch: launch failed: %s\n", hipGetErrorName(le));
}
```

```cpp
#include <hip/hip_runtime.h>
#include <cstdio>
#include <cstdint>
#include <cmath>

#ifndef MK_MULTI_LAUNCH
#define MK_MULTI_LAUNCH 0
#endif

namespace pg8 {
#define PG8_LAS __attribute__((address_space(3)))
typedef unsigned short bf16_t;
typedef short bf16x8 __attribute__((ext_vector_type(8)));
typedef float f32x4 __attribute__((ext_vector_type(4)));
typedef unsigned u32x4 __attribute__((ext_vector_type(4)));
constexpr int BM = 256, BK = 64, HALF = 128, HTB = HALF * BK * 2  , STAGE_BYTES = 8 * HTB, NXCD = 8, WGM = 8;

__host__ __device__ __forceinline__ int lds_byte(int r, int c) { const int st = (r >> 4) * 2 + (c >> 5), rr = r & 15, cc = c & 31, ob = rr * 64 + cc * 2; return st * 1024 + (ob ^ (((ob >> 9) & 1) << 5)); }
__host__ __device__ __forceinline__ void stage_rc(int b, int& R, int& C) { const int st = b / 1024, sb = b % 1024, swz = sb ^ (((sb >> 9) & 1) << 5); R = (st >> 1) * 16 + swz / 64; C = (st & 1) * 32 + (swz % 64) / 2; }
__host__ __device__ __forceinline__ int perm32(int rho) { const int n = rho >> 4, i = rho & 15; return 8 * (i >> 2) + 4 * n + (i & 3); }

struct Unit { int pm, pn; };
struct Gemm { int lda, ldb, K; };

typedef _Float16 h16x8 __attribute__((ext_vector_type(8))); typedef _Float16 h16x2 __attribute__((ext_vector_type(2))); typedef float f32x2 __attribute__((ext_vector_type(2)));
__device__ __forceinline__ unsigned cvt_pk16(float lo, float hi) { const f32x2 v = {lo, hi}; const h16x2 b = __builtin_convertvector(v, h16x2); return __builtin_bit_cast(unsigned, b); }

template <class Epi, class Sched, bool ALIGN_EPI>
__device__ __forceinline__ void gemm_phase(PG8_LAS unsigned char* lds, const Gemm g, const Sched& S, const Epi& E) {
    int tid_ = threadIdx.x; asm volatile("" : "+v"(tid_));
    const int tid = tid_, wid = __builtin_amdgcn_readfirstlane(tid >> 6), lane = tid & 63, wr = wid >> 2, wc = wid & 3, fr = lane & 15, fq = lane >> 4;
    const int K = g.K, nt = K / BK;
    unsigned voffA[2], voffB[2];
#pragma unroll
    for (int i = 0; i < 2; ++i) { int R, C; stage_rc(tid * 16 + i * 8192, R, C); const int Rb = 64 * (R >> 5) + perm32(R & 31);
        voffA[i] = (unsigned)(R * g.lda + C) * 2u; voffB[i] = (unsigned)(Rb * g.ldb + C) * 2u; }
    const size_t kstep = (size_t)(BK * 2);
    const size_t hstepA = (size_t)HALF * g.lda * 2;
    const size_t hstepB = (size_t)32 * g.ldb * 2;
    const unsigned ldsw = (unsigned)wid * 1024u;
    const int aoff = lds_byte(wr * 64 + fr, fq * 8), boff = lds_byte(wc * 32 + fr, fq * 8);
#define PG8_SA(b, h) (((b) * 2 + (h)) * HTB)
#define PG8_SB(b, h) ((4 + (b) * 2 + (h)) * HTB)
#define PG8_STAGE(bufoff, gbase, voff) do { _Pragma("unroll") for (int _i = 0; _i < 2; ++_i) \
        __builtin_amdgcn_global_load_lds((const unsigned*)((const char*)(gbase) + (voff)[_i]), (PG8_LAS unsigned*)(lds + (bufoff) + ldsw + _i * 8192), 16, 0, 0); } while (0)
#define PG8_LDA(dst, b, h) do { _Pragma("unroll") for (int m = 0; m < 4; ++m) _Pragma("unroll") for (int k = 0; k < 2; ++k) dst[m][k] = *(const PG8_LAS bf16x8*)(lds + PG8_SA(b, h) + aoff + m * 2048 + k * 1024); } while (0)
#define PG8_LDB(dst, b, h) do { _Pragma("unroll") for (int n = 0; n < 2; ++n) _Pragma("unroll") for (int k = 0; k < 2; ++k) dst[n][k] = *(const PG8_LAS bf16x8*)(lds + PG8_SB(b, h) + boff + n * 2048 + k * 1024); } while (0)
#define PG8_MMA(ai, bj, At, Bt) do { __builtin_amdgcn_s_setprio(1); _Pragma("unroll") for (int m = 0; m < 4; ++m) _Pragma("unroll") for (int n = 0; n < 2; ++n) _Pragma("unroll") for (int k = 0; k < 2; ++k) \
        acc[ai][bj][m][n] = __builtin_amdgcn_mfma_f32_16x16x32_f16(__builtin_bit_cast(h16x8, Bt[n][k]), __builtin_bit_cast(h16x8, At[m][k]), acc[ai][bj][m][n], 0, 0, 0); __builtin_amdgcn_s_setprio(0); } while (0)
#define PG8_WAIT_V(n) asm volatile("s_waitcnt vmcnt(" #n ")" ::: "memory")
#define PG8_WAIT_L(n) asm volatile("s_waitcnt lgkmcnt(" #n ")" ::: "memory")
#define PG8_BAR __builtin_amdgcn_s_barrier()
#define PG8_SCHED __builtin_amdgcn_sched_barrier(0)
    Unit cur, nxt; int ui = 0;
    const char* cA; const char* cB; const char* nA; const char* nB;
    if (!S.next(0, cur.pm, cur.pn, cA, cB)) return;
    f32x4 acc[2][2][4][2];
#pragma unroll
    for (int a = 0; a < 2; ++a)
#pragma unroll
        for (int b = 0; b < 2; ++b)
#pragma unroll
            for (int m = 0; m < 4; ++m)
#pragma unroll
                for (int n = 0; n < 2; ++n) acc[a][b][m][n] = (f32x4){0.f, 0.f, 0.f, 0.f};
    bf16x8 At[4][2], B0[2][2], B1[2][2];
    PG8_STAGE(PG8_SB(0, 0), cB, voffB); PG8_STAGE(PG8_SB(0, 1), cB + hstepB, voffB); PG8_STAGE(PG8_SA(0, 0), cA, voffA); PG8_STAGE(PG8_SA(0, 1), cA + hstepA, voffA);
    if (wr == 1) PG8_BAR;
    PG8_WAIT_V(2); PG8_BAR;
    PG8_STAGE(PG8_SB(1, 0), cB + kstep, voffB); PG8_STAGE(PG8_SA(1, 0), cA + kstep, voffA); PG8_STAGE(PG8_SB(1, 1), cB + hstepB + kstep, voffB);
    PG8_WAIT_V(6); PG8_BAR;
    for (;;) {
        const bool has_next = S.next(ui + 1, nxt.pm, nxt.pn, nA, nB);
        if (!has_next) { nA = cA; nB = cB; }
        for (int t = 0; t < nt; t += 2) {
            const bool last = (t == nt - 2);
            const char* a1 = cA + (size_t)(t + 1) * kstep;
            const char* a2 = last ? nA : cA + (size_t)(t + 2) * kstep; const char* b2 = last ? nB : cB + (size_t)(t + 2) * kstep;
            const char* a3 = a2 + kstep; const char* b3 = b2 + kstep;
            PG8_LDB(B0, 0, 0); PG8_LDB(B1, 0, 1); PG8_SCHED; PG8_LDA(At, 0, 0); PG8_STAGE(PG8_SA(1, 1), a1 + hstepA, voffA);
            PG8_WAIT_V(8); PG8_WAIT_L(0); PG8_BAR; PG8_MMA(0, 0, At, B0); PG8_MMA(0, 1, At, B1); PG8_BAR; PG8_SCHED;
            PG8_LDA(At, 0, 1); PG8_STAGE(PG8_SB(0, 0), b2, voffB); PG8_STAGE(PG8_SB(0, 1), b2 + hstepB, voffB); PG8_STAGE(PG8_SA(0, 0), a2, voffA);
            PG8_WAIT_V(8); PG8_WAIT_L(0); PG8_BAR; PG8_MMA(1, 0, At, B0); PG8_MMA(1, 1, At, B1); PG8_BAR; PG8_SCHED;
            PG8_LDB(B0, 1, 0); PG8_LDB(B1, 1, 1); PG8_SCHED; PG8_LDA(At, 1, 0); PG8_STAGE(PG8_SA(0, 1), a2 + hstepA, voffA);
            PG8_WAIT_V(8); PG8_WAIT_L(0); PG8_BAR; PG8_MMA(0, 0, At, B0); PG8_MMA(0, 1, At, B1); PG8_BAR; PG8_SCHED;
            PG8_LDA(At, 1, 1); PG8_STAGE(PG8_SB(1, 0), b3, voffB); PG8_STAGE(PG8_SB(1, 1), b3 + hstepB, voffB); PG8_STAGE(PG8_SA(1, 0), a3, voffA);
            PG8_WAIT_V(8); PG8_WAIT_L(0); PG8_BAR; PG8_MMA(1, 0, At, B0); PG8_MMA(1, 1, At, B1); PG8_BAR; PG8_SCHED;
        }
        if constexpr (ALIGN_EPI) { if (wr == 0) PG8_BAR; }
        E(acc, cur, wr, wc, fr, fq);
        if (!has_next) break;
#pragma unroll
        for (int a = 0; a < 2; ++a)
#pragma unroll
            for (int b = 0; b < 2; ++b)
#pragma unroll
                for (int m = 0; m < 4; ++m)
#pragma unroll
                    for (int n = 0; n < 2; ++n) acc[a][b][m][n] = (f32x4){0.f, 0.f, 0.f, 0.f};
        cur.pm = nxt.pm; cur.pn = nxt.pn; cA = nA; cB = nB; ++ui;
        if constexpr (ALIGN_EPI) { if (wr == 1) PG8_BAR; }
    }
    PG8_WAIT_V(0);
    if constexpr (!ALIGN_EPI) { if (wr == 0) PG8_BAR; }
    PG8_BAR;
#undef PG8_SA
#undef PG8_SB
#undef PG8_STAGE
#undef PG8_LDA
#undef PG8_LDB
#undef PG8_MMA
#undef PG8_WAIT_V
#undef PG8_WAIT_L
#undef PG8_BAR
#undef PG8_SCHED
}
}

constexpr int NWAVES = 8;
constexpr int BATCH = 4, SEQ = 8192, DM = 1024, T = BATCH * SEQ, DEPTH = 4;
constexpr int NEXP = 16;
constexpr int PROWS = 2 * T + NEXP * 256;
constexpr float LN_EPS = 1e-5f;
constexpr float ALPHA = 1.681792830507429f;
constexpr float QSCALE = 0.125f * 1.4426950408889634f;
constexpr float LOG2E = 1.4426950408889634f;

constexpr size_t MiB = 1u << 20;
constexpr size_t WS_CTL = 0, CTL_ZERO_BYTES = 1 * MiB;
constexpr size_t WS_ROPE = 1 * MiB;
constexpr size_t WS_WQKV = 3 * MiB;
constexpr size_t WS_WO = 15 * MiB;
constexpr size_t WS_WP = 19 * MiB;
constexpr size_t WS_W13 = 20 * MiB;
constexpr size_t WS_W2 = 276 * MiB;
constexpr size_t WS_XB = 404 * MiB;
constexpr size_t WS_Y = 468 * MiB;
constexpr size_t WS_OP = WS_Y, WS_LSE = WS_Y + 96 * MiB;
constexpr size_t WS_R = 596 * MiB;
constexpr size_t WS_Q = WS_R, WS_K = WS_R + 64 * MiB, WS_V = WS_R + 128 * MiB, WS_O = WS_R + 192 * MiB;
constexpr size_t WS_U = WS_R;
constexpr size_t WS_XS = WS_R, WS_H = WS_R + 136 * MiB;
constexpr size_t WS_TOK = 868 * MiB;
constexpr size_t WS_SMALL = 869 * MiB;
constexpr int SM_RPB = 0, SM_PSC = 7440, SM_RW = 9488, SM_RB = 25872, SM_LNG = 25888, SM_LNB = 34080, SM_END = 42272;
constexpr size_t WS_END = 870 * MiB;
static_assert((size_t)PROWS * DM * 2 <= 136 * MiB && WS_H + 136 * MiB <= WS_TOK, "d_ws map");

constexpr int CW_BAR = 4096;
constexpr int CW_CNT = 16384;

constexpr int RING_BYTES = 131072;
constexpr int MISC_OFF = RING_BYTES + 320;
constexpr int LDS_BYTES = 147456;
constexpr int TEXP_OFF = RING_BYTES + 1024;

#define GAS __attribute__((address_space(1)))
#define LAS __attribute__((address_space(3)))
typedef unsigned short bf16;
typedef unsigned v4u __attribute__((ext_vector_type(4)));
typedef unsigned v2u __attribute__((ext_vector_type(2)));
typedef float f32x4 __attribute__((ext_vector_type(4)));
typedef float f32x16 __attribute__((ext_vector_type(16)));
typedef short bf16x8 __attribute__((ext_vector_type(8)));
typedef short s16x4 __attribute__((ext_vector_type(4)));
typedef GAS unsigned gu32;
#define RLX_AGENT __ATOMIC_RELAXED, __HIP_MEMORY_SCOPE_AGENT
#define LDS_WAIT() asm volatile("s_waitcnt lgkmcnt(0)" ::: "memory")
__device__ __forceinline__ unsigned pk2(float lo, float hi) { return pg8::cvt_pk16(lo, hi); }
__device__ __forceinline__ float bf_lo(unsigned u) { return (float)__builtin_bit_cast(pg8::h16x2, u)[0]; }
__device__ __forceinline__ float bf_hi(unsigned u) { return (float)__builtin_bit_cast(pg8::h16x2, u)[1]; }

#define XB_TMO      128
#define XB_XCNT(j)  (256  + 64 * (j))
#define XB_XSUB(j)  (1280 + 64 * (j))
#define XB_XGEN(j)  (2304 + 64 * (j))
#define XB_TOP      3328
#define XB_TOPGEN   3392
#define XCD_BAR_WORDS 3456
#define XB_SPIN_CAP (1u << 18)

__device__ __forceinline__ unsigned xb_ld(unsigned* p)              { return __hip_atomic_load(p, __ATOMIC_RELAXED, __HIP_MEMORY_SCOPE_AGENT); }
__device__ __forceinline__ unsigned xb_add(unsigned* p, unsigned v) { return __hip_atomic_fetch_add(p, v, __ATOMIC_RELAXED, __HIP_MEMORY_SCOPE_AGENT); }
__device__ __forceinline__ unsigned xb_xcc_id() { return (unsigned)__builtin_amdgcn_s_getreg((3 << 11) | 20) & 0xFu; }
#define XB_SPIN(cond, bar) do { unsigned _sp = 0; while (cond) { __builtin_amdgcn_s_sleep(1); \
    if ((++_sp & 255u) == 0u) { if (xb_ld(&(bar)[XB_TMO])) break; if (_sp > XB_SPIN_CAP) { atomicAdd(&(bar)[XB_TMO], 1u); break; } } } } while (0)

struct XcdBarrier { unsigned* bar; unsigned x; volatile LAS unsigned* st; };

__device__ __forceinline__ XcdBarrier xcd_barrier_post(unsigned* bar, volatile LAS unsigned* st) {
    XcdBarrier b; b.bar = bar; b.x = xb_xcc_id(); b.st = st;
    if (threadIdx.x == 0) (void)xb_add(&bar[XB_XCNT(b.x)], 1u);
    return b;
}
__device__ __forceinline__ void xcd_barrier_complete(unsigned* bar, unsigned x, unsigned& nloc, unsigned& nx) {
    const unsigned G = gridDim.x * gridDim.y * gridDim.z;
    unsigned sum, cnt, mine, sp = 0u;
    for (;;) {
        sum = 0u; cnt = 0u; mine = 0u;
#pragma unroll
        for (unsigned j = 0; j < 16; ++j) { const unsigned c = xb_ld(&bar[XB_XCNT(j)]); sum += c; cnt += (c > 0u) ? 1u : 0u; mine = (j == x) ? c : mine; }
        if (sum == G) break;
        __builtin_amdgcn_s_sleep(1);
        if ((++sp & 255u) == 0u) { if (xb_ld(&bar[XB_TMO])) break; if (sp > XB_SPIN_CAP) { atomicAdd(&bar[XB_TMO], 1u); break; } }
    }
    nloc = mine > 0u ? mine : 1u; nx = cnt > 0u ? cnt : 1u;
}
__device__ __forceinline__ void xcd_barrier(const XcdBarrier& b) {
    asm volatile("s_waitcnt vmcnt(0)" ::: "memory");
    __syncthreads();
    int tid_ = threadIdx.x; asm volatile("" : "+v"(tid_));
    if (tid_ == 0) {
        unsigned* bar = b.bar; asm volatile("" : "+s"(bar));
        __builtin_amdgcn_s_waitcnt(0);
        unsigned nloc = b.st[0], nx = b.st[1];
        if (nloc == 0u) { xcd_barrier_complete(bar, b.x, nloc, nx); b.st[0] = nloc; b.st[1] = nx; }
        const unsigned old = xb_add(&bar[XB_XSUB(b.x)], 1u);
        const unsigned gen = old / nloc;
        if (old + 1u == (gen + 1u) * nloc) {
            __builtin_amdgcn_fence(__ATOMIC_RELEASE, "agent");
            asm volatile("s_waitcnt vmcnt(0)" ::: "memory");
            const unsigned og = xb_add(&bar[XB_TOP], 1u);
            const unsigned tg = og / nx;
            if (og + 1u == (tg + 1u) * nx) xb_add(&bar[XB_TOPGEN], 1u);
            else XB_SPIN(xb_ld(&bar[XB_TOPGEN]) == tg, bar);
            __builtin_amdgcn_fence(__ATOMIC_ACQUIRE, "agent");
            xb_add(&bar[XB_XGEN(b.x)], 1u);
            asm volatile("s_waitcnt vmcnt(0)" ::: "memory");
        } else {
            XB_SPIN(xb_ld(&bar[XB_XGEN(b.x)]) == gen, bar);
            __builtin_amdgcn_fence(__ATOMIC_ACQUIRE, "agent");
            asm volatile("s_waitcnt vmcnt(0)" ::: "memory");
        }
    }
    __syncthreads();
}

struct Sched {
    int nM, nN, nwg, G, c;
    const char* A; const char* B; size_t a_tile, a_pn, b_tile, e_bytes; const LAS unsigned char* texp;
    __device__ __forceinline__ bool next(int i, int& pm, int& pn, const char*& pa, const char*& pb) const {
        const long L = (long)i * G + c; if (L >= nwg) return false;
        int wgid = (int)L; { const int q = nwg / pg8::NXCD, r = nwg % pg8::NXCD, xcd = wgid % pg8::NXCD, off = wgid / pg8::NXCD; wgid = (xcd < r ? xcd * (q + 1) : r * (q + 1) + (xcd - r) * q) + off; }
        const int nig = pg8::WGM * nN, gid = wgid / nig, fm = gid * pg8::WGM, gsz = (nM - fm) < pg8::WGM ? (nM - fm) : pg8::WGM;
        pm = fm + ((wgid % nig) % gsz); pn = (wgid % nig) / gsz;
        pa = A + (size_t)pm * a_tile + (size_t)pn * a_pn;
        const char* bb = B + (size_t)pn * b_tile;
        if (texp) { const int e = __builtin_amdgcn_readfirstlane((int)texp[pm]); bb += (size_t)e * e_bytes; }
        pb = bb; return true;
    }
};

using pg8::f32x4;

struct EpiQKV {
    bf16* Q; size_t kv_stride; const float* cosT; const float* sinT;
    __device__ __forceinline__ void operator()(const f32x4 (&acc)[2][2][4][2], const pg8::Unit& u, int wr, int wc, int fr, int fq) const {
        const int sel = u.pn >> 2, head = 4 * (u.pn & 3) + wc;
        bf16* base = Q + (size_t)sel * kv_stride;
        const bool rope = (sel < 2) && ((u.pn & 3) < 2);
        const float sc = sel == 0 ? QSCALE : 1.f;
        const int col0 = 64 * head + 8 * fq;
#pragma unroll
        for (int ai = 0; ai < 2; ++ai)
#pragma unroll
            for (int m = 0; m < 4; ++m) {
                const int row = u.pm * 256 + ai * 128 + wr * 64 + m * 16 + fr;
                f32x4 a0 = acc[ai][0][m][0], a1 = acc[ai][0][m][1], b0 = acc[ai][1][m][0], b1 = acc[ai][1][m][1];
                if (rope) {
                    const int s = row & (SEQ - 1);
                    const f32x4 c0 = *(const f32x4*)(cosT + s * 32 + 8 * fq), c1 = *(const f32x4*)(cosT + s * 32 + 8 * fq + 4);
                    const f32x4 s0 = *(const f32x4*)(sinT + s * 32 + 8 * fq), s1 = *(const f32x4*)(sinT + s * 32 + 8 * fq + 4);
                    const f32x4 na0 = a0 * c0 - b0 * s0, nb0 = b0 * c0 + a0 * s0, na1 = a1 * c1 - b1 * s1, nb1 = b1 * c1 + a1 * s1;
                    a0 = na0; b0 = nb0; a1 = na1; b1 = nb1;
                }
                a0 = a0 * sc; a1 = a1 * sc; b0 = b0 * sc; b1 = b1 * sc;
                bf16* rowp = base + (size_t)row * DM + col0;
                v4u w; w.x = pg8::cvt_pk16(a0[0], a0[1]); w.y = pg8::cvt_pk16(a0[2], a0[3]); w.z = pg8::cvt_pk16(a1[0], a1[1]); w.w = pg8::cvt_pk16(a1[2], a1[3]);
                *(v4u*)rowp = w;
                v4u x; x.x = pg8::cvt_pk16(b0[0], b0[1]); x.y = pg8::cvt_pk16(b0[2], b0[3]); x.z = pg8::cvt_pk16(b1[0], b1[1]); x.w = pg8::cvt_pk16(b1[2], b1[3]);
                *(v4u*)(rowp + 32) = x;
                asm volatile("" ::: "memory");
            }
    }
};
struct EpiRes {
    bf16* XBp; const float* csc;
    __device__ __forceinline__ void operator()(const f32x4 (&acc)[2][2][4][2], const pg8::Unit& u, int wr, int wc, int fr, int fq) const {
        const int col0 = u.pn * 256 + 64 * wc + 8 * fq;
#pragma unroll
        for (int ai = 0; ai < 2; ++ai)
#pragma unroll
            for (int m = 0; m < 4; ++m) {
                const size_t off = (size_t)(u.pm * 256 + ai * 128 + wr * 64 + m * 16 + fr) * DM + col0;
#pragma unroll
                for (int bj = 0; bj < 2; ++bj) {
                    const v4u xr = *(const v4u*)(XBp + off + 32 * bj);
                    f32x4 a0 = acc[ai][bj][m][0], a1 = acc[ai][bj][m][1];
                    if (csc) { a0 = a0 * *(const f32x4*)(csc + col0 + 32 * bj); a1 = a1 * *(const f32x4*)(csc + col0 + 32 * bj + 4); }
                    v4u w;
                    w.x = pg8::cvt_pk16(bf_lo(xr.x) * ALPHA + a0[0], bf_hi(xr.x) * ALPHA + a0[1]); w.y = pg8::cvt_pk16(bf_lo(xr.y) * ALPHA + a0[2], bf_hi(xr.y) * ALPHA + a0[3]);
                    w.z = pg8::cvt_pk16(bf_lo(xr.z) * ALPHA + a1[0], bf_hi(xr.z) * ALPHA + a1[1]); w.w = pg8::cvt_pk16(bf_lo(xr.w) * ALPHA + a1[2], bf_hi(xr.w) * ALPHA + a1[3]);
                    *(v4u*)(XBp + off + 32 * bj) = w;
                }
                asm volatile("" ::: "memory");
            }
    }
};
struct EpiSwiGLU {
    bf16* H;
    __device__ __forceinline__ void operator()(const f32x4 (&acc)[2][2][4][2], const pg8::Unit& u, int wr, int wc, int fr, int fq) const {
        const int col0 = u.pn * 128 + 32 * wc + 8 * fq;
#pragma unroll
        for (int ai = 0; ai < 2; ++ai)
#pragma unroll
            for (int m = 0; m < 4; ++m) {
                const size_t off = (size_t)(u.pm * 256 + ai * 128 + wr * 64 + m * 16 + fr) * DM + col0;
                float h[8];
#pragma unroll
                for (int n = 0; n < 2; ++n)
#pragma unroll
                    for (int e = 0; e < 4; ++e) {
                        const float gt = acc[ai][0][m][n][e], up = acc[ai][1][m][n][e];
                        const float sg = gt * __builtin_amdgcn_rcpf(1.f + __builtin_amdgcn_exp2f(-gt * LOG2E));
                        h[4 * n + e] = sg * up;
                    }
                v4u w; w.x = pg8::cvt_pk16(h[0], h[1]); w.y = pg8::cvt_pk16(h[2], h[3]); w.z = pg8::cvt_pk16(h[4], h[5]); w.w = pg8::cvt_pk16(h[6], h[7]);
                *(v4u*)(H + off) = w;
                asm volatile("" ::: "memory");
            }
    }
};
struct EpiBf16 {
    bf16* O;
    __device__ __forceinline__ void operator()(const f32x4 (&acc)[2][2][4][2], const pg8::Unit& u, int wr, int wc, int fr, int fq) const {
        const int col0 = u.pn * 256 + 64 * wc + 8 * fq;
#pragma unroll
        for (int ai = 0; ai < 2; ++ai)
#pragma unroll
            for (int m = 0; m < 4; ++m) {
                const size_t off = (size_t)(u.pm * 256 + ai * 128 + wr * 64 + m * 16 + fr) * DM + col0;
#pragma unroll
                for (int bj = 0; bj < 2; ++bj) {
                    const f32x4 v0 = acc[ai][bj][m][0], v1 = acc[ai][bj][m][1];
                    v4u w; w.x = pg8::cvt_pk16(v0[0], v0[1]); w.y = pg8::cvt_pk16(v0[2], v0[3]); w.z = pg8::cvt_pk16(v1[0], v1[1]); w.w = pg8::cvt_pk16(v1[2], v1[3]);
                    *(v4u*)(O + off + 32 * bj) = w;
                }
                asm volatile("" ::: "memory");
            }
    }
};

__device__ __forceinline__ float wave_sum(float v) {
#pragma unroll
    for (int o = 1; o < 64; o <<= 1) v += __shfl_xor(v, o);
    return v;
}
__device__ __forceinline__ unsigned cvtpk_s(float lo, float hi) { return pg8::cvt_pk16(lo, hi); }

__device__ __forceinline__ void p0_transpose_item(const float* W, int K, int N, bf16* WT, int k0, int n0, int drow, LAS float* scr, int lane) {
#pragma unroll 8
    for (int i = 0; i < 32; ++i) { const int kk = 2 * i + (lane >> 5); scr[kk * 33 + (lane & 31)] = W[(size_t)(k0 + kk) * N + n0 + (lane & 31)]; }
    LDS_WAIT(); asm volatile("" ::: "memory");
    const int c = lane & 7;
#pragma unroll
    for (int j = 0; j < 4; ++j) { const int n = (lane >> 3) + 8 * j; const LAS float* s = scr + (8 * c) * 33 + n;
        v4u o; o.x = pk2(s[0 * 33], s[1 * 33]); o.y = pk2(s[2 * 33], s[3 * 33]); o.z = pk2(s[4 * 33], s[5 * 33]); o.w = pk2(s[6 * 33], s[7 * 33]);
        *(GAS v4u*)(WT + (size_t)(drow + n) * K + k0 + 8 * c) = o; }
    LDS_WAIT(); asm volatile("" ::: "memory");
}
struct InPtrs { const float *x, *w_in, *w_out, *rpb, *pool_w, *pool_scale, *router_w, *router_bias, *w1, *w3, *w2, *ln_g, *ln_b; };

__device__ __forceinline__ void sincos_d(double a, double& sn, double& cs) {
    const double n = __builtin_rint(a * 0.63661977236758134308);
    double r = __builtin_fma(-n, 1.57079632679489655800e+00, a); r = __builtin_fma(-n, 6.12323399573676603587e-17, r);
    const double z = r * r;
    const double sp = r + r * z * (-1.66666666666666324348e-01 + z * (8.33333333332248946124e-03 + z * (-1.98412698298579493134e-04 + z * (2.75573137070700676789e-06 + z * (-2.50507602534068634195e-08 + z * 1.58969099521155010221e-10)))));
    const double cp = 1.0 - 0.5 * z + z * z * (4.16666666666666019037e-02 + z * (-1.38888888888741095749e-03 + z * (2.48015872894767294178e-05 + z * (-2.75573143513906633035e-07 + z * (2.08757232129817482790e-09 + z * -1.13596475577881948265e-11)))));
    const int q = (int)((long long)n & 3);
    sn = (q == 0) ? sp : (q == 1) ? cp : (q == 2) ? -sp : -cp;
    cs = (q == 0) ? cp : (q == 1) ? -sp : (q == 2) ? -cp : sp;
}

__device__ __forceinline__ void phase_prologue(const InPtrs& in, unsigned char* ws, LAS unsigned char* lds, int gw, int NGW, int lane, int wave, int gtid, int NTH) {
    LAS float* scr = (LAS float*)(lds + wave * 16384);
    constexpr int MOE_ITEMS = DEPTH * NEXP * 3 * 512, IN_ITEMS = 2 * 1536, OUT_ITEMS = 2 * 512, POOL_ITEMS = 8 * 32;
    constexpr int NITEMS = MOE_ITEMS + IN_ITEMS + OUT_ITEMS + POOL_ITEMS;
    for (int it = gw; it < NITEMS; it += NGW) {
        int r = it;
        if (r < MOE_ITEMS) {
            const int mat = r >> 9, loc = r & 511, le = mat / 3, which = mat - 3 * le;
            const int kb = loc >> 5, nb = loc & 31;
            const float* src = (which == 0 ? in.w1 : which == 1 ? in.w3 : in.w2) + (size_t)le * DM * DM;
            if (which < 2) p0_transpose_item(src, DM, DM, (bf16*)(ws + WS_W13) + (size_t)le * 2048 * DM, 64 * kb, 32 * nb, 64 * nb + 32 * which, scr, lane);
            else           p0_transpose_item(src, DM, DM, (bf16*)(ws + WS_W2) + (size_t)le * DM * DM, 64 * kb, 32 * nb, 32 * nb, scr, lane);
            continue;
        }
        r -= MOE_ITEMS;
        if (r < IN_ITEMS) { const int i = r / 1536, loc = r - 1536 * i, kb = loc / 96, nb = loc - 96 * kb;
            p0_transpose_item(in.w_in + (size_t)i * DM * 3072, DM, 3072, (bf16*)(ws + WS_WQKV) + (size_t)i * 3072 * DM, 64 * kb, 32 * nb, 32 * nb, scr, lane); continue; }
        r -= IN_ITEMS;
        if (r < OUT_ITEMS) { const int i = r >> 9, loc = r & 511, kb = loc >> 5, nb = loc & 31;
            p0_transpose_item(in.w_out + (size_t)i * DM * DM, DM, DM, (bf16*)(ws + WS_WO) + (size_t)i * DM * DM, 64 * kb, 32 * nb, 32 * nb, scr, lane); continue; }
        r -= OUT_ITEMS;
        { const int mat = r >> 5, loc = r & 31, kb = loc >> 3, nb = loc & 7;
            p0_transpose_item(in.pool_w + (size_t)mat * 65536, 256, 256, (bf16*)(ws + WS_WP) + (size_t)mat * 65536, 64 * kb, 32 * nb, 32 * nb, scr, lane); }
    }
    bf16* XB = (bf16*)(ws + WS_XB);
    for (int m = gw; m < T; m += NGW) {
        const GAS f32x4* xr = (const GAS f32x4*)(in.x + (size_t)m * DM) + lane;
        GAS unsigned long long* o8 = (GAS unsigned long long*)(XB + (size_t)m * DM) + lane;
#pragma unroll
        for (int j = 0; j < 4; ++j) { const f32x4 v = xr[64 * j]; o8[64 * j] = (unsigned long long)pk2(v.x, v.y) | ((unsigned long long)pk2(v.z, v.w) << 32); }
    }
    { float* sm = (float*)(ws + WS_SMALL);
      for (int i = gtid; i < SM_END; i += NTH) {
          float v;
          if (i < SM_PSC) v = in.rpb[i]; else if (i < SM_RW) v = in.pool_scale[i - SM_PSC]; else if (i < SM_RB) v = in.router_w[i - SM_RW];
          else if (i < SM_LNG) v = in.router_bias[i - SM_RB]; else if (i < SM_LNB) v = in.ln_g[i - SM_LNG]; else v = in.ln_b[i - SM_LNB];
          sm[i] = v; } }
    float* cosT = (float*)(ws + WS_ROPE); float* sinT = cosT + SEQ * 32;
    for (int idx = gw * 64 + lane; idx < SEQ * 32; idx += NGW * 64) {
        const int s = idx >> 5, i = idx & 31;
        double invf = 1.0;
        if (i & 1) invf *= 0.7498942093324559; if (i & 2) invf *= 0.5623413251903491; if (i & 4) invf *= 0.31622776601683794; if (i & 8) invf *= 0.1; if (i & 16) invf *= 0.01;
        double sn, cs; sincos_d((double)s * invf, sn, cs);
        cosT[idx] = (float)cs; sinT[idx] = (float)sn;
    }
}

struct AttnP { const bf16* Q; const bf16* K; const bf16* V; bf16* O; bf16* OP; float* LSE; };
constexpr int V_RS = 144;
constexpr int V_TILE_BYTES = 32 * V_RS;
constexpr int RPB_OFF = 8 * V_TILE_BYTES;

template <bool NT>
__device__ __forceinline__ void attn_unit(const AttnP& P, int unit, LAS unsigned char* vbuf, const LAS float* rpbt, int lane) {
    const int q = lane & 31, hi = lane >> 5;
    int b, hcol, ntiles, qtok, sh = 0, ph = 0, i0 = 0, L = SEQ, br = 0, hD = 0;
    int r = 0, r0 = 0, qhalf = 0, c = 0, cs = 0, hN = 0;
    if (NT) { b = unit >> 11; hN = (unit >> 8) & 7; r = (unit & 255) >> 1; qhalf = unit & 1; r0 = min(max(r - 4, 0), 120); c = 32 * qhalf + q; cs = min(max(c - 8, 0), 48);
        qtok = b * SEQ + 64 * r + c; hcol = 64 * (8 + hN); ntiles = 12; }
    else { br = unit >> 13; const int rem = unit & 8191; b = rem >> 11; hD = (rem >> 8) & 7; const int qblk = rem & 255;
        sh = 2 * br; ph = qblk >> (8 - sh); const int ib = qblk & ((256 >> sh) - 1); i0 = 32 * ib; L = SEQ >> sh;
        qtok = b * SEQ + ((i0 + q) << sh) + ph; hcol = 64 * hD; ntiles = 5; }
    auto ktok = [&](int t, int key) -> int {
        if (NT) { const int rp = t / 3, cc = t - 3 * rp + qhalf; const int kr = 2 * rp + (key >> 4), kc = 16 * cc + (key & 15); return b * SEQ + 64 * (r0 + kr) + kc; }
        else { int j = i0 - 64 + 32 * t + key; j = min(max(j, 0), L - 1); return b * SEQ + (j << sh) + ph; }
    };
    bf16x8 qf[4];
#pragma unroll
    for (int d0 = 0; d0 < 4; ++d0) qf[d0] = *(const bf16x8*)(P.Q + (size_t)qtok * DM + hcol + 16 * d0 + 8 * hi);
    float m = -1e30f, lsum = 0.f; f32x16 o0 = {}, o1 = {};
    bf16x8 kf[4]; v4u vr[4];
    { const int tk = ktok(0, q);
#pragma unroll
      for (int d0 = 0; d0 < 4; ++d0) kf[d0] = *(const bf16x8*)(P.K + (size_t)tk * DM + hcol + 16 * d0 + 8 * hi);
#pragma unroll
      for (int ii = 0; ii < 4; ++ii) { const int tv = ktok(0, 8 * ii + (lane >> 3)); vr[ii] = *(const v4u*)(P.V + (size_t)tv * DM + hcol + 8 * (lane & 7)); } }
    const int qp = (lane & 15) >> 2, pp = lane & 3, blk = (lane >> 4) & 1;
    LAS unsigned char* trbase = vbuf + (4 * hi + qp) * V_RS + 32 * blk + 8 * pp;
    for (int t = 0; t < ntiles; ++t) {
        bf16x8 kn[4]; v4u vn[4];
        if (t + 1 < ntiles) { const int tk = ktok(t + 1, q);
#pragma unroll
            for (int d0 = 0; d0 < 4; ++d0) kn[d0] = *(const bf16x8*)(P.K + (size_t)tk * DM + hcol + 16 * d0 + 8 * hi);
#pragma unroll
            for (int ii = 0; ii < 4; ++ii) { const int tv = ktok(t + 1, 8 * ii + (lane >> 3)); vn[ii] = *(const v4u*)(P.V + (size_t)tv * DM + hcol + 8 * (lane & 7)); } }
        else {
#pragma unroll
            for (int d0 = 0; d0 < 4; ++d0) { kn[d0] = kf[d0]; vn[d0] = vr[d0]; } }
        f32x16 s = {};
#pragma unroll
        for (int d0 = 0; d0 < 4; ++d0) s = __builtin_amdgcn_mfma_f32_32x32x16_f16(__builtin_bit_cast(pg8::h16x8, kf[d0]), __builtin_bit_cast(pg8::h16x8, qf[d0]), s, 0, 0, 0);
        float mx = -INFINITY;
#pragma unroll
        for (int rr = 0; rr < 16; ++rr) {
            const int key = (rr & 3) + 8 * (rr >> 2) + 4 * hi;
            bool valid; float bias = 0.f;
            if (NT) { const int rp = t / 3, cc = t - 3 * rp + qhalf; const int kr = 2 * rp + (key >> 4), kc = 16 * cc + (key & 15);
                valid = (kc >= cs) && (kc < cs + 16);
                const int co = min(max(kc - c + 15, 0), 30);
                bias = rpbt[hN * 465 + (r0 + kr - r + 7) * 31 + co]; }
            else { const int j = i0 - 64 + 32 * t + key, dlt = q + 64 - 32 * t - key;
                valid = (j >= 0) && (j < L) && (dlt <= 64) && (dlt >= -64); }
            const float sv = valid ? s[rr] + bias : -INFINITY;
            s[rr] = sv; mx = fmaxf(mx, sv);
        }
        mx = fmaxf(mx, __shfl_xor(mx, 32));
        const float mnew = fmaxf(m, mx), alpha = __builtin_amdgcn_exp2f(m - mnew);
        float psum = 0.f;
#pragma unroll
        for (int rr = 0; rr < 16; ++rr) { const float p = __builtin_amdgcn_exp2f(s[rr] - mnew); s[rr] = p; psum += p; }
        lsum = lsum * alpha + psum; m = mnew;
#pragma unroll
        for (int rr = 0; rr < 16; ++rr) { o0[rr] *= alpha; o1[rr] *= alpha; }
        v4u pw0, pw1;
        pw0.x = cvtpk_s(s[0], s[1]); pw0.y = cvtpk_s(s[2], s[3]); pw0.z = cvtpk_s(s[4], s[5]); pw0.w = cvtpk_s(s[6], s[7]);
        pw1.x = cvtpk_s(s[8], s[9]); pw1.y = cvtpk_s(s[10], s[11]); pw1.z = cvtpk_s(s[12], s[13]); pw1.w = cvtpk_s(s[14], s[15]);
        const bf16x8 pf0 = __builtin_bit_cast(bf16x8, pw0), pf1 = __builtin_bit_cast(bf16x8, pw1);
#pragma unroll
        for (int ii = 0; ii < 4; ++ii) *(LAS v4u*)(vbuf + (8 * ii + (lane >> 3)) * V_RS + 16 * (lane & 7)) = vr[ii];
#pragma unroll
        for (int dblk = 0; dblk < 2; ++dblk) {
#pragma unroll
            for (int s2 = 0; s2 < 2; ++s2) {
                const s16x4 lo = __builtin_bit_cast(s16x4, __builtin_amdgcn_ds_read_tr16_b64_v4i16((LAS s16x4*)(trbase + (16 * s2) * V_RS + 64 * dblk)));
                const s16x4 hh = __builtin_bit_cast(s16x4, __builtin_amdgcn_ds_read_tr16_b64_v4i16((LAS s16x4*)(trbase + (16 * s2 + 8) * V_RS + 64 * dblk)));
                const bf16x8 vf = (bf16x8){lo[0], lo[1], lo[2], lo[3], hh[0], hh[1], hh[2], hh[3]};
                if (dblk == 0) o0 = __builtin_amdgcn_mfma_f32_32x32x16_f16(__builtin_bit_cast(pg8::h16x8, vf), __builtin_bit_cast(pg8::h16x8, s2 == 0 ? pf0 : pf1), o0, 0, 0, 0);
                else           o1 = __builtin_amdgcn_mfma_f32_32x32x16_f16(__builtin_bit_cast(pg8::h16x8, vf), __builtin_bit_cast(pg8::h16x8, s2 == 0 ? pf0 : pf1), o1, 0, 0, 0);
            }
        }
#pragma unroll
        for (int d0 = 0; d0 < 4; ++d0) { kf[d0] = kn[d0]; vr[d0] = vn[d0]; }
    }
    lsum += __shfl_xor(lsum, 32);
    const float inv = 1.f / lsum;
    bf16* orow;
    if (NT) orow = P.O + (size_t)qtok * DM + hcol;
    else { orow = P.OP + ((size_t)br * T + qtok) * 512 + hcol; if (hi == 0) P.LSE[((size_t)br * T + qtok) * 8 + hD] = m + __builtin_amdgcn_logf(lsum); }
#pragma unroll
    for (int g = 0; g < 4; ++g) {
        v2u w0, w1;
        w0.x = cvtpk_s(o0[4 * g] * inv, o0[4 * g + 1] * inv); w0.y = cvtpk_s(o0[4 * g + 2] * inv, o0[4 * g + 3] * inv);
        w1.x = cvtpk_s(o1[4 * g] * inv, o1[4 * g + 1] * inv); w1.y = cvtpk_s(o1[4 * g + 2] * inv, o1[4 * g + 3] * inv);
        *(v2u*)(orow + 8 * g + 4 * hi) = w0;
        *(v2u*)(orow + 32 + 8 * g + 4 * hi) = w1;
    }
}

__device__ __forceinline__ void phase_attention(const AttnP& P, const float* rpb, LAS unsigned char* lds, int gw, int NGW, int tid, int lane, int wave) {
    LAS float* rpbt = (LAS float*)(lds + RPB_OFF);
    for (int i = tid; i < 8 * 465; i += NWAVES * 64) rpbt[i] = rpb[i] * LOG2E;
    __syncthreads();
    LAS unsigned char* vbuf = lds + wave * V_TILE_BYTES;
    constexpr int NUNITS_N = BATCH * 8 * 128 * 2, NUNITS_D = 3 * BATCH * 8 * 256;
    { const int ch = (NUNITS_N + NGW - 1) / NGW; const int u1 = min((gw + 1) * ch, NUNITS_N);
      for (int u = gw * ch; u < u1; ++u) attn_unit<true>(P, u, vbuf, rpbt, lane); }
    { const int ch = (NUNITS_D + NGW - 1) / NGW; const int u1 = min((gw + 1) * ch, NUNITS_D);
      for (int u = gw * ch; u < u1; ++u) attn_unit<false>(P, u, vbuf, rpbt, lane); }
}

__device__ __forceinline__ void phase_merge(const bf16* OP, const float* LSE, bf16* O, int gtid, int NT_) {
    for (int idx = gtid; idx < T * 64; idx += NT_) {
        const int tok = idx >> 6, h = (idx >> 3) & 7, ch = idx & 7;
        const float l0 = LSE[(size_t)tok * 8 + h], l1 = LSE[((size_t)T + tok) * 8 + h], l2 = LSE[((size_t)2 * T + tok) * 8 + h];
        const float mx = fmaxf(l0, fmaxf(l1, l2));
        float w0 = __builtin_amdgcn_exp2f(l0 - mx), w1 = __builtin_amdgcn_exp2f(l1 - mx), w2 = __builtin_amdgcn_exp2f(l2 - mx);
        const float inv = 1.f / (w0 + w1 + w2); w0 *= inv; w1 *= inv; w2 *= inv;
        const size_t po = (size_t)tok * 512 + 64 * h + 8 * ch;
        const v4u a = *(const v4u*)(OP + po), b = *(const v4u*)(OP + (size_t)T * 512 + po), c = *(const v4u*)(OP + (size_t)2 * T * 512 + po);
        v4u o;
#pragma unroll
        for (int k = 0; k < 4; ++k) {
            const float lo = w0 * bf_lo(a[k]) + w1 * bf_lo(b[k]) + w2 * bf_lo(c[k]);
            const float hi = w0 * bf_hi(a[k]) + w1 * bf_hi(b[k]) + w2 * bf_hi(c[k]);
            o[k] = cvtpk_s(lo, hi);
        }
        *(v4u*)(O + (size_t)tok * DM + 64 * h + 8 * ch) = o;
    }
}

template <int HALF>
__device__ __forceinline__ void pool_item(const bf16* XBp, bf16* U, int b, int s0, int c8) {
    constexpr int R = 16 + 2 * HALF;
    const bf16* xb = XBp + (size_t)b * SEQ * DM + 8 * c8;
    v4u rows[R];
#pragma unroll
    for (int k = 0; k < R; ++k) { const int s = s0 - HALF + k; const int sc = min(max(s, 0), SEQ - 1); rows[k] = *(const v4u*)(xb + (size_t)sc * DM); if (s < 0 || s >= SEQ) rows[k] = (v4u){0u, 0u, 0u, 0u}; }
    float sum[8];
#pragma unroll
    for (int j = 0; j < 8; ++j) sum[j] = 0.f;
#pragma unroll
    for (int k = 0; k < 2 * HALF; ++k)
#pragma unroll
        for (int j = 0; j < 4; ++j) { sum[2 * j] += bf_lo(rows[k][j]); sum[2 * j + 1] += bf_hi(rows[k][j]); }
#pragma unroll
    for (int i = 0; i < 16; ++i) {
        const int s = s0 + i; const int lo = max(s - HALF, 0), hi = min(s + HALF, SEQ);
        const float rc = 1.f / (float)(hi - lo);
        v4u w;
#pragma unroll
        for (int j = 0; j < 4; ++j) w[j] = cvtpk_s(sum[2 * j] * rc - bf_lo(rows[i + HALF][j]), sum[2 * j + 1] * rc - bf_hi(rows[i + HALF][j]));
        *(v4u*)(U + ((size_t)b * SEQ + s) * DM + 8 * c8) = w;
        if (i < 15) {
#pragma unroll
            for (int j = 0; j < 4; ++j) { sum[2 * j] += bf_lo(rows[i + 2 * HALF][j]) - bf_lo(rows[i][j]); sum[2 * j + 1] += bf_hi(rows[i + 2 * HALF][j]) - bf_hi(rows[i][j]); }
        }
    }
}
__device__ __forceinline__ void phase_pool(const bf16* XBp, bf16* U, int gtid, int NT_) {
    for (int idx = gtid; idx < (T / 16) * 128; idx += NT_) {
        const int g = (idx >> 6) & 3, c8 = 32 * g + (idx & 31), tch = ((idx >> 8) << 1) | ((idx >> 5) & 1), b = tch >> 9, s0 = (tch & 511) * 16;
        if (g == 0) pool_item<1>(XBp, U, b, s0, c8); else if (g == 1) pool_item<2>(XBp, U, b, s0, c8); else if (g == 2) pool_item<4>(XBp, U, b, s0, c8); else pool_item<8>(XBp, U, b, s0, c8);
    }
}

__device__ __forceinline__ void load_row_bf16(float (&v)[16], const bf16* row, int lane) {
#pragma unroll
    for (int j = 0; j < 2; ++j) { const v4u r = *((const GAS v4u*)row + lane + 64 * j);
#pragma unroll
        for (int k = 0; k < 4; ++k) { v[8 * j + 2 * k] = bf_lo(r[k]); v[8 * j + 2 * k + 1] = bf_hi(r[k]); } }
}
__device__ __forceinline__ void ln_row(float (&v)[16], const float* g, const float* bta, int lane) {
    float s = 0.f;
#pragma unroll
    for (int k = 0; k < 16; k += 4) s += (v[k] + v[k + 1]) + (v[k + 2] + v[k + 3]);
    const float mean = wave_sum(s) * (1.f / DM); float s2 = 0.f;
#pragma unroll
    for (int k = 0; k < 16; ++k) { v[k] -= mean; s2 += v[k] * v[k]; }
    const float rstd = 1.f / sqrtf(wave_sum(s2) * (1.f / DM) + LN_EPS);
#pragma unroll
    for (int j = 0; j < 2; ++j)
#pragma unroll
        for (int h = 0; h < 2; ++h) { const f32x4 gg = *(const f32x4*)(g + 512 * j + 8 * lane + 4 * h), bb = *(const f32x4*)(bta + 512 * j + 8 * lane + 4 * h);
#pragma unroll
            for (int c = 0; c < 4; ++c) v[8 * j + 4 * h + c] = v[8 * j + 4 * h + c] * rstd * gg[c] + bb[c]; }
}
__device__ __forceinline__ void store_row_bf16(const float (&v)[16], bf16* row, int lane) {
#pragma unroll
    for (int j = 0; j < 2; ++j) { v4u w;
#pragma unroll
        for (int k = 0; k < 4; ++k) w[k] = cvtpk_s(v[8 * j + 2 * k], v[8 * j + 2 * k + 1]);
        *((GAS v4u*)row + lane + 64 * j) = w; }
}
__device__ __forceinline__ void store_row_f32(const float (&v)[16], float* row, int lane) {
#pragma unroll
    for (int j = 0; j < 2; ++j)
#pragma unroll
        for (int h = 0; h < 2; ++h) *((GAS f32x4*)(row + 512 * j + 8 * lane + 4 * h)) = (f32x4){v[8 * j + 4 * h], v[8 * j + 4 * h + 1], v[8 * j + 4 * h + 2], v[8 * j + 4 * h + 3]};
}

__device__ __forceinline__ float reduce16(float (&v)[16], int lane) {
#pragma unroll
    for (int i = 0; i < 8; ++i) { const bool up = lane & 32; const float send = up ? v[i] : v[i + 8], keep = up ? v[i + 8] : v[i]; v[i] = keep + __shfl_xor(send, 32); }
#pragma unroll
    for (int i = 0; i < 4; ++i) { const bool up = lane & 16; const float send = up ? v[i] : v[i + 4], keep = up ? v[i + 4] : v[i]; v[i] = keep + __shfl_xor(send, 16); }
#pragma unroll
    for (int i = 0; i < 2; ++i) { const bool up = lane & 8; const float send = up ? v[i] : v[i + 2], keep = up ? v[i + 2] : v[i]; v[i] = keep + __shfl_xor(send, 8); }
    { const bool up = lane & 4; const float send = up ? v[0] : v[1], keep = up ? v[1] : v[0]; v[0] = keep + __shfl_xor(send, 4); }
    v[0] += __shfl_xor(v[0], 2); v[0] += __shfl_xor(v[0], 1);
    return v[0];
}

struct TokTabs { int* e; float* g; int* rank; int* pos; };

__device__ __forceinline__ void route_token(const float (&lg)[16], const float* rbias, size_t tok, int tl, const TokTabs& TT, LAS int* lcnt, LAS int* tinfo, int lane) {
    float aff[16], sel[16];
#pragma unroll
    for (int e = 0; e < 16; ++e) { aff[e] = 1.f / (1.f + expf(-lg[e])); sel[e] = aff[e] + rbias[e]; }
    float gs[4];
#pragma unroll
    for (int g = 0; g < 4; ++g) { const float a = sel[4 * g], b = sel[4 * g + 1], c = sel[4 * g + 2], d = sel[4 * g + 3];
        const float h1 = fmaxf(a, b), l1 = fminf(a, b), h2 = fmaxf(c, d), l2 = fminf(c, d);
        gs[g] = fmaxf(h1, h2) + fmaxf(fminf(h1, h2), fmaxf(l1, l2)); }
    int grp = 0; float best = gs[0];
#pragma unroll
    for (int g = 1; g < 4; ++g) if (gs[g] > best) { best = gs[g]; grp = g; }
    float sg[4], ag[4];
#pragma unroll
    for (int k = 0; k < 4; ++k) { sg[k] = grp == 0 ? sel[k] : grp == 1 ? sel[4 + k] : grp == 2 ? sel[8 + k] : sel[12 + k]; ag[k] = grp == 0 ? aff[k] : grp == 1 ? aff[4 + k] : grp == 2 ? aff[8 + k] : aff[12 + k]; }
    int i1 = 0; float b1 = sg[0];
#pragma unroll
    for (int k = 1; k < 4; ++k) if (sg[k] > b1) { b1 = sg[k]; i1 = k; }
    int i2 = -1; float b2 = -INFINITY;
#pragma unroll
    for (int k = 0; k < 4; ++k) if (k != i1 && (i2 < 0 || sg[k] > b2)) { b2 = sg[k]; i2 = k; }
    const float a1 = i1 == 0 ? ag[0] : i1 == 1 ? ag[1] : i1 == 2 ? ag[2] : ag[3];
    const float a2 = i2 == 0 ? ag[0] : i2 == 1 ? ag[1] : i2 == 2 ? ag[2] : ag[3];
    const float den = a1 + a2;
    if (lane == 0) {
        const int e1 = grp * 4 + i1, e2 = grp * 4 + i2;
        const int r1 = __hip_atomic_fetch_add(lcnt + e1, 1, __ATOMIC_RELAXED, __HIP_MEMORY_SCOPE_WORKGROUP);
        const int r2 = __hip_atomic_fetch_add(lcnt + e2, 1, __ATOMIC_RELAXED, __HIP_MEMORY_SCOPE_WORKGROUP);
        tinfo[tl * 4 + 0] = e1; tinfo[tl * 4 + 1] = r1; tinfo[tl * 4 + 2] = e2; tinfo[tl * 4 + 3] = r2;
        TT.e[tok * 2] = e1; TT.e[tok * 2 + 1] = e2; TT.g[tok * 2] = a1 / den; TT.g[tok * 2 + 1] = a2 / den;
    }
}

__device__ __forceinline__ void phase_lnr(bf16* XB, const float* g, const float* bta, const float* router_w, const float* rbias_g,
                                          const TokTabs& TT, gu32* cnt, LAS unsigned char* lds, int tid, int lane, int wave) {
    LAS float* rw = (LAS float*)lds;
    LAS int* lcnt = (LAS int*)(lds + 65536); LAS int* lbase = lcnt + 16; LAS int* tinfo = lcnt + 32;
    for (int idx = tid; idx < DM * 16; idx += NWAVES * 64) { const int col = idx >> 4, e = idx & 15, j = col >> 9, l = (col & 511) >> 3, c = col & 7, k = 8 * j + c;
        rw[(((k * 4 + (e >> 2)) * 64 + l) << 2) + (e & 3)] = router_w[idx]; }
    float rbias[16];
#pragma unroll
    for (int e = 0; e < 16; ++e) rbias[e] = rbias_g[e];
    for (int chunk = blockIdx.x; chunk < T / 128; chunk += gridDim.x) {
        __syncthreads();
        if (tid < 16) lcnt[tid] = 0;
        __syncthreads();
        for (int pass = 0; pass < 8; ++pass) {
            const int tl0 = wave * 16 + 2 * pass; const size_t tok0 = (size_t)chunk * 128 + tl0;
            float va[16], vb[16];
            load_row_bf16(va, XB + tok0 * DM, lane); load_row_bf16(vb, XB + (tok0 + 1) * DM, lane);
            ln_row(va, g, bta, lane); ln_row(vb, g, bta, lane);
            store_row_bf16(va, XB + tok0 * DM, lane); store_row_bf16(vb, XB + (tok0 + 1) * DM, lane);
            float pa[16], pb[16];
#pragma unroll
            for (int e = 0; e < 16; ++e) { pa[e] = 0.f; pb[e] = 0.f; }
#pragma unroll
            for (int k = 0; k < 16; ++k)
#pragma unroll
                for (int e4 = 0; e4 < 4; ++e4) {
                    const f32x4 w = *(const LAS f32x4*)(rw + (((k * 4 + e4) * 64 + lane) << 2));
#pragma unroll
                    for (int ee = 0; ee < 4; ++ee) { pa[4 * e4 + ee] += va[k] * w[ee]; pb[4 * e4 + ee] += vb[k] * w[ee]; }
                }
            const float ra = reduce16(pa, lane), rb = reduce16(pb, lane);
            float lga[16], lgb[16];
#pragma unroll
            for (int e = 0; e < 16; ++e) { lga[e] = __builtin_bit_cast(float, __builtin_amdgcn_readlane(__builtin_bit_cast(int, ra), 4 * e)); lgb[e] = __builtin_bit_cast(float, __builtin_amdgcn_readlane(__builtin_bit_cast(int, rb), 4 * e)); }
            route_token(lga, rbias, tok0, tl0, TT, lcnt, tinfo, lane);
            route_token(lgb, rbias, tok0 + 1, tl0 + 1, TT, lcnt, tinfo, lane);
        }
        __syncthreads();
        if (tid < 16) lbase[tid] = (int)__hip_atomic_fetch_add(cnt + 64 * tid, (unsigned)lcnt[tid], RLX_AGENT);
        __syncthreads();
        if (tid < 256) { const int tl = tid >> 1, k = tid & 1; const int e = tinfo[tl * 4 + 2 * k], lr = tinfo[tl * 4 + 2 * k + 1];
            TT.rank[((size_t)chunk * 128 + tl) * 2 + k] = lbase[e] + lr; }
    }
    __syncthreads();
}

__device__ __forceinline__ int build_expert_tables(const gu32* cnt, LAS int* pstart, LAS unsigned char* texp, LAS int* ntl, int tid) {
    __syncthreads();
    if (tid == 0) {
        int acc = 0;
        for (int e = 0; e < NEXP; ++e) { const int c = (int)__hip_atomic_load(cnt + 64 * e, RLX_AGENT); const int nt = (c + 255) >> 8; pstart[e] = acc * 256; for (int i = 0; i < nt; ++i) texp[acc + i] = (unsigned char)e; acc += nt; }
        *ntl = acc;
    }
    __syncthreads();
    return *ntl;
}

__device__ __forceinline__ void phase_scatter(const bf16* XB, bf16* XS, const TokTabs& TT, const LAS int* pstart, int gw, int NGW, int lane) {
    for (int tok = gw; tok < T; tok += NGW) {
        const int e0 = TT.e[tok * 2], e1 = TT.e[tok * 2 + 1];
        const int p0 = pstart[e0] + TT.rank[tok * 2], p1 = pstart[e1] + TT.rank[tok * 2 + 1];
        const GAS v4u* src = (const GAS v4u*)(XB + (size_t)tok * DM) + lane;
        const v4u a = src[0], b = src[64];
        GAS v4u* d0 = (GAS v4u*)(XS + (size_t)p0 * DM) + lane; GAS v4u* d1 = (GAS v4u*)(XS + (size_t)p1 * DM) + lane;
        d0[0] = a; d0[64] = b; d1[0] = a; d1[64] = b;
        if (lane == 0) { TT.pos[tok * 2] = p0; TT.pos[tok * 2 + 1] = p1; }
    }
}

__device__ __forceinline__ void phase_combine(bf16* XB, float* out, const bf16* YB, const TokTabs& TT, const float* g, const float* bta, int gw, int NGW, int lane) {
    for (int tok = gw; tok < T; tok += NGW) {
        const int p0 = TT.pos[tok * 2], p1 = TT.pos[tok * 2 + 1]; const float g0 = TT.g[tok * 2], g1 = TT.g[tok * 2 + 1];
        float v[16], y0[16], y1[16];
        load_row_bf16(v, XB + (size_t)tok * DM, lane); load_row_bf16(y0, YB + (size_t)p0 * DM, lane); load_row_bf16(y1, YB + (size_t)p1 * DM, lane);
#pragma unroll
        for (int k = 0; k < 16; ++k) v[k] = v[k] * ALPHA + g0 * y0[k] + g1 * y1[k];
        ln_row(v, g, bta, lane);
        if (out) store_row_f32(v, out + (size_t)tok * DM, lane); else store_row_bf16(v, XB + (size_t)tok * DM, lane);
    }
}

#ifndef DUPMASK
#define DUPMASK 0
#endif
constexpr int PSTART_OFF = RING_BYTES + 1536, NTL_OFF = RING_BYTES + 1600;
struct Args { InPtrs in; float* out; unsigned char* ws; int layer, pad; };

template <int SLOT>
__device__ __forceinline__ void do_slot(const Args& args, int layer, LAS unsigned char* lds) {
    int tidL = threadIdx.x; asm volatile("" : "+v"(tidL));
    const int tid = tidL, lane = tidL & 63, wave = __builtin_amdgcn_readfirstlane(tidL >> 6);
    const int G = gridDim.x, gw = blockIdx.x * NWAVES + wave, NGW = G * NWAVES, gtid = blockIdx.x * (NWAVES * 64) + tidL, NTH = G * NWAVES * 64;
    unsigned char* ws = args.ws; asm volatile("" : "+s"(ws));
    float* X = args.out; asm volatile("" : "+s"(X));
    const int i2 = layer >> 1;
    TokTabs TT; TT.e = (int*)(ws + WS_TOK); TT.g = (float*)(ws + WS_TOK + 262144); TT.rank = (int*)(ws + WS_TOK + 2 * 262144); TT.pos = (int*)(ws + WS_TOK + 3 * 262144);
    gu32* cnt = (gu32*)(ws + WS_CTL) + CW_CNT + layer * 16 * 64;
    bf16* XB = (bf16*)(ws + WS_XB);
    bf16* Qb = (bf16*)(ws + WS_Q); bf16* Kb = (bf16*)(ws + WS_K); bf16* Vb = (bf16*)(ws + WS_V); bf16* Ob = (bf16*)(ws + WS_O);
    bf16* OP = (bf16*)(ws + WS_OP); float* LSE = (float*)(ws + WS_LSE);
    bf16* Ub = (bf16*)(ws + WS_U); bf16* XS = (bf16*)(ws + WS_XS); bf16* Hb = (bf16*)(ws + WS_H);
    const float* cosT = (const float*)(ws + WS_ROPE); const float* sinT = cosT + SEQ * 32;
    const float* SMp = (const float*)(ws + WS_SMALL);
    LAS int* pstart = (LAS int*)(lds + PSTART_OFF); LAS unsigned char* texp = lds + TEXP_OFF; LAS int* ntl = (LAS int*)(lds + NTL_OFF);
    (void)tid; (void)lane; (void)gw; (void)NGW; (void)gtid; (void)NTH; (void)i2; (void)TT; (void)cnt; (void)XB; (void)Qb; (void)Kb; (void)Vb; (void)Ob; (void)OP; (void)LSE; (void)Ub; (void)XS; (void)Hb;
    (void)cosT; (void)sinT; (void)SMp; (void)pstart; (void)texp; (void)ntl; (void)X;

    if constexpr (SLOT == 0) { phase_prologue(args.in, ws, lds, gw, NGW, lane, wave, gtid, NTH); }
    if constexpr (SLOT == 1) {
        Sched S{T / 256, 12, (T / 256) * 12, G, (int)blockIdx.x, (const char*)XB, (const char*)(ws + WS_WQKV) + (size_t)i2 * 3072 * DM * 2, (size_t)256 * DM * 2, 0, (size_t)256 * DM * 2, 0, nullptr};
        EpiQKV E{Qb, (size_t)(WS_K - WS_Q) / 2, cosT, sinT};
        pg8::gemm_phase<EpiQKV, Sched, true>(lds, pg8::Gemm{DM, DM, DM}, S, E);
    }
    if constexpr (SLOT == 2) {
        AttnP P{Qb, Kb, Vb, Ob, OP, LSE};
        phase_attention(P, SMp + SM_RPB + (size_t)i2 * 8 * 465, lds, gw, NGW, tid, lane, wave);
    }
    if constexpr (SLOT == 3) { phase_merge(OP, LSE, Ob, gtid, NTH); }
    if constexpr (SLOT == 4) {
        Sched S{T / 256, 4, (T / 256) * 4, G, (int)blockIdx.x, (const char*)Ob, (const char*)(ws + WS_WO) + (size_t)i2 * DM * DM * 2, (size_t)256 * DM * 2, 0, (size_t)256 * DM * 2, 0, nullptr};
        EpiRes E{XB, nullptr};
        pg8::gemm_phase<EpiRes, Sched, true>(lds, pg8::Gemm{DM, DM, DM}, S, E);
    }
    if constexpr (SLOT == 5) { phase_pool(XB, Ub, gtid, NTH); }
    if constexpr (SLOT == 6) {
        Sched S{T / 256, 4, (T / 256) * 4, G, (int)blockIdx.x, (const char*)Ub, (const char*)(ws + WS_WP) + (size_t)i2 * 4 * 65536 * 2, (size_t)256 * DM * 2, (size_t)512, (size_t)65536 * 2, 0, nullptr};
        EpiRes E{XB, SMp + SM_PSC + (size_t)i2 * DM};
        pg8::gemm_phase<EpiRes, Sched, true>(lds, pg8::Gemm{DM, 256, 256}, S, E);
    }
    if constexpr (SLOT == 7) {
        phase_lnr(XB, SMp + SM_LNG + (size_t)(layer * 2) * DM, SMp + SM_LNB + (size_t)(layer * 2) * DM, SMp + SM_RW, SMp + SM_RB, TT, cnt, lds, tid, lane, wave);
    }
    if constexpr (SLOT == 8) {
        (void)build_expert_tables(cnt, pstart, texp, ntl, tid);
        phase_scatter(XB, XS, TT, pstart, gw, NGW, lane);
    }
    if constexpr (SLOT == 9) {
        const int ntiles = build_expert_tables(cnt, pstart, texp, ntl, tid);
        Sched S{ntiles, 8, ntiles * 8, G, (int)blockIdx.x, (const char*)XS, (const char*)(ws + WS_W13) + (size_t)layer * NEXP * 2048 * DM * 2, (size_t)256 * DM * 2, 0, (size_t)256 * DM * 2, (size_t)2048 * DM * 2, texp};
        EpiSwiGLU E{Hb};
        pg8::gemm_phase<EpiSwiGLU, Sched, true>(lds, pg8::Gemm{DM, DM, DM}, S, E);
    }
    if constexpr (SLOT == 10) {
        const int ntiles = build_expert_tables(cnt, pstart, texp, ntl, tid);
        Sched S{ntiles, 4, ntiles * 4, G, (int)blockIdx.x, (const char*)Hb, (const char*)(ws + WS_W2) + (size_t)layer * NEXP * DM * DM * 2, (size_t)256 * DM * 2, 0, (size_t)256 * DM * 2, (size_t)DM * DM * 2, texp};
        EpiBf16 E{XS};
        pg8::gemm_phase<EpiBf16, Sched, true>(lds, pg8::Gemm{DM, DM, DM}, S, E);
    }
    if constexpr (SLOT == 11) {
        phase_combine(XB, layer == DEPTH - 1 ? X : nullptr, XS, TT, SMp + SM_LNG + (size_t)(layer * 2 + 1) * DM, SMp + SM_LNB + (size_t)(layer * 2 + 1) * DM, gw, NGW, lane);
    }
}

#if MK_MULTI_LAUNCH
template <int SLOT>
__global__ void __launch_bounds__(NWAVES * 64, 2) k_slot(Args args) {
    extern __shared__ __attribute__((aligned(16))) unsigned char lds_raw[];
    LAS unsigned char* lds = (LAS unsigned char*)lds_raw;
    for (int u = threadIdx.x; u < (LDS_BYTES - RING_BYTES) / 4; u += NWAVES * 64) ((LAS unsigned*)(lds + RING_BYTES))[u] = 0u;
    __syncthreads();
    do_slot<SLOT>(args, args.layer, lds);
}
template <int SLOT> static void launch_slot(const Args& a, int grid, hipStream_t stream) {
    static bool attr_set = false;
    if (!attr_set) { (void)hipFuncSetAttribute((const void*)k_slot<SLOT>, hipFuncAttributeMaxDynamicSharedMemorySize, LDS_BYTES); attr_set = true; }
    hipLaunchKernelGGL(k_slot<SLOT>, dim3(grid), dim3(NWAVES * 64), LDS_BYTES, stream, a);
}
#else
__global__ void __launch_bounds__(NWAVES * 64, 2) fwd(Args args) {
    extern __shared__ __attribute__((aligned(16))) unsigned char lds_raw[];
    LAS unsigned char* lds = (LAS unsigned char*)lds_raw;
    volatile LAS unsigned* MISC = (volatile LAS unsigned*)(lds + MISC_OFF);
    for (int u = threadIdx.x; u < (LDS_BYTES - RING_BYTES) / 4; u += NWAVES * 64) ((LAS unsigned*)(lds + RING_BYTES))[u] = 0u;
    __syncthreads();
    const XcdBarrier bar = xcd_barrier_post((unsigned*)((gu32*)(args.ws + WS_CTL) + CW_BAR), MISC + 8);
    do_slot<0>(args, 0, lds);
    if constexpr (DUPMASK & 1) { xcd_barrier(bar); do_slot<0>(args, 0, lds); }
#define RUN(S, L) xcd_barrier(bar); do_slot<S>(args, L, lds); if constexpr ((DUPMASK >> S) & 1) { xcd_barrier(bar); do_slot<S>(args, L, lds); }
#define MOE_SLOTS(L) RUN(7, L) RUN(8, L) RUN(9, L) RUN(10, L) RUN(11, L)
#define LAYER_ATT(L) RUN(1, L) RUN(2, L) RUN(3, L) RUN(4, L) MOE_SLOTS(L)
#define LAYER_POOL(L) RUN(5, L) RUN(6, L) MOE_SLOTS(L)
    LAYER_ATT(0) LAYER_POOL(1) LAYER_ATT(2) LAYER_POOL(3)
#undef RUN
#undef MOE_SLOTS
#undef LAYER_ATT
#undef LAYER_POOL
}
#endif

extern "C" void kernel_launch(void* const* d_in, const int* in_sizes, int n_in, void* d_out, int out_size, void* d_ws, size_t ws_size, hipStream_t stream) {
    static int grid = 0;
    if (grid == 0) {
        if (n_in != 13 || in_sizes[0] != T * DM || out_size != T * DM || ws_size < WS_END) {
            fprintf(stderr, "kernel_launch: unexpected shapes (n_in %d, in0 %d, out %d, ws %zu; need ws >= %zu); nothing launched\n", n_in, n_in > 0 ? in_sizes[0] : -1, out_size, ws_size, (size_t)WS_END); grid = -1; return; }
        int dev = 0, cus = 0;
        if (hipGetDevice(&dev) != hipSuccess || hipDeviceGetAttribute(&cus, hipDeviceAttributeMultiprocessorCount, dev) != hipSuccess) { fprintf(stderr, "kernel_launch: device query failed\n"); grid = -1; return; }
#if !MK_MULTI_LAUNCH
        int per_cu = 0;
        if (hipFuncSetAttribute((const void*)fwd, hipFuncAttributeMaxDynamicSharedMemorySize, LDS_BYTES) != hipSuccess) { fprintf(stderr, "kernel_launch: hipFuncSetAttribute failed\n"); grid = -1; return; }
        if (hipOccupancyMaxActiveBlocksPerMultiprocessor(&per_cu, (const void*)fwd, NWAVES * 64, LDS_BYTES) != hipSuccess || per_cu < 1)
            fprintf(stderr, "kernel_launch: note: occupancy query reports %d workgroups per CU\n", per_cu);
        (void)hipGetLastError();
#endif
        grid = cus;
    }
    if (grid < 0) return;
    if (hipMemsetAsync((char*)d_ws + WS_CTL, 0, CTL_ZERO_BYTES, stream) != hipSuccess) { fprintf(stderr, "kernel_launch: memset failed\n"); return; }
    Args a{};
    const float** ip = (const float**)&a.in;
    for (int i = 0; i < 13; ++i) ip[i] = (const float*)d_in[i];
    a.out = (float*)d_out; a.ws = (unsigned char*)d_ws; a.layer = 0; a.pad = 0;
#if MK_MULTI_LAUNCH
    launch_slot<0>(a, grid, stream);
    for (int layer = 0; layer < DEPTH; ++layer) {
        a.layer = layer;
        if ((layer & 1) == 0) { launch_slot<1>(a, grid, stream); launch_slot<2>(a, grid, stream); launch_slot<3>(a, grid, stream); launch_slot<4>(a, grid, stream); }
        else { launch_slot<5>(a, grid, stream); launch_slot<6>(a, grid, stream); }
        launch_slot<7>(a, grid, stream); launch_slot<8>(a, grid, stream); launch_slot<9>(a, grid, stream); launch_slot<10>(a, grid, stream); launch_slot<11>(a, grid, stream);
    }
#else
    hipLaunchKernelGGL(fwd, dim3(grid), dim3(NWAVES * 64), LDS_BYTES, stream, a);
#endif
    const hipError_t le = hipPeekAtLastError();
    if (le != hipSuccess) fprintf(stderr, "kernel_launch: launch failed: %s\n", hipGetErrorName(le));
}
```

```cpp
#include <hip/hip_runtime.h>
#include <cstdio>
#include <cstdint>
#include <cmath>

#ifndef MK_MULTI_LAUNCH
#define MK_MULTI_LAUNCH 0
#endif

namespace pg8 {
#define PG8_LAS __attribute__((address_space(3)))
typedef unsigned short bf16_t;
typedef short bf16x8 __attribute__((ext_vector_type(8)));
typedef float f32x4 __attribute__((ext_vector_type(4)));
typedef unsigned u32x4 __attribute__((ext_vector_type(4)));
constexpr int BM = 256, BK = 64, HALF = 128, HTB = HALF * BK * 2  , STAGE_BYTES = 8 * HTB, NXCD = 8, WGM = 8;

__host__ __device__ __forceinline__ int lds_byte(int r, int c) { const int st = (r >> 4) * 2 + (c >> 5), rr = r & 15, cc = c & 31, ob = rr * 64 + cc * 2; return st * 1024 + (ob ^ (((ob >> 9) & 1) << 5)); }
__host__ __device__ __forceinline__ void stage_rc(int b, int& R, int& C) { const int st = b / 1024, sb = b % 1024, swz = sb ^ (((sb >> 9) & 1) << 5); R = (st >> 1) * 16 + swz / 64; C = (st & 1) * 32 + (swz % 64) / 2; }
__host__ __device__ __forceinline__ int perm32(int rho) { const int n = rho >> 4, i = rho & 15; return 8 * (i >> 2) + 4 * n + (i & 3); }

struct Unit { int pm, pn; };
struct Gemm { int lda, ldb, K; };

typedef _Float16 h16x8 __attribute__((ext_vector_type(8))); typedef _Float16 h16x2 __attribute__((ext_vector_type(2))); typedef float f32x2 __attribute__((ext_vector_type(2)));
__device__ __forceinline__ unsigned cvt_pk16(float lo, float hi) { const f32x2 v = {lo, hi}; const h16x2 b = __builtin_convertvector(v, h16x2); return __builtin_bit_cast(unsigned, b); }

constexpr int GATHER_TAB_OFF = 131072 + 2048;
template <class Epi, class Sched, bool ALIGN_EPI, bool GATHER = false>
__device__ __forceinline__ void gemm_phase(PG8_LAS unsigned char* lds, const Gemm g, const Sched& S, const Epi& E) {
    int tid_ = threadIdx.x; asm volatile("" : "+v"(tid_));
    const int tid = tid_, wid = __builtin_amdgcn_readfirstlane(tid >> 6), lane = tid & 63, wr = wid >> 2, wc = wid & 3, fr = lane & 15, fq = lane >> 4;
    const int K = g.K, nt = K / BK;
    unsigned voffA[2], voffB[2];
#pragma unroll
    for (int i = 0; i < 2; ++i) { int R, C; stage_rc(tid * 16 + i * 8192, R, C); const int Rb = 64 * (R >> 5) + perm32(R & 31);
        voffA[i] = (unsigned)(R * g.lda + C) * 2u; voffB[i] = (unsigned)(Rb * g.ldb + C) * 2u; }
    const size_t kstep = (size_t)(BK * 2);
    const size_t hstepA = (size_t)HALF * g.lda * 2;
    const size_t hstepB = (size_t)32 * g.ldb * 2;
    const unsigned ldsw = (unsigned)wid * 1024u;
    const int aoff = lds_byte(wr * 64 + fr, fq * 8), boff = lds_byte(wc * 32 + fr, fq * 8);
#define PG8_SA(b, h) (((b) * 2 + (h)) * HTB)
#define PG8_SB(b, h) ((4 + (b) * 2 + (h)) * HTB)
#define PG8_STAGE(bufoff, gbase, voff) do { _Pragma("unroll") for (int _i = 0; _i < 2; ++_i) \
        __builtin_amdgcn_global_load_lds((const unsigned*)((const char*)(gbase) + (voff)[_i]), (PG8_LAS unsigned*)(lds + (bufoff) + ldsw + _i * 8192), 16, 0, 0); } while (0)
#define PG8_STAGE_A(bufoff, gbase, h, usenext) do { if constexpr (GATHER) { unsigned _v[2]; _v[0] = (usenext) ? nvA[h][0] : cvA[h][0]; _v[1] = (usenext) ? nvA[h][1] : cvA[h][1]; PG8_STAGE(bufoff, gbase, _v); } \
        else { PG8_STAGE(bufoff, (gbase) + (h) * hstepA, voffA); } } while (0)
#define PG8_LDA(dst, b, h) do { _Pragma("unroll") for (int m = 0; m < 4; ++m) _Pragma("unroll") for (int k = 0; k < 2; ++k) dst[m][k] = *(const PG8_LAS bf16x8*)(lds + PG8_SA(b, h) + aoff + m * 2048 + k * 1024); } while (0)
#define PG8_LDB(dst, b, h) do { _Pragma("unroll") for (int n = 0; n < 2; ++n) _Pragma("unroll") for (int k = 0; k < 2; ++k) dst[n][k] = *(const PG8_LAS bf16x8*)(lds + PG8_SB(b, h) + boff + n * 2048 + k * 1024); } while (0)
#define PG8_MMA(ai, bj, At, Bt) do { __builtin_amdgcn_s_setprio(1); _Pragma("unroll") for (int m = 0; m < 4; ++m) _Pragma("unroll") for (int n = 0; n < 2; ++n) _Pragma("unroll") for (int k = 0; k < 2; ++k) \
        acc[ai][bj][m][n] = __builtin_amdgcn_mfma_f32_16x16x32_f16(__builtin_bit_cast(h16x8, Bt[n][k]), __builtin_bit_cast(h16x8, At[m][k]), acc[ai][bj][m][n], 0, 0, 0); __builtin_amdgcn_s_setprio(0); } while (0)
#define PG8_WAIT_V(n) asm volatile("s_waitcnt vmcnt(" #n ")" ::: "memory")
#define PG8_WAIT_L(n) asm volatile("s_waitcnt lgkmcnt(" #n ")" ::: "memory")
#define PG8_BAR __builtin_amdgcn_s_barrier()
#define PG8_SCHED __builtin_amdgcn_sched_barrier(0)
    Unit cur, nxt; int ui = 0;
    const char* cA; const char* cB; const char* nA; const char* nB;
    if (!S.next(0, cur.pm, cur.pn, cA, cB)) return;
    f32x4 acc[2][2][4][2];
#pragma unroll
    for (int a = 0; a < 2; ++a)
#pragma unroll
        for (int b = 0; b < 2; ++b)
#pragma unroll
            for (int m = 0; m < 4; ++m)
#pragma unroll
                for (int n = 0; n < 2; ++n) acc[a][b][m][n] = (f32x4){0.f, 0.f, 0.f, 0.f};
    bf16x8 At[4][2], B0[2][2], B1[2][2];
    unsigned cvA[2][2] = {{0u, 0u}, {0u, 0u}}, nvA[2][2] = {{0u, 0u}, {0u, 0u}}; int Rl[2], Cl[2], nnv = 0;
#pragma unroll
    for (int i = 0; i < 2; ++i) stage_rc(tid * 16 + i * 8192, Rl[i], Cl[i]);
    if constexpr (GATHER) {
        const int* lp; int nv; S.rows(cur.pm, lp, nv);
        if (wid == 0) __builtin_amdgcn_global_load_lds((const unsigned*)(lp + 4 * lane), (PG8_LAS unsigned*)(lds + GATHER_TAB_OFF), 16, 0, 0);
        PG8_WAIT_V(0); PG8_BAR;
        const PG8_LAS int* tab = (const PG8_LAS int*)(lds + GATHER_TAB_OFF);
#pragma unroll
        for (int h = 0; h < 2; ++h)
#pragma unroll
            for (int i = 0; i < 2; ++i) { const int r = 128 * h + Rl[i]; const int tok = r < nv ? tab[r] : 0; cvA[h][i] = (unsigned)(tok * g.lda + Cl[i]) * 2u; }
    }
    PG8_STAGE(PG8_SB(0, 0), cB, voffB); PG8_STAGE(PG8_SB(0, 1), cB + hstepB, voffB); PG8_STAGE_A(PG8_SA(0, 0), cA, 0, false); PG8_STAGE_A(PG8_SA(0, 1), cA, 1, false);
    if (wr == 1) PG8_BAR;
    PG8_WAIT_V(2); PG8_BAR;
    PG8_STAGE(PG8_SB(1, 0), cB + kstep, voffB); PG8_STAGE_A(PG8_SA(1, 0), cA + kstep, 0, false); PG8_STAGE(PG8_SB(1, 1), cB + hstepB + kstep, voffB);
    PG8_WAIT_V(6); PG8_BAR;
    for (;;) {
        const bool has_next = S.next(ui + 1, nxt.pm, nxt.pn, nA, nB);
        if (!has_next) { nA = cA; nB = cB; }
        if constexpr (GATHER) { if (has_next) { const int* lp; S.rows(nxt.pm, lp, nnv);
            if (wid == 0) __builtin_amdgcn_global_load_lds((const unsigned*)(lp + 4 * lane), (PG8_LAS unsigned*)(lds + GATHER_TAB_OFF + 1024 * ((ui + 1) & 1)), 16, 0, 0); } }
        for (int t = 0; t < nt; t += 2) {
            const bool last = (t == nt - 2);
            if constexpr (GATHER) { if (last) {
                if (has_next) { const PG8_LAS int* tab = (const PG8_LAS int*)(lds + GATHER_TAB_OFF + 1024 * ((ui + 1) & 1));
#pragma unroll
                    for (int h = 0; h < 2; ++h)
#pragma unroll
                        for (int i = 0; i < 2; ++i) { const int r = 128 * h + Rl[i]; const int tok = r < nnv ? tab[r] : 0; nvA[h][i] = (unsigned)(tok * g.lda + Cl[i]) * 2u; } }
                else {
#pragma unroll
                    for (int h = 0; h < 2; ++h)
#pragma unroll
                        for (int i = 0; i < 2; ++i) nvA[h][i] = cvA[h][i]; } } }
            const char* a1 = cA + (size_t)(t + 1) * kstep;
            const char* a2 = last ? nA : cA + (size_t)(t + 2) * kstep; const char* b2 = last ? nB : cB + (size_t)(t + 2) * kstep;
            const char* a3 = a2 + kstep; const char* b3 = b2 + kstep;
            PG8_LDB(B0, 0, 0); PG8_LDB(B1, 0, 1); PG8_SCHED; PG8_LDA(At, 0, 0); PG8_STAGE_A(PG8_SA(1, 1), a1, 1, false);
            PG8_WAIT_V(8); PG8_WAIT_L(0); PG8_BAR; PG8_MMA(0, 0, At, B0); PG8_MMA(0, 1, At, B1); PG8_BAR; PG8_SCHED;
            PG8_LDA(At, 0, 1); PG8_STAGE(PG8_SB(0, 0), b2, voffB); PG8_STAGE(PG8_SB(0, 1), b2 + hstepB, voffB); PG8_STAGE_A(PG8_SA(0, 0), a2, 0, last);
            PG8_WAIT_V(8); PG8_WAIT_L(0); PG8_BAR; PG8_MMA(1, 0, At, B0); PG8_MMA(1, 1, At, B1); PG8_BAR; PG8_SCHED;
            PG8_LDB(B0, 1, 0); PG8_LDB(B1, 1, 1); PG8_SCHED; PG8_LDA(At, 1, 0); PG8_STAGE_A(PG8_SA(0, 1), a2, 1, last);
            PG8_WAIT_V(8); PG8_WAIT_L(0); PG8_BAR; PG8_MMA(0, 0, At, B0); PG8_MMA(0, 1, At, B1); PG8_BAR; PG8_SCHED;
            PG8_LDA(At, 1, 1); PG8_STAGE(PG8_SB(1, 0), b3, voffB); PG8_STAGE(PG8_SB(1, 1), b3 + hstepB, voffB); PG8_STAGE_A(PG8_SA(1, 0), a3, 0, last);
            PG8_WAIT_V(8); PG8_WAIT_L(0); PG8_BAR; PG8_MMA(1, 0, At, B0); PG8_MMA(1, 1, At, B1); PG8_BAR; PG8_SCHED;
        }
        if constexpr (ALIGN_EPI) { if (wr == 0) PG8_BAR; }
        E(acc, cur, wr, wc, fr, fq);
        if (!has_next) break;
#pragma unroll
        for (int a = 0; a < 2; ++a)
#pragma unroll
            for (int b = 0; b < 2; ++b)
#pragma unroll
                for (int m = 0; m < 4; ++m)
#pragma unroll
                    for (int n = 0; n < 2; ++n) acc[a][b][m][n] = (f32x4){0.f, 0.f, 0.f, 0.f};
        cur.pm = nxt.pm; cur.pn = nxt.pn; cA = nA; cB = nB; ++ui;
        if constexpr (GATHER) {
#pragma unroll
            for (int h = 0; h < 2; ++h)
#pragma unroll
                for (int i = 0; i < 2; ++i) cvA[h][i] = nvA[h][i]; }
        if constexpr (ALIGN_EPI) { if (wr == 1) PG8_BAR; }
    }
    PG8_WAIT_V(0);
    if constexpr (!ALIGN_EPI) { if (wr == 0) PG8_BAR; }
    PG8_BAR;
#undef PG8_SA
#undef PG8_SB
#undef PG8_STAGE
#undef PG8_STAGE_A
#undef PG8_LDA
#undef PG8_LDB
#undef PG8_MMA
#undef PG8_WAIT_V
#undef PG8_WAIT_L
#undef PG8_BAR
#undef PG8_SCHED
}
}

constexpr int NWAVES = 8;
constexpr int BATCH = 4, SEQ = 8192, DM = 1024, T = BATCH * SEQ, DEPTH = 4;
constexpr int NEXP = 16;
constexpr int PROWS = 2 * T + NEXP * 256;
constexpr float LN_EPS = 1e-5f;
constexpr float ALPHA = 1.681792830507429f;
constexpr float QSCALE = 0.125f * 1.4426950408889634f;
constexpr float LOG2E = 1.4426950408889634f;

constexpr size_t MiB = 1u << 20;
constexpr size_t WS_CTL = 0, CTL_ZERO_BYTES = 1 * MiB;
constexpr size_t WS_ROPE = 1 * MiB;
constexpr size_t WS_WQKV = 3 * MiB;
constexpr size_t WS_WO = 15 * MiB;
constexpr size_t WS_WP = 19 * MiB;
constexpr size_t WS_W13 = 20 * MiB;
constexpr size_t WS_W2 = 276 * MiB;
constexpr size_t WS_XB = 404 * MiB;
constexpr size_t WS_Y = 468 * MiB;
constexpr size_t WS_OP = WS_Y, WS_LSE = WS_Y + 96 * MiB;
constexpr size_t WS_R = 596 * MiB;
constexpr size_t WS_Q = WS_R, WS_K = WS_R + 64 * MiB, WS_V = WS_R + 128 * MiB, WS_O = WS_R + 192 * MiB;
constexpr size_t WS_U = WS_R;
constexpr size_t WS_XS = WS_R, WS_H = WS_R + 136 * MiB;
constexpr size_t WS_TOK = 868 * MiB;
constexpr size_t WS_SMALL = 869 * MiB;
constexpr int SM_RPB = 0, SM_PSC = 7440, SM_RW = 9488, SM_RB = 25872, SM_LNG = 25888, SM_LNB = 34080, SM_END = 42272;
constexpr size_t WS_LIST = 870 * MiB;
constexpr size_t WS_END = 872 * MiB;
static_assert((size_t)PROWS * DM * 2 <= 136 * MiB && WS_H + 136 * MiB <= WS_TOK, "d_ws map");

constexpr int CW_BAR = 4096;
constexpr int CW_CNT = 16384;

constexpr int RING_BYTES = 131072;
constexpr int MISC_OFF = RING_BYTES + 320;
constexpr int LDS_BYTES = 147456;
constexpr int TEXP_OFF = RING_BYTES + 1024;
constexpr int PSTART_OFF = RING_BYTES + 1536, NTL_OFF = RING_BYTES + 1600;
constexpr int TSTART_OFF = RING_BYTES + 1664, ECNT_OFF = RING_BYTES + 1728;

#define GAS __attribute__((address_space(1)))
#define LAS __attribute__((address_space(3)))
typedef unsigned short bf16;
typedef unsigned v4u __attribute__((ext_vector_type(4)));
typedef unsigned v2u __attribute__((ext_vector_type(2)));
typedef float f32x4 __attribute__((ext_vector_type(4)));
typedef float f32x16 __attribute__((ext_vector_type(16)));
typedef short bf16x8 __attribute__((ext_vector_type(8)));
typedef short s16x4 __attribute__((ext_vector_type(4)));
typedef GAS unsigned gu32;
#define RLX_AGENT __ATOMIC_RELAXED, __HIP_MEMORY_SCOPE_AGENT
#define LDS_WAIT() asm volatile("s_waitcnt lgkmcnt(0)" ::: "memory")
__device__ __forceinline__ unsigned pk2(float lo, float hi) { return pg8::cvt_pk16(lo, hi); }
__device__ __forceinline__ float bf_lo(unsigned u) { return (float)__builtin_bit_cast(pg8::h16x2, u)[0]; }
__device__ __forceinline__ float bf_hi(unsigned u) { return (float)__builtin_bit_cast(pg8::h16x2, u)[1]; }

#define XB_TMO      128
#define XB_XCNT(j)  (256  + 64 * (j))
#define XB_XSUB(j)  (1280 + 64 * (j))
#define XB_XGEN(j)  (2304 + 64 * (j))
#define XB_TOP      3328
#define XB_TOPGEN   3392
#define XCD_BAR_WORDS 3456
#define XB_SPIN_CAP (1u << 18)

__device__ __forceinline__ unsigned xb_ld(unsigned* p)              { return __hip_atomic_load(p, __ATOMIC_RELAXED, __HIP_MEMORY_SCOPE_AGENT); }
__device__ __forceinline__ unsigned xb_add(unsigned* p, unsigned v) { return __hip_atomic_fetch_add(p, v, __ATOMIC_RELAXED, __HIP_MEMORY_SCOPE_AGENT); }
__device__ __forceinline__ unsigned xb_xcc_id() { return (unsigned)__builtin_amdgcn_s_getreg((3 << 11) | 20) & 0xFu; }
#define XB_SPIN(cond, bar) do { unsigned _sp = 0; while (cond) { __builtin_amdgcn_s_sleep(1); \
    if ((++_sp & 255u) == 0u) { if (xb_ld(&(bar)[XB_TMO])) break; if (_sp > XB_SPIN_CAP) { atomicAdd(&(bar)[XB_TMO], 1u); break; } } } } while (0)

struct XcdBarrier { unsigned* bar; unsigned x; volatile LAS unsigned* st; };

__device__ __forceinline__ XcdBarrier xcd_barrier_post(unsigned* bar, volatile LAS unsigned* st) {
    XcdBarrier b; b.bar = bar; b.x = xb_xcc_id(); b.st = st;
    if (threadIdx.x == 0) (void)xb_add(&bar[XB_XCNT(b.x)], 1u);
    return b;
}
__device__ __forceinline__ void xcd_barrier_complete(unsigned* bar, unsigned x, unsigned& nloc, unsigned& nx) {
    const unsigned G = gridDim.x * gridDim.y * gridDim.z;
    unsigned sum, cnt, mine, sp = 0u;
    for (;;) {
        sum = 0u; cnt = 0u; mine = 0u;
#pragma unroll
        for (unsigned j = 0; j < 16; ++j) { const unsigned c = xb_ld(&bar[XB_XCNT(j)]); sum += c; cnt += (c > 0u) ? 1u : 0u; mine = (j == x) ? c : mine; }
        if (sum == G) break;
        __builtin_amdgcn_s_sleep(1);
        if ((++sp & 255u) == 0u) { if (xb_ld(&bar[XB_TMO])) break; if (sp > XB_SPIN_CAP) { atomicAdd(&bar[XB_TMO], 1u); break; } }
    }
    nloc = mine > 0u ? mine : 1u; nx = cnt > 0u ? cnt : 1u;
}
__device__ __forceinline__ void xcd_barrier(const XcdBarrier& b) {
    asm volatile("s_waitcnt vmcnt(0)" ::: "memory");
    __syncthreads();
    int tid_ = threadIdx.x; asm volatile("" : "+v"(tid_));
    if (tid_ == 0) {
        unsigned* bar = b.bar; asm volatile("" : "+s"(bar));
        __builtin_amdgcn_s_waitcnt(0);
        unsigned nloc = b.st[0], nx = b.st[1];
        if (nloc == 0u) { xcd_barrier_complete(bar, b.x, nloc, nx); b.st[0] = nloc; b.st[1] = nx; }
        const unsigned old = xb_add(&bar[XB_XSUB(b.x)], 1u);
        const unsigned gen = old / nloc;
        if (old + 1u == (gen + 1u) * nloc) {
            __builtin_amdgcn_fence(__ATOMIC_RELEASE, "agent");
            asm volatile("s_waitcnt vmcnt(0)" ::: "memory");
            const unsigned og = xb_add(&bar[XB_TOP], 1u);
            const unsigned tg = og / nx;
            if (og + 1u == (tg + 1u) * nx) xb_add(&bar[XB_TOPGEN], 1u);
            else XB_SPIN(xb_ld(&bar[XB_TOPGEN]) == tg, bar);
            __builtin_amdgcn_fence(__ATOMIC_ACQUIRE, "agent");
            xb_add(&bar[XB_XGEN(b.x)], 1u);
            asm volatile("s_waitcnt vmcnt(0)" ::: "memory");
        } else {
            XB_SPIN(xb_ld(&bar[XB_XGEN(b.x)]) == gen, bar);
            __builtin_amdgcn_fence(__ATOMIC_ACQUIRE, "agent");
            asm volatile("s_waitcnt vmcnt(0)" ::: "memory");
        }
    }
    __syncthreads();
}

struct Sched {
    int nM, nN, nwg, G, c;
    const char* A; const char* B; size_t a_tile, a_pn, b_tile, e_bytes; const LAS unsigned char* texp;
    const LAS int* tstart; const LAS int* ecnt; const int* list;
    __device__ __forceinline__ void rows(int pm, const int*& lp, int& nv) const {
        const int e = __builtin_amdgcn_readfirstlane((int)texp[pm]); const int mt = pm - __builtin_amdgcn_readfirstlane(tstart[e]);
        lp = list + (size_t)e * T + 256 * mt; nv = min(256, max(0, __builtin_amdgcn_readfirstlane(ecnt[e]) - 256 * mt)); }
    __device__ __forceinline__ bool next(int i, int& pm, int& pn, const char*& pa, const char*& pb) const {
        const long L = (long)i * G + c; if (L >= nwg) return false;
        int wgid = (int)L; { const int q = nwg / pg8::NXCD, r = nwg % pg8::NXCD, xcd = wgid % pg8::NXCD, off = wgid / pg8::NXCD; wgid = (xcd < r ? xcd * (q + 1) : r * (q + 1) + (xcd - r) * q) + off; }
        const int nig = pg8::WGM * nN, gid = wgid / nig, fm = gid * pg8::WGM, gsz = (nM - fm) < pg8::WGM ? (nM - fm) : pg8::WGM;
        pm = fm + ((wgid % nig) % gsz); pn = (wgid % nig) / gsz;
        pa = A + (size_t)pm * a_tile + (size_t)pn * a_pn;
        const char* bb = B + (size_t)pn * b_tile;
        if (texp) { const int e = __builtin_amdgcn_readfirstlane((int)texp[pm]); bb += (size_t)e * e_bytes; }
        pb = bb; return true;
    }
};

using pg8::f32x4;

struct EpiQKV {
    bf16* Q; size_t kv_stride; const float* cosT; const float* sinT;
    __device__ __forceinline__ void operator()(const f32x4 (&acc)[2][2][4][2], const pg8::Unit& u, int wr, int wc, int fr, int fq) const {
        const int sel = u.pn >> 2, head = 4 * (u.pn & 3) + wc;
        bf16* base = Q + (size_t)sel * kv_stride;
        const bool rope = (sel < 2) && ((u.pn & 3) < 2);
        const float sc = sel == 0 ? QSCALE : 1.f;
        const int col0 = 64 * head + 8 * fq;
#pragma unroll
        for (int ai = 0; ai < 2; ++ai)
#pragma unroll
            for (int m = 0; m < 4; ++m) {
                const int row = u.pm * 256 + ai * 128 + wr * 64 + m * 16 + fr;
                f32x4 a0 = acc[ai][0][m][0], a1 = acc[ai][0][m][1], b0 = acc[ai][1][m][0], b1 = acc[ai][1][m][1];
                if (rope) {
                    const int s = row & (SEQ - 1);
                    const f32x4 c0 = *(const f32x4*)(cosT + s * 32 + 8 * fq), c1 = *(const f32x4*)(cosT + s * 32 + 8 * fq + 4);
                    const f32x4 s0 = *(const f32x4*)(sinT + s * 32 + 8 * fq), s1 = *(const f32x4*)(sinT + s * 32 + 8 * fq + 4);
                    const f32x4 na0 = a0 * c0 - b0 * s0, nb0 = b0 * c0 + a0 * s0, na1 = a1 * c1 - b1 * s1, nb1 = b1 * c1 + a1 * s1;
                    a0 = na0; b0 = nb0; a1 = na1; b1 = nb1;
                }
                a0 = a0 * sc; a1 = a1 * sc; b0 = b0 * sc; b1 = b1 * sc;
                bf16* rowp = base + (size_t)row * DM + col0;
                v4u w; w.x = pg8::cvt_pk16(a0[0], a0[1]); w.y = pg8::cvt_pk16(a0[2], a0[3]); w.z = pg8::cvt_pk16(a1[0], a1[1]); w.w = pg8::cvt_pk16(a1[2], a1[3]);
                *(v4u*)rowp = w;
                v4u x; x.x = pg8::cvt_pk16(b0[0], b0[1]); x.y = pg8::cvt_pk16(b0[2], b0[3]); x.z = pg8::cvt_pk16(b1[0], b1[1]); x.w = pg8::cvt_pk16(b1[2], b1[3]);
                *(v4u*)(rowp + 32) = x;
                asm volatile("" ::: "memory");
            }
    }
};
struct EpiRes {
    bf16* XBp; const float* csc;
    __device__ __forceinline__ void operator()(const f32x4 (&acc)[2][2][4][2], const pg8::Unit& u, int wr, int wc, int fr, int fq) const {
        const int col0 = u.pn * 256 + 64 * wc + 8 * fq;
#pragma unroll
        for (int ai = 0; ai < 2; ++ai)
#pragma unroll
            for (int m = 0; m < 4; ++m) {
                const size_t off = (size_t)(u.pm * 256 + ai * 128 + wr * 64 + m * 16 + fr) * DM + col0;
#pragma unroll
                for (int bj = 0; bj < 2; ++bj) {
                    const v4u xr = *(const v4u*)(XBp + off + 32 * bj);
                    f32x4 a0 = acc[ai][bj][m][0], a1 = acc[ai][bj][m][1];
                    if (csc) { a0 = a0 * *(const f32x4*)(csc + col0 + 32 * bj); a1 = a1 * *(const f32x4*)(csc + col0 + 32 * bj + 4); }
                    v4u w;
                    w.x = pg8::cvt_pk16(bf_lo(xr.x) * ALPHA + a0[0], bf_hi(xr.x) * ALPHA + a0[1]); w.y = pg8::cvt_pk16(bf_lo(xr.y) * ALPHA + a0[2], bf_hi(xr.y) * ALPHA + a0[3]);
                    w.z = pg8::cvt_pk16(bf_lo(xr.z) * ALPHA + a1[0], bf_hi(xr.z) * ALPHA + a1[1]); w.w = pg8::cvt_pk16(bf_lo(xr.w) * ALPHA + a1[2], bf_hi(xr.w) * ALPHA + a1[3]);
                    *(v4u*)(XBp + off + 32 * bj) = w;
                }
                asm volatile("" ::: "memory");
            }
    }
};
struct EpiSwiGLU {
    bf16* H;
    __device__ __forceinline__ void operator()(const f32x4 (&acc)[2][2][4][2], const pg8::Unit& u, int wr, int wc, int fr, int fq) const {
        const int col0 = u.pn * 128 + 32 * wc + 8 * fq;
#pragma unroll
        for (int ai = 0; ai < 2; ++ai)
#pragma unroll
            for (int m = 0; m < 4; ++m) {
                const size_t off = (size_t)(u.pm * 256 + ai * 128 + wr * 64 + m * 16 + fr) * DM + col0;
                float h[8];
#pragma unroll
                for (int n = 0; n < 2; ++n)
#pragma unroll
                    for (int e = 0; e < 4; ++e) {
                        const float gt = acc[ai][0][m][n][e], up = acc[ai][1][m][n][e];
                        const float sg = gt * __builtin_amdgcn_rcpf(1.f + __builtin_amdgcn_exp2f(-gt * LOG2E));
                        h[4 * n + e] = sg * up;
                    }
                v4u w; w.x = pg8::cvt_pk16(h[0], h[1]); w.y = pg8::cvt_pk16(h[2], h[3]); w.z = pg8::cvt_pk16(h[4], h[5]); w.w = pg8::cvt_pk16(h[6], h[7]);
                *(v4u*)(H + off) = w;
                asm volatile("" ::: "memory");
            }
    }
};
struct EpiBf16 {
    bf16* O;
    __device__ __forceinline__ void operator()(const f32x4 (&acc)[2][2][4][2], const pg8::Unit& u, int wr, int wc, int fr, int fq) const {
        const int col0 = u.pn * 256 + 64 * wc + 8 * fq;
#pragma unroll
        for (int ai = 0; ai < 2; ++ai)
#pragma unroll
            for (int m = 0; m < 4; ++m) {
                const size_t off = (size_t)(u.pm * 256 + ai * 128 + wr * 64 + m * 16 + fr) * DM + col0;
#pragma unroll
                for (int bj = 0; bj < 2; ++bj) {
                    const f32x4 v0 = acc[ai][bj][m][0], v1 = acc[ai][bj][m][1];
                    v4u w; w.x = pg8::cvt_pk16(v0[0], v0[1]); w.y = pg8::cvt_pk16(v0[2], v0[3]); w.z = pg8::cvt_pk16(v1[0], v1[1]); w.w = pg8::cvt_pk16(v1[2], v1[3]);
                    *(v4u*)(O + off + 32 * bj) = w;
                }
                asm volatile("" ::: "memory");
            }
    }
};

__device__ __forceinline__ float wave_sum(float v) {
#pragma unroll
    for (int o = 1; o < 64; o <<= 1) v += __shfl_xor(v, o);
    return v;
}
__device__ __forceinline__ unsigned cvtpk_s(float lo, float hi) { return pg8::cvt_pk16(lo, hi); }

__device__ __forceinline__ void p0_transpose_item(const float* W, int K, int N, bf16* WT, int k0, int n0, int drow, LAS float* scr, int lane) {
#pragma unroll 8
    for (int i = 0; i < 32; ++i) { const int kk = 2 * i + (lane >> 5); scr[kk * 33 + (lane & 31)] = W[(size_t)(k0 + kk) * N + n0 + (lane & 31)]; }
    LDS_WAIT(); asm volatile("" ::: "memory");
    const int c = lane & 7;
#pragma unroll
    for (int j = 0; j < 4; ++j) { const int n = (lane >> 3) + 8 * j; const LAS float* s = scr + (8 * c) * 33 + n;
        v4u o; o.x = pk2(s[0 * 33], s[1 * 33]); o.y = pk2(s[2 * 33], s[3 * 33]); o.z = pk2(s[4 * 33], s[5 * 33]); o.w = pk2(s[6 * 33], s[7 * 33]);
        *(GAS v4u*)(WT + (size_t)(drow + n) * K + k0 + 8 * c) = o; }
    LDS_WAIT(); asm volatile("" ::: "memory");
}
struct InPtrs { const float *x, *w_in, *w_out, *rpb, *pool_w, *pool_scale, *router_w, *router_bias, *w1, *w3, *w2, *ln_g, *ln_b; };

__device__ __forceinline__ void sincos_d(double a, double& sn, double& cs) {
    const double n = __builtin_rint(a * 0.63661977236758134308);
    double r = __builtin_fma(-n, 1.57079632679489655800e+00, a); r = __builtin_fma(-n, 6.12323399573676603587e-17, r);
    const double z = r * r;
    const double sp = r + r * z * (-1.66666666666666324348e-01 + z * (8.33333333332248946124e-03 + z * (-1.98412698298579493134e-04 + z * (2.75573137070700676789e-06 + z * (-2.50507602534068634195e-08 + z * 1.58969099521155010221e-10)))));
    const double cp = 1.0 - 0.5 * z + z * z * (4.16666666666666019037e-02 + z * (-1.38888888888741095749e-03 + z * (2.48015872894767294178e-05 + z * (-2.75573143513906633035e-07 + z * (2.08757232129817482790e-09 + z * -1.13596475577881948265e-11)))));
    const int q = (int)((long long)n & 3);
    sn = (q == 0) ? sp : (q == 1) ? cp : (q == 2) ? -sp : -cp;
    cs = (q == 0) ? cp : (q == 1) ? -sp : (q == 2) ? -cp : sp;
}

__device__ __forceinline__ void phase_prologue(const InPtrs& in, unsigned char* ws, LAS unsigned char* lds, int gw, int NGW, int lane, int wave, int gtid, int NTH) {
    LAS float* scr = (LAS float*)(lds + wave * 16384);
    constexpr int MOE_ITEMS = DEPTH * NEXP * 3 * 512, IN_ITEMS = 2 * 1536, OUT_ITEMS = 2 * 512, POOL_ITEMS = 8 * 32;
    constexpr int NITEMS = MOE_ITEMS + IN_ITEMS + OUT_ITEMS + POOL_ITEMS;
    for (int it = gw; it < NITEMS; it += NGW) {
        int r = it;
        if (r < MOE_ITEMS) {
            const int mat = r >> 9, loc = r & 511, le = mat / 3, which = mat - 3 * le;
            const int kb = loc >> 5, nb = loc & 31;
            const float* src = (which == 0 ? in.w1 : which == 1 ? in.w3 : in.w2) + (size_t)le * DM * DM;
            if (which < 2) p0_transpose_item(src, DM, DM, (bf16*)(ws + WS_W13) + (size_t)le * 2048 * DM, 64 * kb, 32 * nb, 64 * nb + 32 * which, scr, lane);
            else           p0_transpose_item(src, DM, DM, (bf16*)(ws + WS_W2) + (size_t)le * DM * DM, 64 * kb, 32 * nb, 32 * nb, scr, lane);
            continue;
        }
        r -= MOE_ITEMS;
        if (r < IN_ITEMS) { const int i = r / 1536, loc = r - 1536 * i, kb = loc / 96, nb = loc - 96 * kb;
            p0_transpose_item(in.w_in + (size_t)i * DM * 3072, DM, 3072, (bf16*)(ws + WS_WQKV) + (size_t)i * 3072 * DM, 64 * kb, 32 * nb, 32 * nb, scr, lane); continue; }
        r -= IN_ITEMS;
        if (r < OUT_ITEMS) { const int i = r >> 9, loc = r & 511, kb = loc >> 5, nb = loc & 31;
            p0_transpose_item(in.w_out + (size_t)i * DM * DM, DM, DM, (bf16*)(ws + WS_WO) + (size_t)i * DM * DM, 64 * kb, 32 * nb, 32 * nb, scr, lane); continue; }
        r -= OUT_ITEMS;
        { const int mat = r >> 5, loc = r & 31, kb = loc >> 3, nb = loc & 7;
            p0_transpose_item(in.pool_w + (size_t)mat * 65536, 256, 256, (bf16*)(ws + WS_WP) + (size_t)mat * 65536, 64 * kb, 32 * nb, 32 * nb, scr, lane); }
    }
    bf16* XB = (bf16*)(ws + WS_XB);
    for (int m = gw; m < T; m += NGW) {
        const GAS f32x4* xr = (const GAS f32x4*)(in.x + (size_t)m * DM) + lane;
        GAS unsigned long long* o8 = (GAS unsigned long long*)(XB + (size_t)m * DM) + lane;
#pragma unroll
        for (int j = 0; j < 4; ++j) { const f32x4 v = xr[64 * j]; o8[64 * j] = (unsigned long long)pk2(v.x, v.y) | ((unsigned long long)pk2(v.z, v.w) << 32); }
    }
    { float* sm = (float*)(ws + WS_SMALL);
      for (int i = gtid; i < SM_END; i += NTH) {
          float v;
          if (i < SM_PSC) v = in.rpb[i]; else if (i < SM_RW) v = in.pool_scale[i - SM_PSC]; else if (i < SM_RB) v = in.router_w[i - SM_RW];
          else if (i < SM_LNG) v = in.router_bias[i - SM_RB]; else if (i < SM_LNB) v = in.ln_g[i - SM_LNG]; else v = in.ln_b[i - SM_LNB];
          sm[i] = v; } }
    float* cosT = (float*)(ws + WS_ROPE); float* sinT = cosT + SEQ * 32;
    for (int idx = gw * 64 + lane; idx < SEQ * 32; idx += NGW * 64) {
        const int s = idx >> 5, i = idx & 31;
        double invf = 1.0;
        if (i & 1) invf *= 0.7498942093324559; if (i & 2) invf *= 0.5623413251903491; if (i & 4) invf *= 0.31622776601683794; if (i & 8) invf *= 0.1; if (i & 16) invf *= 0.01;
        double sn, cs; sincos_d((double)s * invf, sn, cs);
        cosT[idx] = (float)cs; sinT[idx] = (float)sn;
    }
}

struct AttnP { const bf16* Q; const bf16* K; const bf16* V; bf16* O; bf16* OP; float* LSE; };
constexpr int V_RS = 144;
constexpr int V_TILE_BYTES = 32 * V_RS;
constexpr int RPB_OFF = 8 * V_TILE_BYTES;

template <bool NT>
__device__ __forceinline__ void attn_unit(const AttnP& P, int unit, LAS unsigned char* vbuf, const LAS float* rpbt, int lane) {
    const int q = lane & 31, hi = lane >> 5;
    int b, hcol, ntiles, qtok, sh = 0, ph = 0, i0 = 0, L = SEQ, br = 0, hD = 0;
    int r = 0, r0 = 0, qhalf = 0, c = 0, cs = 0, hN = 0;
    if (NT) { b = unit >> 11; hN = (unit >> 8) & 7; r = (unit & 255) >> 1; qhalf = unit & 1; r0 = min(max(r - 4, 0), 120); c = 32 * qhalf + q; cs = min(max(c - 8, 0), 48);
        qtok = b * SEQ + 64 * r + c; hcol = 64 * (8 + hN); ntiles = 12; }
    else { br = unit >> 13; const int rem = unit & 8191; b = rem >> 11; hD = (rem >> 8) & 7; const int qblk = rem & 255;
        sh = 2 * br; ph = qblk >> (8 - sh); const int ib = qblk & ((256 >> sh) - 1); i0 = 32 * ib; L = SEQ >> sh;
        qtok = b * SEQ + ((i0 + q) << sh) + ph; hcol = 64 * hD; ntiles = 5; }
    auto ktok = [&](int t, int key) -> int {
        if (NT) { const int rp = t / 3, cc = t - 3 * rp + qhalf; const int kr = 2 * rp + (key >> 4), kc = 16 * cc + (key & 15); return b * SEQ + 64 * (r0 + kr) + kc; }
        else { int j = i0 - 64 + 32 * t + key; j = min(max(j, 0), L - 1); return b * SEQ + (j << sh) + ph; }
    };
    bf16x8 qf[4];
#pragma unroll
    for (int d0 = 0; d0 < 4; ++d0) qf[d0] = *(const bf16x8*)(P.Q + (size_t)qtok * DM + hcol + 16 * d0 + 8 * hi);
    float m = -1e30f, lsum = 0.f; f32x16 o0 = {}, o1 = {};
    bf16x8 kf[4]; v4u vr[4];
    { const int tk = ktok(0, q);
#pragma unroll
      for (int d0 = 0; d0 < 4; ++d0) kf[d0] = *(const bf16x8*)(P.K + (size_t)tk * DM + hcol + 16 * d0 + 8 * hi);
#pragma unroll
      for (int ii = 0; ii < 4; ++ii) { const int tv = ktok(0, 8 * ii + (lane >> 3)); vr[ii] = *(const v4u*)(P.V + (size_t)tv * DM + hcol + 8 * (lane & 7)); } }
    const int qp = (lane & 15) >> 2, pp = lane & 3, blk = (lane >> 4) & 1;
    LAS unsigned char* trbase = vbuf + (4 * hi + qp) * V_RS + 32 * blk + 8 * pp;
    for (int t = 0; t < ntiles; ++t) {
        bf16x8 kn[4]; v4u vn[4];
        if (t + 1 < ntiles) { const int tk = ktok(t + 1, q);
#pragma unroll
            for (int d0 = 0; d0 < 4; ++d0) kn[d0] = *(const bf16x8*)(P.K + (size_t)tk * DM + hcol + 16 * d0 + 8 * hi);
#pragma unroll
            for (int ii = 0; ii < 4; ++ii) { const int tv = ktok(t + 1, 8 * ii + (lane >> 3)); vn[ii] = *(const v4u*)(P.V + (size_t)tv * DM + hcol + 8 * (lane & 7)); } }
        else {
#pragma unroll
            for (int d0 = 0; d0 < 4; ++d0) { kn[d0] = kf[d0]; vn[d0] = vr[d0]; } }
        f32x16 s = {};
#pragma unroll
        for (int d0 = 0; d0 < 4; ++d0) s = __builtin_amdgcn_mfma_f32_32x32x16_f16(__builtin_bit_cast(pg8::h16x8, kf[d0]), __builtin_bit_cast(pg8::h16x8, qf[d0]), s, 0, 0, 0);
        float mx = -INFINITY;
#pragma unroll
        for (int rr = 0; rr < 16; ++rr) {
            const int key = (rr & 3) + 8 * (rr >> 2) + 4 * hi;
            bool valid; float bias = 0.f;
            if (NT) { const int rp = t / 3, cc = t - 3 * rp + qhalf; const int kr = 2 * rp + (key >> 4), kc = 16 * cc + (key & 15);
                valid = (kc >= cs) && (kc < cs + 16);
                const int co = min(max(kc - c + 15, 0), 30);
                bias = rpbt[hN * 465 + (r0 + kr - r + 7) * 31 + co]; }
            else { const int j = i0 - 64 + 32 * t + key, dlt = q + 64 - 32 * t - key;
                valid = (j >= 0) && (j < L) && (dlt <= 64) && (dlt >= -64); }
            const float sv = valid ? s[rr] + bias : -INFINITY;
            s[rr] = sv; mx = fmaxf(mx, sv);
        }
        mx = fmaxf(mx, __shfl_xor(mx, 32));
        const float mnew = fmaxf(m, mx), alpha = __builtin_amdgcn_exp2f(m - mnew);
        float psum = 0.f;
#pragma unroll
        for (int rr = 0; rr < 16; ++rr) { const float p = __builtin_amdgcn_exp2f(s[rr] - mnew); s[rr] = p; psum += p; }
        lsum = lsum * alpha + psum; m = mnew;
#pragma unroll
        for (int rr = 0; rr < 16; ++rr) { o0[rr] *= alpha; o1[rr] *= alpha; }
        v4u pw0, pw1;
        pw0.x = cvtpk_s(s[0], s[1]); pw0.y = cvtpk_s(s[2], s[3]); pw0.z = cvtpk_s(s[4], s[5]); pw0.w = cvtpk_s(s[6], s[7]);
        pw1.x = cvtpk_s(s[8], s[9]); pw1.y = cvtpk_s(s[10], s[11]); pw1.z = cvtpk_s(s[12], s[13]); pw1.w = cvtpk_s(s[14], s[15]);
        const bf16x8 pf0 = __builtin_bit_cast(bf16x8, pw0), pf1 = __builtin_bit_cast(bf16x8, pw1);
#pragma unroll
        for (int ii = 0; ii < 4; ++ii) *(LAS v4u*)(vbuf + (8 * ii + (lane >> 3)) * V_RS + 16 * (lane & 7)) = vr[ii];
#pragma unroll
        for (int dblk = 0; dblk < 2; ++dblk) {
#pragma unroll
            for (int s2 = 0; s2 < 2; ++s2) {
                const s16x4 lo = __builtin_bit_cast(s16x4, __builtin_amdgcn_ds_read_tr16_b64_v4i16((LAS s16x4*)(trbase + (16 * s2) * V_RS + 64 * dblk)));
                const s16x4 hh = __builtin_bit_cast(s16x4, __builtin_amdgcn_ds_read_tr16_b64_v4i16((LAS s16x4*)(trbase + (16 * s2 + 8) * V_RS + 64 * dblk)));
                const bf16x8 vf = (bf16x8){lo[0], lo[1], lo[2], lo[3], hh[0], hh[1], hh[2], hh[3]};
                if (dblk == 0) o0 = __builtin_amdgcn_mfma_f32_32x32x16_f16(__builtin_bit_cast(pg8::h16x8, vf), __builtin_bit_cast(pg8::h16x8, s2 == 0 ? pf0 : pf1), o0, 0, 0, 0);
                else           o1 = __builtin_amdgcn_mfma_f32_32x32x16_f16(__builtin_bit_cast(pg8::h16x8, vf), __builtin_bit_cast(pg8::h16x8, s2 == 0 ? pf0 : pf1), o1, 0, 0, 0);
            }
        }
#pragma unroll
        for (int d0 = 0; d0 < 4; ++d0) { kf[d0] = kn[d0]; vr[d0] = vn[d0]; }
    }
    lsum += __shfl_xor(lsum, 32);
    const float inv = 1.f / lsum;
    bf16* orow;
    if (NT) orow = P.O + (size_t)qtok * DM + hcol;
    else { orow = P.OP + ((size_t)br * T + qtok) * 512 + hcol; if (hi == 0) P.LSE[((size_t)br * T + qtok) * 8 + hD] = m + __builtin_amdgcn_logf(lsum); }
#pragma unroll
    for (int g = 0; g < 4; ++g) {
        v2u w0, w1;
        w0.x = cvtpk_s(o0[4 * g] * inv, o0[4 * g + 1] * inv); w0.y = cvtpk_s(o0[4 * g + 2] * inv, o0[4 * g + 3] * inv);
        w1.x = cvtpk_s(o1[4 * g] * inv, o1[4 * g + 1] * inv); w1.y = cvtpk_s(o1[4 * g + 2] * inv, o1[4 * g + 3] * inv);
        *(v2u*)(orow + 8 * g + 4 * hi) = w0;
        *(v2u*)(orow + 32 + 8 * g + 4 * hi) = w1;
    }
}

__device__ __forceinline__ void phase_attention(const AttnP& P, const float* rpb, LAS unsigned char* lds, int gw, int NGW, int tid, int lane, int wave) {
    LAS float* rpbt = (LAS float*)(lds + RPB_OFF);
    for (int i = tid; i < 8 * 465; i += NWAVES * 64) rpbt[i] = rpb[i] * LOG2E;
    __syncthreads();
    LAS unsigned char* vbuf = lds + wave * V_TILE_BYTES;
    constexpr int NUNITS_N = BATCH * 8 * 128 * 2, NUNITS_D = 3 * BATCH * 8 * 256;
    { const int ch = (NUNITS_N + NGW - 1) / NGW; const int u1 = min((gw + 1) * ch, NUNITS_N);
      for (int u = gw * ch; u < u1; ++u) attn_unit<true>(P, u, vbuf, rpbt, lane); }
    { const int ch = (NUNITS_D + NGW - 1) / NGW; const int u1 = min((gw + 1) * ch, NUNITS_D);
      for (int u = gw * ch; u < u1; ++u) attn_unit<false>(P, u, vbuf, rpbt, lane); }
}

__device__ __forceinline__ void phase_merge(const bf16* OP, const float* LSE, bf16* O, int gtid, int NT_) {
    for (int idx = gtid; idx < T * 64; idx += NT_) {
        const int tok = idx >> 6, h = (idx >> 3) & 7, ch = idx & 7;
        const float l0 = LSE[(size_t)tok * 8 + h], l1 = LSE[((size_t)T + tok) * 8 + h], l2 = LSE[((size_t)2 * T + tok) * 8 + h];
        const float mx = fmaxf(l0, fmaxf(l1, l2));
        float w0 = __builtin_amdgcn_exp2f(l0 - mx), w1 = __builtin_amdgcn_exp2f(l1 - mx), w2 = __builtin_amdgcn_exp2f(l2 - mx);
        const float inv = 1.f / (w0 + w1 + w2); w0 *= inv; w1 *= inv; w2 *= inv;
        const size_t po = (size_t)tok * 512 + 64 * h + 8 * ch;
        const v4u a = *(const v4u*)(OP + po), b = *(const v4u*)(OP + (size_t)T * 512 + po), c = *(const v4u*)(OP + (size_t)2 * T * 512 + po);
        v4u o;
#pragma unroll
        for (int k = 0; k < 4; ++k) {
            const float lo = w0 * bf_lo(a[k]) + w1 * bf_lo(b[k]) + w2 * bf_lo(c[k]);
            const float hi = w0 * bf_hi(a[k]) + w1 * bf_hi(b[k]) + w2 * bf_hi(c[k]);
            o[k] = cvtpk_s(lo, hi);
        }
        *(v4u*)(O + (size_t)tok * DM + 64 * h + 8 * ch) = o;
    }
}

template <int HALF>
__device__ __forceinline__ void pool_item(const bf16* XBp, bf16* U, int b, int s0, int c8) {
    constexpr int R = 16 + 2 * HALF;
    const bf16* xb = XBp + (size_t)b * SEQ * DM + 8 * c8;
    v4u rows[R];
#pragma unroll
    for (int k = 0; k < R; ++k) { const int s = s0 - HALF + k; const int sc = min(max(s, 0), SEQ - 1); rows[k] = *(const v4u*)(xb + (size_t)sc * DM); if (s < 0 || s >= SEQ) rows[k] = (v4u){0u, 0u, 0u, 0u}; }
    float sum[8];
#pragma unroll
    for (int j = 0; j < 8; ++j) sum[j] = 0.f;
#pragma unroll
    for (int k = 0; k < 2 * HALF; ++k)
#pragma unroll
        for (int j = 0; j < 4; ++j) { sum[2 * j] += bf_lo(rows[k][j]); sum[2 * j + 1] += bf_hi(rows[k][j]); }
#pragma unroll
    for (int i = 0; i < 16; ++i) {
        const int s = s0 + i; const int lo = max(s - HALF, 0), hi = min(s + HALF, SEQ);
        const float rc = 1.f / (float)(hi - lo);
        v4u w;
#pragma unroll
        for (int j = 0; j < 4; ++j) w[j] = cvtpk_s(sum[2 * j] * rc - bf_lo(rows[i + HALF][j]), sum[2 * j + 1] * rc - bf_hi(rows[i + HALF][j]));
        *(v4u*)(U + ((size_t)b * SEQ + s) * DM + 8 * c8) = w;
        if (i < 15) {
#pragma unroll
            for (int j = 0; j < 4; ++j) { sum[2 * j] += bf_lo(rows[i + 2 * HALF][j]) - bf_lo(rows[i][j]); sum[2 * j + 1] += bf_hi(rows[i + 2 * HALF][j]) - bf_hi(rows[i][j]); }
        }
    }
}
__device__ __forceinline__ void phase_pool(const bf16* XBp, bf16* U, int gtid, int NT_) {
    for (int idx = gtid; idx < (T / 16) * 128; idx += NT_) {
        const int g = (idx >> 6) & 3, c8 = 32 * g + (idx & 31), tch = ((idx >> 8) << 1) | ((idx >> 5) & 1), b = tch >> 9, s0 = (tch & 511) * 16;
        if (g == 0) pool_item<1>(XBp, U, b, s0, c8); else if (g == 1) pool_item<2>(XBp, U, b, s0, c8); else if (g == 2) pool_item<4>(XBp, U, b, s0, c8); else pool_item<8>(XBp, U, b, s0, c8);
    }
}

__device__ __forceinline__ void load_row_bf16(float (&v)[16], const bf16* row, int lane) {
#pragma unroll
    for (int j = 0; j < 2; ++j) { const v4u r = *((const GAS v4u*)row + lane + 64 * j);
#pragma unroll
        for (int k = 0; k < 4; ++k) { v[8 * j + 2 * k] = bf_lo(r[k]); v[8 * j + 2 * k + 1] = bf_hi(r[k]); } }
}
__device__ __forceinline__ void ln_row(float (&v)[16], const float* g, const float* bta, int lane) {
    float s = 0.f;
#pragma unroll
    for (int k = 0; k < 16; k += 4) s += (v[k] + v[k + 1]) + (v[k + 2] + v[k + 3]);
    const float mean = wave_sum(s) * (1.f / DM); float s2 = 0.f;
#pragma unroll
    for (int k = 0; k < 16; ++k) { v[k] -= mean; s2 += v[k] * v[k]; }
    const float rstd = 1.f / sqrtf(wave_sum(s2) * (1.f / DM) + LN_EPS);
#pragma unroll
    for (int j = 0; j < 2; ++j)
#pragma unroll
        for (int h = 0; h < 2; ++h) { const f32x4 gg = *(const f32x4*)(g + 512 * j + 8 * lane + 4 * h), bb = *(const f32x4*)(bta + 512 * j + 8 * lane + 4 * h);
#pragma unroll
            for (int c = 0; c < 4; ++c) v[8 * j + 4 * h + c] = v[8 * j + 4 * h + c] * rstd * gg[c] + bb[c]; }
}
__device__ __forceinline__ void store_row_bf16(const float (&v)[16], bf16* row, int lane) {
#pragma unroll
    for (int j = 0; j < 2; ++j) { v4u w;
#pragma unroll
        for (int k = 0; k < 4; ++k) w[k] = cvtpk_s(v[8 * j + 2 * k], v[8 * j + 2 * k + 1]);
        *((GAS v4u*)row + lane + 64 * j) = w; }
}
__device__ __forceinline__ void store_row_f32(const float (&v)[16], float* row, int lane) {
#pragma unroll
    for (int j = 0; j < 2; ++j)
#pragma unroll
        for (int h = 0; h < 2; ++h) *((GAS f32x4*)(row + 512 * j + 8 * lane + 4 * h)) = (f32x4){v[8 * j + 4 * h], v[8 * j + 4 * h + 1], v[8 * j + 4 * h + 2], v[8 * j + 4 * h + 3]};
}

__device__ __forceinline__ float reduce16(float (&v)[16], int lane) {
#pragma unroll
    for (int i = 0; i < 8; ++i) { const bool up = lane & 32; const float send = up ? v[i] : v[i + 8], keep = up ? v[i + 8] : v[i]; v[i] = keep + __shfl_xor(send, 32); }
#pragma unroll
    for (int i = 0; i < 4; ++i) { const bool up = lane & 16; const float send = up ? v[i] : v[i + 4], keep = up ? v[i + 4] : v[i]; v[i] = keep + __shfl_xor(send, 16); }
#pragma unroll
    for (int i = 0; i < 2; ++i) { const bool up = lane & 8; const float send = up ? v[i] : v[i + 2], keep = up ? v[i + 2] : v[i]; v[i] = keep + __shfl_xor(send, 8); }
    { const bool up = lane & 4; const float send = up ? v[0] : v[1], keep = up ? v[1] : v[0]; v[0] = keep + __shfl_xor(send, 4); }
    v[0] += __shfl_xor(v[0], 2); v[0] += __shfl_xor(v[0], 1);
    return v[0];
}

struct TokTabs { int* e; float* g; int* rank; int* pos; };

__device__ __forceinline__ void route_token(const float (&lg)[16], const float* rbias, size_t tok, int tl, const TokTabs& TT, LAS int* lcnt, LAS int* tinfo, int lane) {
    float aff[16], sel[16];
#pragma unroll
    for (int e = 0; e < 16; ++e) { aff[e] = 1.f / (1.f + expf(-lg[e])); sel[e] = aff[e] + rbias[e]; }
    float gs[4];
#pragma unroll
    for (int g = 0; g < 4; ++g) { const float a = sel[4 * g], b = sel[4 * g + 1], c = sel[4 * g + 2], d = sel[4 * g + 3];
        const float h1 = fmaxf(a, b), l1 = fminf(a, b), h2 = fmaxf(c, d), l2 = fminf(c, d);
        gs[g] = fmaxf(h1, h2) + fmaxf(fminf(h1, h2), fmaxf(l1, l2)); }
    int grp = 0; float best = gs[0];
#pragma unroll
    for (int g = 1; g < 4; ++g) if (gs[g] > best) { best = gs[g]; grp = g; }
    float sg[4], ag[4];
#pragma unroll
    for (int k = 0; k < 4; ++k) { sg[k] = grp == 0 ? sel[k] : grp == 1 ? sel[4 + k] : grp == 2 ? sel[8 + k] : sel[12 + k]; ag[k] = grp == 0 ? aff[k] : grp == 1 ? aff[4 + k] : grp == 2 ? aff[8 + k] : aff[12 + k]; }
    int i1 = 0; float b1 = sg[0];
#pragma unroll
    for (int k = 1; k < 4; ++k) if (sg[k] > b1) { b1 = sg[k]; i1 = k; }
    int i2 = -1; float b2 = -INFINITY;
#pragma unroll
    for (int k = 0; k < 4; ++k) if (k != i1 && (i2 < 0 || sg[k] > b2)) { b2 = sg[k]; i2 = k; }
    const float a1 = i1 == 0 ? ag[0] : i1 == 1 ? ag[1] : i1 == 2 ? ag[2] : ag[3];
    const float a2 = i2 == 0 ? ag[0] : i2 == 1 ? ag[1] : i2 == 2 ? ag[2] : ag[3];
    const float den = a1 + a2;
    if (lane == 0) {
        const int e1 = grp * 4 + i1, e2 = grp * 4 + i2;
        const int r1 = __hip_atomic_fetch_add(lcnt + e1, 1, __ATOMIC_RELAXED, __HIP_MEMORY_SCOPE_WORKGROUP);
        const int r2 = __hip_atomic_fetch_add(lcnt + e2, 1, __ATOMIC_RELAXED, __HIP_MEMORY_SCOPE_WORKGROUP);
        tinfo[tl * 4 + 0] = e1; tinfo[tl * 4 + 1] = r1; tinfo[tl * 4 + 2] = e2; tinfo[tl * 4 + 3] = r2;
        TT.e[tok * 2] = e1; TT.e[tok * 2 + 1] = e2; TT.g[tok * 2] = a1 / den; TT.g[tok * 2 + 1] = a2 / den;
    }
}

__device__ __forceinline__ void phase_lnr(bf16* XB, const float* g, const float* bta, const float* router_w, const float* rbias_g,
                                          const TokTabs& TT, int* list, gu32* cnt, LAS unsigned char* lds, int tid, int lane, int wave) {
    LAS float* rw = (LAS float*)lds;
    LAS int* lcnt = (LAS int*)(lds + 65536); LAS int* lbase = lcnt + 16; LAS int* tinfo = lcnt + 32;
    for (int idx = tid; idx < DM * 16; idx += NWAVES * 64) { const int col = idx >> 4, e = idx & 15, j = col >> 9, l = (col & 511) >> 3, c = col & 7, k = 8 * j + c;
        rw[(((k * 4 + (e >> 2)) * 64 + l) << 2) + (e & 3)] = router_w[idx]; }
    float rbias[16];
#pragma unroll
    for (int e = 0; e < 16; ++e) rbias[e] = rbias_g[e];
    for (int chunk = blockIdx.x; chunk < T / 128; chunk += gridDim.x) {
        __syncthreads();
        if (tid < 16) lcnt[tid] = 0;
        __syncthreads();
        for (int pass = 0; pass < 8; ++pass) {
            const int tl0 = wave * 16 + 2 * pass; const size_t tok0 = (size_t)chunk * 128 + tl0;
            float va[16], vb[16];
            load_row_bf16(va, XB + tok0 * DM, lane); load_row_bf16(vb, XB + (tok0 + 1) * DM, lane);
            ln_row(va, g, bta, lane); ln_row(vb, g, bta, lane);
            store_row_bf16(va, XB + tok0 * DM, lane); store_row_bf16(vb, XB + (tok0 + 1) * DM, lane);
            float pa[16], pb[16];
#pragma unroll
            for (int e = 0; e < 16; ++e) { pa[e] = 0.f; pb[e] = 0.f; }
#pragma unroll
            for (int k = 0; k < 16; ++k)
#pragma unroll
                for (int e4 = 0; e4 < 4; ++e4) {
                    const f32x4 w = *(const LAS f32x4*)(rw + (((k * 4 + e4) * 64 + lane) << 2));
#pragma unroll
                    for (int ee = 0; ee < 4; ++ee) { pa[4 * e4 + ee] += va[k] * w[ee]; pb[4 * e4 + ee] += vb[k] * w[ee]; }
                }
            const float ra = reduce16(pa, lane), rb = reduce16(pb, lane);
            float lga[16], lgb[16];
#pragma unroll
            for (int e = 0; e < 16; ++e) { lga[e] = __builtin_bit_cast(float, __builtin_amdgcn_readlane(__builtin_bit_cast(int, ra), 4 * e)); lgb[e] = __builtin_bit_cast(float, __builtin_amdgcn_readlane(__builtin_bit_cast(int, rb), 4 * e)); }
            route_token(lga, rbias, tok0, tl0, TT, lcnt, tinfo, lane);
            route_token(lgb, rbias, tok0 + 1, tl0 + 1, TT, lcnt, tinfo, lane);
        }
        __syncthreads();
        if (tid < 16) lbase[tid] = (int)__hip_atomic_fetch_add(cnt + 64 * tid, (unsigned)lcnt[tid], RLX_AGENT);
        __syncthreads();
        if (tid < 256) { const int tl = tid >> 1, k = tid & 1; const int e = tinfo[tl * 4 + 2 * k], lr = tinfo[tl * 4 + 2 * k + 1];
            const int rk = lbase[e] + lr; TT.rank[((size_t)chunk * 128 + tl) * 2 + k] = rk; list[(size_t)e * T + rk] = chunk * 128 + tl; }
    }
    __syncthreads();
}

__device__ __forceinline__ int build_expert_tables(const gu32* cnt, LAS unsigned char* lds, int tid) {
    LAS int* pstart = (LAS int*)(lds + PSTART_OFF); LAS unsigned char* texp = lds + TEXP_OFF; LAS int* ntl = (LAS int*)(lds + NTL_OFF); LAS int* tstart = (LAS int*)(lds + TSTART_OFF); LAS int* ecnt = (LAS int*)(lds + ECNT_OFF);
    __syncthreads();
    if (tid == 0) {
        int acc = 0;
        for (int e = 0; e < NEXP; ++e) { const int c = (int)__hip_atomic_load(cnt + 64 * e, RLX_AGENT); const int nt = (c + 255) >> 8; pstart[e] = acc * 256; tstart[e] = acc; ecnt[e] = c; for (int i = 0; i < nt; ++i) texp[acc + i] = (unsigned char)e; acc += nt; }
        *ntl = acc;
    }
    __syncthreads();
    return *ntl;
}

__device__ __forceinline__ void phase_combine(bf16* XB, float* out, const bf16* YB, const TokTabs& TT, const LAS int* pstart, const float* g, const float* bta, int gw, int NGW, int lane) {
    for (int tok = gw; tok < T; tok += NGW) {
        const int p0 = pstart[TT.e[tok * 2]] + TT.rank[tok * 2], p1 = pstart[TT.e[tok * 2 + 1]] + TT.rank[tok * 2 + 1]; const float g0 = TT.g[tok * 2], g1 = TT.g[tok * 2 + 1];
        float v[16], y0[16], y1[16];
        load_row_bf16(v, XB + (size_t)tok * DM, lane); load_row_bf16(y0, YB + (size_t)p0 * DM, lane); load_row_bf16(y1, YB + (size_t)p1 * DM, lane);
#pragma unroll
        for (int k = 0; k < 16; ++k) v[k] = v[k] * ALPHA + g0 * y0[k] + g1 * y1[k];
        ln_row(v, g, bta, lane);
        if (out) store_row_f32(v, out + (size_t)tok * DM, lane); else store_row_bf16(v, XB + (size_t)tok * DM, lane);
    }
}

#ifndef DUPMASK
#define DUPMASK 0
#endif
struct Args { InPtrs in; float* out; unsigned char* ws; int layer, pad; };

template <int SLOT>
__device__ __forceinline__ void do_slot(const Args& args, int layer, LAS unsigned char* lds) {
    int tidL = threadIdx.x; asm volatile("" : "+v"(tidL));
    const int tid = tidL, lane = tidL & 63, wave = __builtin_amdgcn_readfirstlane(tidL >> 6);
    const int G = gridDim.x, gw = blockIdx.x * NWAVES + wave, NGW = G * NWAVES, gtid = blockIdx.x * (NWAVES * 64) + tidL, NTH = G * NWAVES * 64;
    unsigned char* ws = args.ws; asm volatile("" : "+s"(ws));
    float* X = args.out; asm volatile("" : "+s"(X));
    const int i2 = layer >> 1;
    TokTabs TT; TT.e = (int*)(ws + WS_TOK); TT.g = (float*)(ws + WS_TOK + 262144); TT.rank = (int*)(ws + WS_TOK + 2 * 262144); TT.pos = (int*)(ws + WS_TOK + 3 * 262144);
    gu32* cnt = (gu32*)(ws + WS_CTL) + CW_CNT + layer * 16 * 64;
    bf16* XB = (bf16*)(ws + WS_XB);
    bf16* Qb = (bf16*)(ws + WS_Q); bf16* Kb = (bf16*)(ws + WS_K); bf16* Vb = (bf16*)(ws + WS_V); bf16* Ob = (bf16*)(ws + WS_O);
    bf16* OP = (bf16*)(ws + WS_OP); float* LSE = (float*)(ws + WS_LSE);
    bf16* Ub = (bf16*)(ws + WS_U); bf16* XS = (bf16*)(ws + WS_XS); bf16* Hb = (bf16*)(ws + WS_H);
    const float* cosT = (const float*)(ws + WS_ROPE); const float* sinT = cosT + SEQ * 32;
    const float* SMp = (const float*)(ws + WS_SMALL);
    LAS int* pstart = (LAS int*)(lds + PSTART_OFF); LAS unsigned char* texp = lds + TEXP_OFF;
    (void)tid; (void)lane; (void)gw; (void)NGW; (void)gtid; (void)NTH; (void)i2; (void)TT; (void)cnt; (void)XB; (void)Qb; (void)Kb; (void)Vb; (void)Ob; (void)OP; (void)LSE; (void)Ub; (void)XS; (void)Hb;
    (void)cosT; (void)sinT; (void)SMp; (void)pstart; (void)texp; (void)X;

    if constexpr (SLOT == 0) { phase_prologue(args.in, ws, lds, gw, NGW, lane, wave, gtid, NTH); }
    if constexpr (SLOT == 1) {
        Sched S{T / 256, 12, (T / 256) * 12, G, (int)blockIdx.x, (const char*)XB, (const char*)(ws + WS_WQKV) + (size_t)i2 * 3072 * DM * 2, (size_t)256 * DM * 2, 0, (size_t)256 * DM * 2, 0, nullptr, nullptr, nullptr, nullptr};
        EpiQKV E{Qb, (size_t)(WS_K - WS_Q) / 2, cosT, sinT};
        pg8::gemm_phase<EpiQKV, Sched, true>(lds, pg8::Gemm{DM, DM, DM}, S, E);
    }
    if constexpr (SLOT == 2) {
        AttnP P{Qb, Kb, Vb, Ob, OP, LSE};
        phase_attention(P, SMp + SM_RPB + (size_t)i2 * 8 * 465, lds, gw, NGW, tid, lane, wave);
    }
    if constexpr (SLOT == 3) { phase_merge(OP, LSE, Ob, gtid, NTH); }
    if constexpr (SLOT == 4) {
        Sched S{T / 256, 4, (T / 256) * 4, G, (int)blockIdx.x, (const char*)Ob, (const char*)(ws + WS_WO) + (size_t)i2 * DM * DM * 2, (size_t)256 * DM * 2, 0, (size_t)256 * DM * 2, 0, nullptr, nullptr, nullptr, nullptr};
        EpiRes E{XB, nullptr};
        pg8::gemm_phase<EpiRes, Sched, true>(lds, pg8::Gemm{DM, DM, DM}, S, E);
    }
    if constexpr (SLOT == 5) { phase_pool(XB, Ub, gtid, NTH); }
    if constexpr (SLOT == 6) {
        Sched S{T / 256, 4, (T / 256) * 4, G, (int)blockIdx.x, (const char*)Ub, (const char*)(ws + WS_WP) + (size_t)i2 * 4 * 65536 * 2, (size_t)256 * DM * 2, (size_t)512, (size_t)65536 * 2, 0, nullptr, nullptr, nullptr, nullptr};
        EpiRes E{XB, SMp + SM_PSC + (size_t)i2 * DM};
        pg8::gemm_phase<EpiRes, Sched, true>(lds, pg8::Gemm{DM, 256, 256}, S, E);
    }
    if constexpr (SLOT == 7) {
        phase_lnr(XB, SMp + SM_LNG + (size_t)(layer * 2) * DM, SMp + SM_LNB + (size_t)(layer * 2) * DM, SMp + SM_RW, SMp + SM_RB, TT, (int*)(ws + WS_LIST), cnt, lds, tid, lane, wave);
    }
    if constexpr (SLOT == 9) {
        const int ntiles = build_expert_tables(cnt, lds, tid);
        Sched S{ntiles, 8, ntiles * 8, G, (int)blockIdx.x, (const char*)XB, (const char*)(ws + WS_W13) + (size_t)layer * NEXP * 2048 * DM * 2, 0, 0, (size_t)256 * DM * 2, (size_t)2048 * DM * 2, texp,
                (const LAS int*)(lds + TSTART_OFF), (const LAS int*)(lds + ECNT_OFF), (const int*)(ws + WS_LIST)};
        EpiSwiGLU E{Hb};
        pg8::gemm_phase<EpiSwiGLU, Sched, true, true>(lds, pg8::Gemm{DM, DM, DM}, S, E);
    }
    if constexpr (SLOT == 10) {
        const int ntiles = build_expert_tables(cnt, lds, tid);
        Sched S{ntiles, 4, ntiles * 4, G, (int)blockIdx.x, (const char*)Hb, (const char*)(ws + WS_W2) + (size_t)layer * NEXP * DM * DM * 2, (size_t)256 * DM * 2, 0, (size_t)256 * DM * 2, (size_t)DM * DM * 2, texp, nullptr, nullptr, nullptr};
        EpiBf16 E{XS};
        pg8::gemm_phase<EpiBf16, Sched, true>(lds, pg8::Gemm{DM, DM, DM}, S, E);
    }
    if constexpr (SLOT == 11) {
        (void)build_expert_tables(cnt, lds, tid);
        phase_combine(XB, layer == DEPTH - 1 ? X : nullptr, XS, TT, pstart, SMp + SM_LNG + (size_t)(layer * 2 + 1) * DM, SMp + SM_LNB + (size_t)(layer * 2 + 1) * DM, gw, NGW, lane);
    }
}

#if MK_MULTI_LAUNCH
template <int SLOT>
__global__ void __launch_bounds__(NWAVES * 64, 2) k_slot(Args args) {
    extern __shared__ __attribute__((aligned(16))) unsigned char lds_raw[];
    LAS unsigned char* lds = (LAS unsigned char*)lds_raw;
    for (int u = threadIdx.x; u < (LDS_BYTES - RING_BYTES) / 4; u += NWAVES * 64) ((LAS unsigned*)(lds + RING_BYTES))[u] = 0u;
    __syncthreads();
    do_slot<SLOT>(args, args.layer, lds);
}
template <int SLOT> static void launch_slot(const Args& a, int grid, hipStream_t stream) {
    static bool attr_set = false;
    if (!attr_set) { (void)hipFuncSetAttribute((const void*)k_slot<SLOT>, hipFuncAttributeMaxDynamicSharedMemorySize, LDS_BYTES); attr_set = true; }
    hipLaunchKernelGGL(k_slot<SLOT>, dim3(grid), dim3(NWAVES * 64), LDS_BYTES, stream, a);
}
#else
__global__ void __launch_bounds__(NWAVES * 64, 2) fwd(Args args) {
    extern __shared__ __attribute__((aligned(16))) unsigned char lds_raw[];
    LAS unsigned char* lds = (LAS unsigned char*)lds_raw;
    volatile LAS unsigned* MISC = (volatile LAS unsigned*)(lds + MISC_OFF);
    for (int u = threadIdx.x; u < (LDS_BYTES - RING_BYTES) / 4; u += NWAVES * 64) ((LAS unsigned*)(lds + RING_BYTES))[u] = 0u;
    __syncthreads();
    const XcdBarrier bar = xcd_barrier_post((unsigned*)((gu32*)(args.ws + WS_CTL) + CW_BAR), MISC + 8);
    do_slot<0>(args, 0, lds);
    if constexpr (DUPMASK & 1) { xcd_barrier(bar); do_slot<0>(args, 0, lds); }
#define RUN(S, L) xcd_barrier(bar); do_slot<S>(args, L, lds); if constexpr ((DUPMASK >> S) & 1) { xcd_barrier(bar); do_slot<S>(args, L, lds); }
#define MOE_SLOTS(L) RUN(7, L) RUN(9, L) RUN(10, L) RUN(11, L)
#define LAYER_ATT(L) RUN(1, L) RUN(2, L) RUN(3, L) RUN(4, L) MOE_SLOTS(L)
#define LAYER_POOL(L) RUN(5, L) RUN(6, L) MOE_SLOTS(L)
    LAYER_ATT(0) LAYER_POOL(1) LAYER_ATT(2) LAYER_POOL(3)
#undef RUN
#undef MOE_SLOTS
#undef LAYER_ATT
#undef LAYER_POOL
}
#endif

extern "C" void kernel_launch(void* const* d_in, const int* in_sizes, int n_in, void* d_out, int out_size, void* d_ws, size_t ws_size, hipStream_t stream) {
    static int grid = 0;
    if (grid == 0) {
        if (n_in != 13 || in_sizes[0] != T * DM || out_size != T * DM || ws_size < WS_END) {
            fprintf(stderr, "kernel_launch: unexpected shapes (n_in %d, in0 %d, out %d, ws %zu; need ws >= %zu); nothing launched\n", n_in, n_in > 0 ? in_sizes[0] : -1, out_size, ws_size, (size_t)WS_END); grid = -1; return; }
        int dev = 0, cus = 0;
        if (hipGetDevice(&dev) != hipSuccess || hipDeviceGetAttribute(&cus, hipDeviceAttributeMultiprocessorCount, dev) != hipSuccess) { fprintf(stderr, "kernel_launch: device query failed\n"); grid = -1; return; }
#if !MK_MULTI_LAUNCH
        int per_cu = 0;
        if (hipFuncSetAttribute((const void*)fwd, hipFuncAttributeMaxDynamicSharedMemorySize, LDS_BYTES) != hipSuccess) { fprintf(stderr, "kernel_launch: hipFuncSetAttribute failed\n"); grid = -1; return; }
        if (hipOccupancyMaxActiveBlocksPerMultiprocessor(&per_cu, (const void*)fwd, NWAVES * 64, LDS_BYTES) != hipSuccess || per_cu < 1)
            fprintf(stderr, "kernel_launch: note: occupancy query reports %d workgroups per CU\n", per_cu);
        (void)hipGetLastError();
#endif
        grid = cus;
    }
    if (grid < 0) return;
    if (hipMemsetAsync((char*)d_ws + WS_CTL, 0, CTL_ZERO_BYTES, stream) != hipSuccess) { fprintf(stderr, "kernel_launch: memset failed\n"); return; }
    Args a{};
    const float** ip = (const float**)&a.in;
    for (int i = 0; i < 13; ++i) ip[i] = (const float*)d_in[i];
    a.out = (float*)d_out; a.ws = (unsigned char*)d_ws; a.layer = 0; a.pad = 0;
#if MK_MULTI_LAUNCH
    launch_slot<0>(a, grid, stream);
    for (int layer = 0; layer < DEPTH; ++layer) {
        a.layer = layer;
        if ((layer & 1) == 0) { launch_slot<1>(a, grid, stream); launch_slot<2>(a, grid, stream); launch_slot<3>(a, grid, stream); launch_slot<4>(a, grid, stream); }
        else { launch_slot<5>(a, grid, stream); launch_slot<6>(a, grid, stream); }
        launch_slot<7>(a, grid, stream); launch_slot<9>(a, grid, stream); launch_slot<10>(a, grid, stream); launch_slot<11>(a, grid, stream);
    }
#else
    hipLaunchKernelGGL(fwd, dim3(grid), dim3(NWAVES * 64), LDS_BYTES, stream, a);
#endif
    const hipError_t le = hipPeekAtLastError();
    if (le != hipSuccess) fprintf(stderr, "kernel_launch: launch failed: %s\n", hipGetErrorName(le));
}
```

```cpp
#include <hip/hip_runtime.h>
#include <cstdio>
#include <cstdint>
#include <cmath>

#ifndef MK_MULTI_LAUNCH
#define MK_MULTI_LAUNCH 0
#endif

namespace pg8 {
#define PG8_LAS __attribute__((address_space(3)))
typedef unsigned short bf16_t;
typedef short bf16x8 __attribute__((ext_vector_type(8)));
typedef float f32x4 __attribute__((ext_vector_type(4)));
typedef unsigned u32x4 __attribute__((ext_vector_type(4)));
constexpr int BM = 256, BK = 64, HALF = 128, HTB = HALF * BK * 2  , STAGE_BYTES = 8 * HTB, NXCD = 8, WGM = 8;

__host__ __device__ __forceinline__ int lds_byte(int r, int c) { const int st = (r >> 4) * 2 + (c >> 5), rr = r & 15, cc = c & 31, ob = rr * 64 + cc * 2; return st * 1024 + (ob ^ (((ob >> 9) & 1) << 5)); }
__host__ __device__ __forceinline__ void stage_rc(int b, int& R, int& C) { const int st = b / 1024, sb = b % 1024, swz = sb ^ (((sb >> 9) & 1) << 5); R = (st >> 1) * 16 + swz / 64; C = (st & 1) * 32 + (swz % 64) / 2; }
__host__ __device__ __forceinline__ int perm32(int rho) { const int n = rho >> 4, i = rho & 15; return 8 * (i >> 2) + 4 * n + (i & 3); }

struct Unit { int pm, pn; };
struct Gemm { int lda, ldb, K; };

typedef _Float16 h16x8 __attribute__((ext_vector_type(8))); typedef _Float16 h16x2 __attribute__((ext_vector_type(2))); typedef float f32x2 __attribute__((ext_vector_type(2)));
__device__ __forceinline__ unsigned cvt_pk16(float lo, float hi) { const f32x2 v = {lo, hi}; const h16x2 b = __builtin_convertvector(v, h16x2); return __builtin_bit_cast(unsigned, b); }

constexpr int GATHER_TAB_OFF = 131072 + 2048;
template <class Epi, class Sched, bool ALIGN_EPI, bool GATHER = false>
__device__ __forceinline__ void gemm_phase(PG8_LAS unsigned char* lds, const Gemm g, const Sched& S, const Epi& E) {
    int tid_ = threadIdx.x; asm volatile("" : "+v"(tid_));
    const int tid = tid_, wid = __builtin_amdgcn_readfirstlane(tid >> 6), lane = tid & 63, wr = wid >> 2, wc = wid & 3, fr = lane & 15, fq = lane >> 4;
    const int K = g.K, nt = K / BK;
    unsigned voffA[2], voffB[2];
#pragma unroll
    for (int i = 0; i < 2; ++i) { int R, C; stage_rc(tid * 16 + i * 8192, R, C); const int Rb = 64 * (R >> 5) + perm32(R & 31);
        voffA[i] = (unsigned)(R * g.lda + C) * 2u; voffB[i] = (unsigned)(Rb * g.ldb + C) * 2u; }
    const size_t kstep = (size_t)(BK * 2);
    const size_t hstepA = (size_t)HALF * g.lda * 2;
    const size_t hstepB = (size_t)32 * g.ldb * 2;
    const unsigned ldsw = (unsigned)wid * 1024u;
    const int aoff = lds_byte(wr * 64 + fr, fq * 8), boff = lds_byte(wc * 32 + fr, fq * 8);
#define PG8_SA(b, h) (((b) * 2 + (h)) * HTB)
#define PG8_SB(b, h) ((4 + (b) * 2 + (h)) * HTB)
#define PG8_STAGE(bufoff, gbase, voff) do { _Pragma("unroll") for (int _i = 0; _i < 2; ++_i) \
        __builtin_amdgcn_global_load_lds((const unsigned*)((const char*)(gbase) + (voff)[_i]), (PG8_LAS unsigned*)(lds + (bufoff) + ldsw + _i * 8192), 16, 0, 0); } while (0)
#define PG8_STAGE_A(bufoff, gbase, h, usenext) do { if constexpr (GATHER) { unsigned _v[2]; _v[0] = (usenext) ? nvA[h][0] : cvA[h][0]; _v[1] = (usenext) ? nvA[h][1] : cvA[h][1]; PG8_STAGE(bufoff, gbase, _v); } \
        else { PG8_STAGE(bufoff, (gbase) + (h) * hstepA, voffA); } } while (0)
#define PG8_LDA(dst, b, h) do { _Pragma("unroll") for (int m = 0; m < 4; ++m) _Pragma("unroll") for (int k = 0; k < 2; ++k) dst[m][k] = *(const PG8_LAS bf16x8*)(lds + PG8_SA(b, h) + aoff + m * 2048 + k * 1024); } while (0)
#define PG8_LDB(dst, b, h) do { _Pragma("unroll") for (int n = 0; n < 2; ++n) _Pragma("unroll") for (int k = 0; k < 2; ++k) dst[n][k] = *(const PG8_LAS bf16x8*)(lds + PG8_SB(b, h) + boff + n * 2048 + k * 1024); } while (0)
#define PG8_MMA(ai, bj, At, Bt) do { __builtin_amdgcn_s_setprio(1); _Pragma("unroll") for (int m = 0; m < 4; ++m) _Pragma("unroll") for (int n = 0; n < 2; ++n) _Pragma("unroll") for (int k = 0; k < 2; ++k) \
        acc[ai][bj][m][n] = __builtin_amdgcn_mfma_f32_16x16x32_f16(__builtin_bit_cast(h16x8, Bt[n][k]), __builtin_bit_cast(h16x8, At[m][k]), acc[ai][bj][m][n], 0, 0, 0); __builtin_amdgcn_s_setprio(0); } while (0)
#define PG8_WAIT_V(n) asm volatile("s_waitcnt vmcnt(" #n ")" ::: "memory")
#define PG8_WAIT_L(n) asm volatile("s_waitcnt lgkmcnt(" #n ")" ::: "memory")
#define PG8_BAR __builtin_amdgcn_s_barrier()
#define PG8_SCHED __builtin_amdgcn_sched_barrier(0)
    Unit cur, nxt; int ui = 0;
    const char* cA; const char* cB; const char* nA; const char* nB;
    if (!S.next(0, cur.pm, cur.pn, cA, cB)) return;
    f32x4 acc[2][2][4][2];
#pragma unroll
    for (int a = 0; a < 2; ++a)
#pragma unroll
        for (int b = 0; b < 2; ++b)
#pragma unroll
            for (int m = 0; m < 4; ++m)
#pragma unroll
                for (int n = 0; n < 2; ++n) acc[a][b][m][n] = (f32x4){0.f, 0.f, 0.f, 0.f};
    bf16x8 At[4][2], B0[2][2], B1[2][2];
    unsigned cvA[2][2] = {{0u, 0u}, {0u, 0u}}, nvA[2][2] = {{0u, 0u}, {0u, 0u}}; int Rl[2], Cl[2], nnv = 0;
#pragma unroll
    for (int i = 0; i < 2; ++i) stage_rc(tid * 16 + i * 8192, Rl[i], Cl[i]);
    if constexpr (GATHER) {
        const int* lp; int nv; S.rows(cur.pm, lp, nv);
        if (wid == 0) __builtin_amdgcn_global_load_lds((const unsigned*)(lp + 4 * lane), (PG8_LAS unsigned*)(lds + GATHER_TAB_OFF), 16, 0, 0);
        PG8_WAIT_V(0); PG8_BAR;
        const PG8_LAS int* tab = (const PG8_LAS int*)(lds + GATHER_TAB_OFF);
#pragma unroll
        for (int h = 0; h < 2; ++h)
#pragma unroll
            for (int i = 0; i < 2; ++i) { const int r = 128 * h + Rl[i]; const int tok = r < nv ? tab[r] : 0; cvA[h][i] = (unsigned)(tok * g.lda + Cl[i]) * 2u; }
    }
    PG8_STAGE(PG8_SB(0, 0), cB, voffB); PG8_STAGE(PG8_SB(0, 1), cB + hstepB, voffB); PG8_STAGE_A(PG8_SA(0, 0), cA, 0, false); PG8_STAGE_A(PG8_SA(0, 1), cA, 1, false);
    if (wr == 1) PG8_BAR;
    PG8_WAIT_V(2); PG8_BAR;
    PG8_STAGE(PG8_SB(1, 0), cB + kstep, voffB); PG8_STAGE_A(PG8_SA(1, 0), cA + kstep, 0, false); PG8_STAGE(PG8_SB(1, 1), cB + hstepB + kstep, voffB);
    PG8_WAIT_V(6); PG8_BAR;
    for (;;) {
        const bool has_next = S.next(ui + 1, nxt.pm, nxt.pn, nA, nB);
        if (!has_next) { nA = cA; nB = cB; }
        if constexpr (GATHER) { if (has_next) { const int* lp; S.rows(nxt.pm, lp, nnv);
            if (wid == 0) __builtin_amdgcn_global_load_lds((const unsigned*)(lp + 4 * lane), (PG8_LAS unsigned*)(lds + GATHER_TAB_OFF + 1024 * ((ui + 1) & 1)), 16, 0, 0); } }
        for (int t = 0; t < nt; t += 2) {
            const bool last = (t == nt - 2);
            if constexpr (GATHER) { if (last) {
                if (has_next) { const PG8_LAS int* tab = (const PG8_LAS int*)(lds + GATHER_TAB_OFF + 1024 * ((ui + 1) & 1));
#pragma unroll
                    for (int h = 0; h < 2; ++h)
#pragma unroll
                        for (int i = 0; i < 2; ++i) { const int r = 128 * h + Rl[i]; const int tok = r < nnv ? tab[r] : 0; nvA[h][i] = (unsigned)(tok * g.lda + Cl[i]) * 2u; } }
                else {
#pragma unroll
                    for (int h = 0; h < 2; ++h)
#pragma unroll
                        for (int i = 0; i < 2; ++i) nvA[h][i] = cvA[h][i]; } } }
            const char* a1 = cA + (size_t)(t + 1) * kstep;
            const char* a2 = last ? nA : cA + (size_t)(t + 2) * kstep; const char* b2 = last ? nB : cB + (size_t)(t + 2) * kstep;
            const char* a3 = a2 + kstep; const char* b3 = b2 + kstep;
            PG8_LDB(B0, 0, 0); PG8_LDB(B1, 0, 1); PG8_SCHED; PG8_LDA(At, 0, 0); PG8_STAGE_A(PG8_SA(1, 1), a1, 1, false);
            PG8_WAIT_V(8); PG8_WAIT_L(0); PG8_BAR; PG8_MMA(0, 0, At, B0); PG8_MMA(0, 1, At, B1); PG8_BAR; PG8_SCHED;
            PG8_LDA(At, 0, 1); PG8_STAGE(PG8_SB(0, 0), b2, voffB); PG8_STAGE(PG8_SB(0, 1), b2 + hstepB, voffB); PG8_STAGE_A(PG8_SA(0, 0), a2, 0, last);
            PG8_WAIT_V(8); PG8_WAIT_L(0); PG8_BAR; PG8_MMA(1, 0, At, B0); PG8_MMA(1, 1, At, B1); PG8_BAR; PG8_SCHED;
            PG8_LDB(B0, 1, 0); PG8_LDB(B1, 1, 1); PG8_SCHED; PG8_LDA(At, 1, 0); PG8_STAGE_A(PG8_SA(0, 1), a2, 1, last);
            PG8_WAIT_V(8); PG8_WAIT_L(0); PG8_BAR; PG8_MMA(0, 0, At, B0); PG8_MMA(0, 1, At, B1); PG8_BAR; PG8_SCHED;
            PG8_LDA(At, 1, 1); PG8_STAGE(PG8_SB(1, 0), b3, voffB); PG8_STAGE(PG8_SB(1, 1), b3 + hstepB, voffB); PG8_STAGE_A(PG8_SA(1, 0), a3, 0, last);
            PG8_WAIT_V(8); PG8_WAIT_L(0); PG8_BAR; PG8_MMA(1, 0, At, B0); PG8_MMA(1, 1, At, B1); PG8_BAR; PG8_SCHED;
        }
        if constexpr (ALIGN_EPI) { if (wr == 0) PG8_BAR; }
        E(acc, cur, wr, wc, fr, fq);
        if (!has_next) break;
#pragma unroll
        for (int a = 0; a < 2; ++a)
#pragma unroll
            for (int b = 0; b < 2; ++b)
#pragma unroll
                for (int m = 0; m < 4; ++m)
#pragma unroll
                    for (int n = 0; n < 2; ++n) acc[a][b][m][n] = (f32x4){0.f, 0.f, 0.f, 0.f};
        cur.pm = nxt.pm; cur.pn = nxt.pn; cA = nA; cB = nB; ++ui;
        if constexpr (GATHER) {
#pragma unroll
            for (int h = 0; h < 2; ++h)
#pragma unroll
                for (int i = 0; i < 2; ++i) cvA[h][i] = nvA[h][i]; }
        if constexpr (ALIGN_EPI) { if (wr == 1) PG8_BAR; }
    }
    PG8_WAIT_V(0);
    if constexpr (!ALIGN_EPI) { if (wr == 0) PG8_BAR; }
    PG8_BAR;
#undef PG8_SA
#undef PG8_SB
#undef PG8_STAGE
#undef PG8_STAGE_A
#undef PG8_LDA
#undef PG8_LDB
#undef PG8_MMA
#undef PG8_WAIT_V
#undef PG8_WAIT_L
#undef PG8_BAR
#undef PG8_SCHED
}
}

constexpr int NWAVES = 8;
constexpr int BATCH = 4, SEQ = 8192, DM = 1024, T = BATCH * SEQ, DEPTH = 4;
constexpr int NEXP = 16;
constexpr int PROWS = 2 * T + NEXP * 256;
constexpr float LN_EPS = 1e-5f;
constexpr float ALPHA = 1.681792830507429f;
constexpr float QSCALE = 0.125f * 1.4426950408889634f;
constexpr float LOG2E = 1.4426950408889634f;

constexpr size_t MiB = 1u << 20;
constexpr size_t WS_CTL = 0, CTL_ZERO_BYTES = 1 * MiB;
constexpr size_t WS_ROPE = 1 * MiB;
constexpr size_t WS_WQKV = 3 * MiB;
constexpr size_t WS_WO = 15 * MiB;
constexpr size_t WS_WP = 19 * MiB;
constexpr size_t WS_W13 = 20 * MiB;
constexpr size_t WS_W2 = 276 * MiB;
constexpr size_t WS_XB = 404 * MiB;
constexpr size_t WS_Y = 468 * MiB;
constexpr size_t WS_OP = WS_Y, WS_LSE = WS_Y + 96 * MiB;
constexpr size_t WS_R = 596 * MiB;
constexpr size_t WS_Q = WS_R, WS_K = WS_R + 64 * MiB, WS_V = WS_R + 128 * MiB, WS_O = WS_R + 192 * MiB;
constexpr size_t WS_U = WS_R;
constexpr size_t WS_XS = WS_R, WS_H = WS_R + 136 * MiB;
constexpr size_t WS_TOK = 868 * MiB;
constexpr size_t WS_SMALL = 869 * MiB;
constexpr int SM_RPB = 0, SM_PSC = 7440, SM_RW = 9488, SM_RB = 25872, SM_LNG = 25888, SM_LNB = 34080, SM_END = 42272;
constexpr size_t WS_LIST = 870 * MiB;
constexpr size_t WS_END = 872 * MiB;
static_assert((size_t)PROWS * DM * 2 <= 136 * MiB && WS_H + 136 * MiB <= WS_TOK, "d_ws map");

constexpr int CW_BAR = 4096;
constexpr int CW_CNT = 16384;

constexpr int RING_BYTES = 131072;
constexpr int MISC_OFF = RING_BYTES + 320;
constexpr int LDS_BYTES = 147456;
constexpr int TEXP_OFF = RING_BYTES + 1024;
constexpr int PSTART_OFF = RING_BYTES + 1536, NTL_OFF = RING_BYTES + 1600;
constexpr int TSTART_OFF = RING_BYTES + 1664, ECNT_OFF = RING_BYTES + 1728;

#define GAS __attribute__((address_space(1)))
#define LAS __attribute__((address_space(3)))
typedef unsigned short bf16;
typedef unsigned v4u __attribute__((ext_vector_type(4)));
typedef unsigned v2u __attribute__((ext_vector_type(2)));
typedef float f32x4 __attribute__((ext_vector_type(4)));
typedef float f32x16 __attribute__((ext_vector_type(16)));
typedef short bf16x8 __attribute__((ext_vector_type(8)));
typedef short s16x4 __attribute__((ext_vector_type(4)));
typedef GAS unsigned gu32;
#define RLX_AGENT __ATOMIC_RELAXED, __HIP_MEMORY_SCOPE_AGENT
#define LDS_WAIT() asm volatile("s_waitcnt lgkmcnt(0)" ::: "memory")
__device__ __forceinline__ unsigned pk2(float lo, float hi) { return pg8::cvt_pk16(lo, hi); }
__device__ __forceinline__ float bf_lo(unsigned u) { return (float)__builtin_bit_cast(pg8::h16x2, u)[0]; }
__device__ __forceinline__ float bf_hi(unsigned u) { return (float)__builtin_bit_cast(pg8::h16x2, u)[1]; }

#define XB_TMO      128
#define XB_XCNT(j)  (256  + 64 * (j))
#define XB_XSUB(j)  (1280 + 64 * (j))
#define XB_XGEN(j)  (2304 + 64 * (j))
#define XB_TOP      3328
#define XB_TOPGEN   3392
#define XCD_BAR_WORDS 3456
#define XB_SPIN_CAP (1u << 18)

__device__ __forceinline__ unsigned xb_ld(unsigned* p)              { return __hip_atomic_load(p, __ATOMIC_RELAXED, __HIP_MEMORY_SCOPE_AGENT); }
__device__ __forceinline__ unsigned xb_add(unsigned* p, unsigned v) { return __hip_atomic_fetch_add(p, v, __ATOMIC_RELAXED, __HIP_MEMORY_SCOPE_AGENT); }
__device__ __forceinline__ unsigned xb_xcc_id() { return (unsigned)__builtin_amdgcn_s_getreg((3 << 11) | 20) & 0xFu; }
#define XB_SPIN(cond, bar) do { unsigned _sp = 0; while (cond) { __builtin_amdgcn_s_sleep(1); \
    if ((++_sp & 255u) == 0u) { if (xb_ld(&(bar)[XB_TMO])) break; if (_sp > XB_SPIN_CAP) { atomicAdd(&(bar)[XB_TMO], 1u); break; } } } } while (0)

struct XcdBarrier { unsigned* bar; unsigned x; volatile LAS unsigned* st; };

__device__ __forceinline__ XcdBarrier xcd_barrier_post(unsigned* bar, volatile LAS unsigned* st) {
    XcdBarrier b; b.bar = bar; b.x = xb_xcc_id(); b.st = st;
    if (threadIdx.x == 0) (void)xb_add(&bar[XB_XCNT(b.x)], 1u);
    return b;
}
__device__ __forceinline__ void xcd_barrier_complete(unsigned* bar, unsigned x, unsigned& nloc, unsigned& nx) {
    const unsigned G = gridDim.x * gridDim.y * gridDim.z;
    unsigned sum, cnt, mine, sp = 0u;
    for (;;) {
        sum = 0u; cnt = 0u; mine = 0u;
#pragma unroll
        for (unsigned j = 0; j < 16; ++j) { const unsigned c = xb_ld(&bar[XB_XCNT(j)]); sum += c; cnt += (c > 0u) ? 1u : 0u; mine = (j == x) ? c : mine; }
        if (sum == G) break;
        __builtin_amdgcn_s_sleep(1);
        if ((++sp & 255u) == 0u) { if (xb_ld(&bar[XB_TMO])) break; if (sp > XB_SPIN_CAP) { atomicAdd(&bar[XB_TMO], 1u); break; } }
    }
    nloc = mine > 0u ? mine : 1u; nx = cnt > 0u ? cnt : 1u;
}
__device__ __forceinline__ void xcd_barrier(const XcdBarrier& b) {
    asm volatile("s_waitcnt vmcnt(0)" ::: "memory");
    __syncthreads();
    int tid_ = threadIdx.x; asm volatile("" : "+v"(tid_));
    if (tid_ == 0) {
        size_t zb = 0; asm volatile("" : "+s"(zb)); unsigned* bar = b.bar + zb;
        __builtin_amdgcn_s_waitcnt(0);
        unsigned nloc = b.st[0], nx = b.st[1];
        if (nloc == 0u) { xcd_barrier_complete(bar, b.x, nloc, nx); b.st[0] = nloc; b.st[1] = nx; }
        const unsigned old = xb_add(&bar[XB_XSUB(b.x)], 1u);
        const unsigned gen = old / nloc;
        if (old + 1u == (gen + 1u) * nloc) {
            __builtin_amdgcn_fence(__ATOMIC_RELEASE, "agent");
            asm volatile("s_waitcnt vmcnt(0)" ::: "memory");
            const unsigned og = xb_add(&bar[XB_TOP], 1u);
            const unsigned tg = og / nx;
            if (og + 1u == (tg + 1u) * nx) xb_add(&bar[XB_TOPGEN], 1u);
            else XB_SPIN(xb_ld(&bar[XB_TOPGEN]) == tg, bar);
            __builtin_amdgcn_fence(__ATOMIC_ACQUIRE, "agent");
            xb_add(&bar[XB_XGEN(b.x)], 1u);
            asm volatile("s_waitcnt vmcnt(0)" ::: "memory");
        } else {
            XB_SPIN(xb_ld(&bar[XB_XGEN(b.x)]) == gen, bar);
            __builtin_amdgcn_fence(__ATOMIC_ACQUIRE, "agent");
            asm volatile("s_waitcnt vmcnt(0)" ::: "memory");
        }
    }
    __syncthreads();
}

struct Sched {
    int nM, nN, nwg, G, c;
    const char* A; const char* B; size_t a_tile, a_pn, b_tile, e_bytes; const LAS unsigned char* texp;
    const LAS int* tstart; const LAS int* ecnt; const int* list;
    __device__ __forceinline__ void rows(int pm, const int*& lp, int& nv) const {
        const int e = __builtin_amdgcn_readfirstlane((int)texp[pm]); const int mt = pm - __builtin_amdgcn_readfirstlane(tstart[e]);
        lp = list + (size_t)e * T + 256 * mt; nv = min(256, max(0, __builtin_amdgcn_readfirstlane(ecnt[e]) - 256 * mt)); }
    __device__ __forceinline__ bool next(int i, int& pm, int& pn, const char*& pa, const char*& pb) const {
        const long L = (long)i * G + c; if (L >= nwg) return false;
        int wgid = (int)L; { const int q = nwg / pg8::NXCD, r = nwg % pg8::NXCD, xcd = wgid % pg8::NXCD, off = wgid / pg8::NXCD; wgid = (xcd < r ? xcd * (q + 1) : r * (q + 1) + (xcd - r) * q) + off; }
        const int nig = pg8::WGM * nN, gid = wgid / nig, fm = gid * pg8::WGM, gsz = (nM - fm) < pg8::WGM ? (nM - fm) : pg8::WGM;
        pm = fm + ((wgid % nig) % gsz); pn = (wgid % nig) / gsz;
        pa = A + (size_t)pm * a_tile + (size_t)pn * a_pn;
        const char* bb = B + (size_t)pn * b_tile;
        if (texp) { const int e = __builtin_amdgcn_readfirstlane((int)texp[pm]); bb += (size_t)e * e_bytes; }
        pb = bb; return true;
    }
};

using pg8::f32x4;

struct EpiQKV {
    bf16* Q; size_t kv_stride; const float* cosT; const float* sinT;
    __device__ __forceinline__ void operator()(const f32x4 (&acc)[2][2][4][2], const pg8::Unit& u, int wr, int wc, int fr, int fq) const {
        const int sel = u.pn >> 2, head = 4 * (u.pn & 3) + wc;
        bf16* base = Q + (size_t)sel * kv_stride;
        const bool rope = (sel < 2) && ((u.pn & 3) < 2);
        const float sc = sel == 0 ? QSCALE : 1.f;
        const int col0 = 64 * head + 8 * fq;
#pragma unroll
        for (int ai = 0; ai < 2; ++ai)
#pragma unroll
            for (int m = 0; m < 4; ++m) {
                const int row = u.pm * 256 + ai * 128 + wr * 64 + m * 16 + fr;
                f32x4 a0 = acc[ai][0][m][0], a1 = acc[ai][0][m][1], b0 = acc[ai][1][m][0], b1 = acc[ai][1][m][1];
                if (rope) {
                    const int s = row & (SEQ - 1);
                    const f32x4 c0 = *(const f32x4*)(cosT + s * 32 + 8 * fq), c1 = *(const f32x4*)(cosT + s * 32 + 8 * fq + 4);
                    const f32x4 s0 = *(const f32x4*)(sinT + s * 32 + 8 * fq), s1 = *(const f32x4*)(sinT + s * 32 + 8 * fq + 4);
                    const f32x4 na0 = a0 * c0 - b0 * s0, nb0 = b0 * c0 + a0 * s0, na1 = a1 * c1 - b1 * s1, nb1 = b1 * c1 + a1 * s1;
                    a0 = na0; b0 = nb0; a1 = na1; b1 = nb1;
                }
                a0 = a0 * sc; a1 = a1 * sc; b0 = b0 * sc; b1 = b1 * sc;
                bf16* rowp = base + (size_t)row * DM + col0;
                v4u w; w.x = pg8::cvt_pk16(a0[0], a0[1]); w.y = pg8::cvt_pk16(a0[2], a0[3]); w.z = pg8::cvt_pk16(a1[0], a1[1]); w.w = pg8::cvt_pk16(a1[2], a1[3]);
                *(v4u*)rowp = w;
                v4u x; x.x = pg8::cvt_pk16(b0[0], b0[1]); x.y = pg8::cvt_pk16(b0[2], b0[3]); x.z = pg8::cvt_pk16(b1[0], b1[1]); x.w = pg8::cvt_pk16(b1[2], b1[3]);
                *(v4u*)(rowp + 32) = x;
                asm volatile("" ::: "memory");
            }
    }
};
struct EpiRes {
    bf16* XBp; const float* csc;
    __device__ __forceinline__ void operator()(const f32x4 (&acc)[2][2][4][2], const pg8::Unit& u, int wr, int wc, int fr, int fq) const {
        const int col0 = u.pn * 256 + 64 * wc + 8 * fq;
#pragma unroll
        for (int ai = 0; ai < 2; ++ai)
#pragma unroll
            for (int m = 0; m < 4; ++m) {
                const size_t off = (size_t)(u.pm * 256 + ai * 128 + wr * 64 + m * 16 + fr) * DM + col0;
#pragma unroll
                for (int bj = 0; bj < 2; ++bj) {
                    const v4u xr = *(const v4u*)(XBp + off + 32 * bj);
                    f32x4 a0 = acc[ai][bj][m][0], a1 = acc[ai][bj][m][1];
                    if (csc) { a0 = a0 * *(const f32x4*)(csc + col0 + 32 * bj); a1 = a1 * *(const f32x4*)(csc + col0 + 32 * bj + 4); }
                    v4u w;
                    w.x = pg8::cvt_pk16(bf_lo(xr.x) * ALPHA + a0[0], bf_hi(xr.x) * ALPHA + a0[1]); w.y = pg8::cvt_pk16(bf_lo(xr.y) * ALPHA + a0[2], bf_hi(xr.y) * ALPHA + a0[3]);
                    w.z = pg8::cvt_pk16(bf_lo(xr.z) * ALPHA + a1[0], bf_hi(xr.z) * ALPHA + a1[1]); w.w = pg8::cvt_pk16(bf_lo(xr.w) * ALPHA + a1[2], bf_hi(xr.w) * ALPHA + a1[3]);
                    *(v4u*)(XBp + off + 32 * bj) = w;
                }
                asm volatile("" ::: "memory");
            }
    }
};
struct EpiSwiGLU {
    bf16* H;
    __device__ __forceinline__ void operator()(const f32x4 (&acc)[2][2][4][2], const pg8::Unit& u, int wr, int wc, int fr, int fq) const {
        const int col0 = u.pn * 128 + 32 * wc + 8 * fq;
#pragma unroll
        for (int ai = 0; ai < 2; ++ai)
#pragma unroll
            for (int m = 0; m < 4; ++m) {
                const size_t off = (size_t)(u.pm * 256 + ai * 128 + wr * 64 + m * 16 + fr) * DM + col0;
                float h[8];
#pragma unroll
                for (int n = 0; n < 2; ++n)
#pragma unroll
                    for (int e = 0; e < 4; ++e) {
                        const float gt = acc[ai][0][m][n][e], up = acc[ai][1][m][n][e];
                        const float sg = gt * __builtin_amdgcn_rcpf(1.f + __builtin_amdgcn_exp2f(-gt * LOG2E));
                        h[4 * n + e] = sg * up;
                    }
                v4u w; w.x = pg8::cvt_pk16(h[0], h[1]); w.y = pg8::cvt_pk16(h[2], h[3]); w.z = pg8::cvt_pk16(h[4], h[5]); w.w = pg8::cvt_pk16(h[6], h[7]);
                *(v4u*)(H + off) = w;
                asm volatile("" ::: "memory");
            }
    }
};
struct EpiBf16 {
    bf16* O;
    __device__ __forceinline__ void operator()(const f32x4 (&acc)[2][2][4][2], const pg8::Unit& u, int wr, int wc, int fr, int fq) const {
        const int col0 = u.pn * 256 + 64 * wc + 8 * fq;
#pragma unroll
        for (int ai = 0; ai < 2; ++ai)
#pragma unroll
            for (int m = 0; m < 4; ++m) {
                const size_t off = (size_t)(u.pm * 256 + ai * 128 + wr * 64 + m * 16 + fr) * DM + col0;
#pragma unroll
                for (int bj = 0; bj < 2; ++bj) {
                    const f32x4 v0 = acc[ai][bj][m][0], v1 = acc[ai][bj][m][1];
                    v4u w; w.x = pg8::cvt_pk16(v0[0], v0[1]); w.y = pg8::cvt_pk16(v0[2], v0[3]); w.z = pg8::cvt_pk16(v1[0], v1[1]); w.w = pg8::cvt_pk16(v1[2], v1[3]);
                    *(v4u*)(O + off + 32 * bj) = w;
                }
                asm volatile("" ::: "memory");
            }
    }
};

__device__ __forceinline__ float wave_sum(float v) {
#pragma unroll
    for (int o = 1; o < 64; o <<= 1) v += __shfl_xor(v, o);
    return v;
}
__device__ __forceinline__ unsigned cvtpk_s(float lo, float hi) { return pg8::cvt_pk16(lo, hi); }

__device__ __forceinline__ void p0_transpose_item(const float* W, int K, int N, bf16* WT, int k0, int n0, int drow, LAS float* scr, int lane) {
#pragma unroll 8
    for (int i = 0; i < 32; ++i) { const int kk = 2 * i + (lane >> 5); scr[kk * 33 + (lane & 31)] = W[(size_t)(k0 + kk) * N + n0 + (lane & 31)]; }
    LDS_WAIT(); asm volatile("" ::: "memory");
    const int c = lane & 7;
#pragma unroll
    for (int j = 0; j < 4; ++j) { const int n = (lane >> 3) + 8 * j; const LAS float* s = scr + (8 * c) * 33 + n;
        v4u o; o.x = pk2(s[0 * 33], s[1 * 33]); o.y = pk2(s[2 * 33], s[3 * 33]); o.z = pk2(s[4 * 33], s[5 * 33]); o.w = pk2(s[6 * 33], s[7 * 33]);
        *(GAS v4u*)(WT + (size_t)(drow + n) * K + k0 + 8 * c) = o; }
    LDS_WAIT(); asm volatile("" ::: "memory");
}
struct InPtrs { const float *x, *w_in, *w_out, *rpb, *pool_w, *pool_scale, *router_w, *router_bias, *w1, *w3, *w2, *ln_g, *ln_b; };

__device__ __forceinline__ void sincos_d(double a, double& sn, double& cs) {
    const double n = __builtin_rint(a * 0.63661977236758134308);
    double r = __builtin_fma(-n, 1.57079632679489655800e+00, a); r = __builtin_fma(-n, 6.12323399573676603587e-17, r);
    const double z = r * r;
    const double sp = r + r * z * (-1.66666666666666324348e-01 + z * (8.33333333332248946124e-03 + z * (-1.98412698298579493134e-04 + z * (2.75573137070700676789e-06 + z * (-2.50507602534068634195e-08 + z * 1.58969099521155010221e-10)))));
    const double cp = 1.0 - 0.5 * z + z * z * (4.16666666666666019037e-02 + z * (-1.38888888888741095749e-03 + z * (2.48015872894767294178e-05 + z * (-2.75573143513906633035e-07 + z * (2.08757232129817482790e-09 + z * -1.13596475577881948265e-11)))));
    const int q = (int)((long long)n & 3);
    sn = (q == 0) ? sp : (q == 1) ? cp : (q == 2) ? -sp : -cp;
    cs = (q == 0) ? cp : (q == 1) ? -sp : (q == 2) ? -cp : sp;
}

__device__ __forceinline__ void phase_prologue(const InPtrs& in, unsigned char* ws, LAS unsigned char* lds, int gw, int NGW, int lane, int wave, int gtid, int NTH) {
    LAS float* scr = (LAS float*)(lds + wave * 16384);
    constexpr int MOE_ITEMS = DEPTH * NEXP * 3 * 512, IN_ITEMS = 2 * 1536, OUT_ITEMS = 2 * 512, POOL_ITEMS = 8 * 32;
    constexpr int NITEMS = MOE_ITEMS + IN_ITEMS + OUT_ITEMS + POOL_ITEMS;
    for (int it = gw; it < NITEMS; it += NGW) {
        int r = it;
        if (r < MOE_ITEMS) {
            const int mat = r >> 9, loc = r & 511, le = mat / 3, which = mat - 3 * le;
            const int kb = loc >> 5, nb = loc & 31;
            const float* src = (which == 0 ? in.w1 : which == 1 ? in.w3 : in.w2) + (size_t)le * DM * DM;
            if (which < 2) p0_transpose_item(src, DM, DM, (bf16*)(ws + WS_W13) + (size_t)le * 2048 * DM, 64 * kb, 32 * nb, 64 * nb + 32 * which, scr, lane);
            else           p0_transpose_item(src, DM, DM, (bf16*)(ws + WS_W2) + (size_t)le * DM * DM, 64 * kb, 32 * nb, 32 * nb, scr, lane);
            continue;
        }
        r -= MOE_ITEMS;
        if (r < IN_ITEMS) { const int i = r / 1536, loc = r - 1536 * i, kb = loc / 96, nb = loc - 96 * kb;
            p0_transpose_item(in.w_in + (size_t)i * DM * 3072, DM, 3072, (bf16*)(ws + WS_WQKV) + (size_t)i * 3072 * DM, 64 * kb, 32 * nb, 32 * nb, scr, lane); continue; }
        r -= IN_ITEMS;
        if (r < OUT_ITEMS) { const int i = r >> 9, loc = r & 511, kb = loc >> 5, nb = loc & 31;
            p0_transpose_item(in.w_out + (size_t)i * DM * DM, DM, DM, (bf16*)(ws + WS_WO) + (size_t)i * DM * DM, 64 * kb, 32 * nb, 32 * nb, scr, lane); continue; }
        r -= OUT_ITEMS;
        { const int mat = r >> 5, loc = r & 31, kb = loc >> 3, nb = loc & 7;
            p0_transpose_item(in.pool_w + (size_t)mat * 65536, 256, 256, (bf16*)(ws + WS_WP) + (size_t)mat * 65536, 64 * kb, 32 * nb, 32 * nb, scr, lane); }
    }
    bf16* XB = (bf16*)(ws + WS_XB);
    for (int m = gw; m < T; m += NGW) {
        const GAS f32x4* xr = (const GAS f32x4*)(in.x + (size_t)m * DM) + lane;
        GAS unsigned long long* o8 = (GAS unsigned long long*)(XB + (size_t)m * DM) + lane;
#pragma unroll
        for (int j = 0; j < 4; ++j) { const f32x4 v = xr[64 * j]; o8[64 * j] = (unsigned long long)pk2(v.x, v.y) | ((unsigned long long)pk2(v.z, v.w) << 32); }
    }
    { float* sm = (float*)(ws + WS_SMALL);
      for (int i = gtid; i < SM_END; i += NTH) {
          float v;
          if (i < SM_PSC) v = in.rpb[i]; else if (i < SM_RW) v = in.pool_scale[i - SM_PSC]; else if (i < SM_RB) v = in.router_w[i - SM_RW];
          else if (i < SM_LNG) v = in.router_bias[i - SM_RB]; else if (i < SM_LNB) v = in.ln_g[i - SM_LNG]; else v = in.ln_b[i - SM_LNB];
          sm[i] = v; } }
    float* cosT = (float*)(ws + WS_ROPE); float* sinT = cosT + SEQ * 32;
    for (int idx = gw * 64 + lane; idx < SEQ * 32; idx += NGW * 64) {
        const int s = idx >> 5, i = idx & 31;
        double invf = 1.0;
        if (i & 1) invf *= 0.7498942093324559; if (i & 2) invf *= 0.5623413251903491; if (i & 4) invf *= 0.31622776601683794; if (i & 8) invf *= 0.1; if (i & 16) invf *= 0.01;
        double sn, cs; sincos_d((double)s * invf, sn, cs);
        cosT[idx] = (float)cs; sinT[idx] = (float)sn;
    }
}

struct AttnP { const bf16* Q; const bf16* K; const bf16* V; bf16* O; bf16* OP; float* LSE; };
constexpr int V_RS = 144;
constexpr int V_TILE_BYTES = 32 * V_RS;
constexpr int RPB_OFF = 16 * V_TILE_BYTES;

struct AState { float m, lsum; f32x16 o0, o1; };
template <int MODE>
__device__ __forceinline__ void attn_tile(AState& st, const v4u (&kr)[4], const v4u (&vr)[4], const bf16x8 (&qf)[4], LAS unsigned char* vbuf, LAS unsigned char* trbase, int lane, int q4, int e0, const LAS float* bptr) {
    LAS unsigned char* kbuf = vbuf + V_TILE_BYTES;
#pragma unroll
    for (int ii = 0; ii < 4; ++ii) *(LAS v4u*)(kbuf + (8 * ii + (lane >> 3)) * V_RS + 16 * (lane & 7)) = kr[ii];
    bf16x8 kf[4];
#pragma unroll
    for (int d0 = 0; d0 < 4; ++d0) kf[d0] = *(const LAS bf16x8*)(kbuf + (lane & 31) * V_RS + 32 * d0 + 16 * (lane >> 5));
    f32x16 s = {};
#pragma unroll
    for (int d0 = 0; d0 < 4; ++d0) s = __builtin_amdgcn_mfma_f32_32x32x16_f16(__builtin_bit_cast(pg8::h16x8, kf[d0]), __builtin_bit_cast(pg8::h16x8, qf[d0]), s, 0, 0, 0);
    float mx = -INFINITY;
#pragma unroll
    for (int rr = 0; rr < 16; ++rr) {
        const int keyc = (rr & 3) + 8 * (rr >> 2);
        float sv = s[rr];
        if (MODE == 1) sv = (keyc >= q4) ? sv : -INFINITY;
        if (MODE == 2) sv = (keyc <= q4) ? sv : -INFINITY;
        if (MODE == 3) { const int k15c = (rr & 3) + 8 * ((rr >> 2) & 1); const float bias = bptr[(rr >> 3) * 31 + k15c];
            sv = ((unsigned)(e0 + k15c) < 16u) ? sv + bias : -INFINITY; }
        s[rr] = sv; mx = fmaxf(mx, sv);
    }
    mx = fmaxf(mx, __shfl_xor(mx, 32));
    const float mnew = fmaxf(st.m, mx);
    if (__builtin_amdgcn_ballot_w64(mnew > st.m) != 0ull) {
        const float alpha = __builtin_amdgcn_exp2f(st.m - mnew);
        st.lsum *= alpha;
#pragma unroll
        for (int rr = 0; rr < 16; ++rr) { st.o0[rr] *= alpha; st.o1[rr] *= alpha; }
        st.m = mnew;
    }
    float psum = 0.f;
#pragma unroll
    for (int rr = 0; rr < 16; ++rr) { const float p = __builtin_amdgcn_exp2f(s[rr] - mnew); s[rr] = p; psum += p; }
    st.lsum += psum;
    v4u pw0, pw1;
    pw0.x = cvtpk_s(s[0], s[1]); pw0.y = cvtpk_s(s[2], s[3]); pw0.z = cvtpk_s(s[4], s[5]); pw0.w = cvtpk_s(s[6], s[7]);
    pw1.x = cvtpk_s(s[8], s[9]); pw1.y = cvtpk_s(s[10], s[11]); pw1.z = cvtpk_s(s[12], s[13]); pw1.w = cvtpk_s(s[14], s[15]);
    const bf16x8 pf0 = __builtin_bit_cast(bf16x8, pw0), pf1 = __builtin_bit_cast(bf16x8, pw1);
#pragma unroll
    for (int ii = 0; ii < 4; ++ii) *(LAS v4u*)(vbuf + (8 * ii + (lane >> 3)) * V_RS + 16 * (lane & 7)) = vr[ii];
#pragma unroll
    for (int dblk = 0; dblk < 2; ++dblk) {
#pragma unroll
        for (int s2 = 0; s2 < 2; ++s2) {
            const s16x4 lo = __builtin_bit_cast(s16x4, __builtin_amdgcn_ds_read_tr16_b64_v4i16((LAS s16x4*)(trbase + (16 * s2) * V_RS + 64 * dblk)));
            const s16x4 hh = __builtin_bit_cast(s16x4, __builtin_amdgcn_ds_read_tr16_b64_v4i16((LAS s16x4*)(trbase + (16 * s2 + 8) * V_RS + 64 * dblk)));
            const bf16x8 vf = (bf16x8){lo[0], lo[1], lo[2], lo[3], hh[0], hh[1], hh[2], hh[3]};
            if (dblk == 0) st.o0 = __builtin_amdgcn_mfma_f32_32x32x16_f16(__builtin_bit_cast(pg8::h16x8, vf), __builtin_bit_cast(pg8::h16x8, s2 == 0 ? pf0 : pf1), st.o0, 0, 0, 0);
            else           st.o1 = __builtin_amdgcn_mfma_f32_32x32x16_f16(__builtin_bit_cast(pg8::h16x8, vf), __builtin_bit_cast(pg8::h16x8, s2 == 0 ? pf0 : pf1), st.o1, 0, 0, 0);
        }
    }
}
__device__ __forceinline__ void attn_load(const bf16* Kp, const bf16* Vp, int tokV0, int vstride8, int hcol, v4u (&kr)[4], v4u (&vr)[4], int lane) {
#pragma unroll
    for (int ii = 0; ii < 4; ++ii) { const size_t off = (size_t)(tokV0 + ii * vstride8) * DM + hcol + 8 * (lane & 7); kr[ii] = *(const v4u*)(Kp + off); vr[ii] = *(const v4u*)(Vp + off); }
}
__device__ __forceinline__ void attn_store(const AState& st0, bf16* orow, int hi) {
    float lsum = st0.lsum; lsum += __shfl_xor(lsum, 32);
    const float inv = 1.f / lsum;
#pragma unroll
    for (int g = 0; g < 4; ++g) {
        v2u w0, w1;
        w0.x = cvtpk_s(st0.o0[4 * g] * inv, st0.o0[4 * g + 1] * inv); w0.y = cvtpk_s(st0.o0[4 * g + 2] * inv, st0.o0[4 * g + 3] * inv);
        w1.x = cvtpk_s(st0.o1[4 * g] * inv, st0.o1[4 * g + 1] * inv); w1.y = cvtpk_s(st0.o1[4 * g + 2] * inv, st0.o1[4 * g + 3] * inv);
        *(v2u*)(orow + 8 * g + 4 * hi) = w0;
        *(v2u*)(orow + 32 + 8 * g + 4 * hi) = w1;
    }
}
__device__ __forceinline__ void attn_unit_D(const AttnP& P, int unit, LAS unsigned char* vbuf, LAS unsigned char* trbase, int lane) {
    const int q = lane & 31, hi = lane >> 5;
    const int br = unit >> 13, rem = unit & 8191, b = rem >> 11, hD = (rem >> 8) & 7, qblk = rem & 255;
    const int sh = 2 * br, ph = qblk >> (8 - sh), i0 = 32 * (qblk & ((256 >> sh) - 1)), L = SEQ >> sh;
    const int qtok = b * SEQ + ((i0 + q) << sh) + ph, hcol = 64 * hD;
    bf16x8 qf[4];
#pragma unroll
    for (int d0 = 0; d0 < 4; ++d0) qf[d0] = *(const bf16x8*)(P.Q + (size_t)qtok * DM + hcol + 16 * d0 + 8 * hi);
    AState st; st.m = -1e30f; st.lsum = 0.f; st.o0 = (f32x16){}; st.o1 = (f32x16){};
    const int q4 = q - 4 * hi, base = b * SEQ + ph, vs8 = 8 << sh;
    v4u kA[4], kB[4], vA[4], vB[4];
#define D_IN(t) ((i0 - 64 + 32 * (t)) >= 0 && (i0 - 64 + 32 * (t)) < L)
#define D_LOAD(kf, vr, t) do { const int j0 = min(max(i0 - 64 + 32 * (t), 0), L - 32); attn_load(P.K, P.V, base + ((j0 + (lane >> 3)) << sh), vs8, hcol, kf, vr, lane); } while (0)
    D_LOAD(kA, vA, 0);
    D_LOAD(kB, vB, 1); if (D_IN(0)) attn_tile<1>(st, kA, vA, qf, vbuf, trbase, lane, q4, 0, nullptr);
    D_LOAD(kA, vA, 2); if (D_IN(1)) attn_tile<0>(st, kB, vB, qf, vbuf, trbase, lane, q4, 0, nullptr);
    D_LOAD(kB, vB, 3); attn_tile<0>(st, kA, vA, qf, vbuf, trbase, lane, q4, 0, nullptr);
    D_LOAD(kA, vA, 4); if (D_IN(3)) attn_tile<0>(st, kB, vB, qf, vbuf, trbase, lane, q4, 0, nullptr);
    if (D_IN(4)) attn_tile<2>(st, kA, vA, qf, vbuf, trbase, lane, q4, 0, nullptr);
#undef D_IN
#undef D_LOAD
    float lt = st.lsum; lt += __shfl_xor(lt, 32);
    if (hi == 0) P.LSE[((size_t)br * T + qtok) * 8 + hD] = st.m + __builtin_amdgcn_logf(lt);
    attn_store(st, P.OP + ((size_t)br * T + qtok) * 512 + hcol, hi);
}
__device__ __forceinline__ void attn_unit_N(const AttnP& P, int unit, LAS unsigned char* vbuf, LAS unsigned char* trbase, const LAS float* rpbt, int lane) {
    const int q = lane & 31, hi = lane >> 5;
    const int b = unit >> 11, hN = (unit >> 8) & 7, r = (unit & 255) >> 1, qhalf = unit & 1, r0 = min(max(r - 4, 0), 120), c = 32 * qhalf + q, cs = min(max(c - 8, 0), 48);
    const int qtok = b * SEQ + 64 * r + c, hcol = 64 * (8 + hN);
    bf16x8 qf[4];
#pragma unroll
    for (int d0 = 0; d0 < 4; ++d0) qf[d0] = *(const bf16x8*)(P.Q + (size_t)qtok * DM + hcol + 16 * d0 + 8 * hi);
    AState st; st.m = -1e30f; st.lsum = 0.f; st.o0 = (f32x16){}; st.o1 = (f32x16){};
    v4u kA[4], kB[4], vA[4], vB[4];
#define N_LOAD(kf, vr, t) do { const int rp_ = (t) / 3, cc_ = (t) - 3 * rp_ + qhalf; const int rowtok = b * SEQ + 64 * (r0 + 2 * rp_) + 16 * cc_; const int l8 = lane >> 3; \
        _Pragma("unroll") for (int ii = 0; ii < 4; ++ii) { const size_t off_ = (size_t)(rowtok + 64 * (ii >> 1) + 8 * (ii & 1) + l8) * DM + hcol + 8 * (lane & 7); kf[ii] = *(const v4u*)(P.K + off_); vr[ii] = *(const v4u*)(P.V + off_); } } while (0)
#define N_TILE(kf, vr, t) do { const int rp_ = (t) / 3, cc_ = (t) - 3 * rp_ + qhalf; const int e0 = 16 * cc_ - cs + 4 * hi; \
        const LAS float* bptr = rpbt + (hN * 465 + (r0 + 2 * rp_ - r + 7) * 31 + 16 * cc_ + 15) + (4 * hi - c); \
        attn_tile<3>(st, kf, vr, qf, vbuf, trbase, lane, 0, e0, bptr); } while (0)
    N_LOAD(kA, vA, 0);
    for (int pr = 0; pr < 6; ++pr) {
        N_LOAD(kB, vB, 2 * pr + 1); N_TILE(kA, vA, 2 * pr);
        if (pr < 5) N_LOAD(kA, vA, 2 * pr + 2);
        N_TILE(kB, vB, 2 * pr + 1);
    }
#undef N_LOAD
#undef N_TILE
    attn_store(st, P.O + (size_t)qtok * DM + hcol, hi);
}

__device__ __forceinline__ void phase_attention(const AttnP& P, const float* rpb, LAS unsigned char* lds, int gw, int NGW, int tid, int lane, int wave) {
    LAS float* rpbt = (LAS float*)(lds + RPB_OFF);
    for (int i = tid; i < 8 * 465; i += NWAVES * 64) rpbt[i] = rpb[i] * LOG2E;
    __syncthreads();
    LAS unsigned char* vbuf = lds + wave * (2 * V_TILE_BYTES);
    const int hi = lane >> 5, qp = (lane & 15) >> 2, pp = lane & 3, blk = (lane >> 4) & 1;
    LAS unsigned char* trbase = vbuf + (4 * hi + qp) * V_RS + 32 * blk + 8 * pp;
    constexpr int NUNITS_N = BATCH * 8 * 128 * 2, NUNITS_D = 3 * BATCH * 8 * 256;
    { const int ch = (NUNITS_N + NGW - 1) / NGW; const int u1 = min((gw + 1) * ch, NUNITS_N);
      for (int u = gw * ch; u < u1; ++u) attn_unit_N(P, u, vbuf, trbase, rpbt, lane); }
    { const int ch = (NUNITS_D + NGW - 1) / NGW; const int u1 = min((gw + 1) * ch, NUNITS_D);
      for (int u = gw * ch; u < u1; ++u) attn_unit_D(P, u, vbuf, trbase, lane); }
}

__device__ __forceinline__ void phase_merge(const bf16* OP, const float* LSE, bf16* O, int gtid, int NT_) {
    for (int idx = gtid; idx < T * 64; idx += NT_) {
        const int tok = idx >> 6, h = (idx >> 3) & 7, ch = idx & 7;
        const float l0 = LSE[(size_t)tok * 8 + h], l1 = LSE[((size_t)T + tok) * 8 + h], l2 = LSE[((size_t)2 * T + tok) * 8 + h];
        const float mx = fmaxf(l0, fmaxf(l1, l2));
        float w0 = __builtin_amdgcn_exp2f(l0 - mx), w1 = __builtin_amdgcn_exp2f(l1 - mx), w2 = __builtin_amdgcn_exp2f(l2 - mx);
        const float inv = 1.f / (w0 + w1 + w2); w0 *= inv; w1 *= inv; w2 *= inv;
        const size_t po = (size_t)tok * 512 + 64 * h + 8 * ch;
        const v4u a = *(const v4u*)(OP + po), b = *(const v4u*)(OP + (size_t)T * 512 + po), c = *(const v4u*)(OP + (size_t)2 * T * 512 + po);
        v4u o;
#pragma unroll
        for (int k = 0; k < 4; ++k) {
            const float lo = w0 * bf_lo(a[k]) + w1 * bf_lo(b[k]) + w2 * bf_lo(c[k]);
            const float hi = w0 * bf_hi(a[k]) + w1 * bf_hi(b[k]) + w2 * bf_hi(c[k]);
            o[k] = cvtpk_s(lo, hi);
        }
        *(v4u*)(O + (size_t)tok * DM + 64 * h + 8 * ch) = o;
    }
}

template <int HALF>
__device__ __forceinline__ void pool_item(const bf16* XBp, bf16* U, int b, int s0, int c8) {
    constexpr int R = 16 + 2 * HALF;
    const bf16* xb = XBp + (size_t)b * SEQ * DM + 8 * c8;
    v4u rows[R];
#pragma unroll
    for (int k = 0; k < R; ++k) { const int s = s0 - HALF + k; const int sc = min(max(s, 0), SEQ - 1); rows[k] = *(const v4u*)(xb + (size_t)sc * DM); if (s < 0 || s >= SEQ) rows[k] = (v4u){0u, 0u, 0u, 0u}; }
    float sum[8];
#pragma unroll
    for (int j = 0; j < 8; ++j) sum[j] = 0.f;
#pragma unroll
    for (int k = 0; k < 2 * HALF; ++k)
#pragma unroll
        for (int j = 0; j < 4; ++j) { sum[2 * j] += bf_lo(rows[k][j]); sum[2 * j + 1] += bf_hi(rows[k][j]); }
#pragma unroll
    for (int i = 0; i < 16; ++i) {
        const int s = s0 + i; const int lo = max(s - HALF, 0), hi = min(s + HALF, SEQ);
        const float rc = 1.f / (float)(hi - lo);
        v4u w;
#pragma unroll
        for (int j = 0; j < 4; ++j) w[j] = cvtpk_s(sum[2 * j] * rc - bf_lo(rows[i + HALF][j]), sum[2 * j + 1] * rc - bf_hi(rows[i + HALF][j]));
        *(v4u*)(U + ((size_t)b * SEQ + s) * DM + 8 * c8) = w;
        if (i < 15) {
#pragma unroll
            for (int j = 0; j < 4; ++j) { sum[2 * j] += bf_lo(rows[i + 2 * HALF][j]) - bf_lo(rows[i][j]); sum[2 * j + 1] += bf_hi(rows[i + 2 * HALF][j]) - bf_hi(rows[i][j]); }
        }
    }
}
__device__ __forceinline__ void phase_pool(const bf16* XBp, bf16* U, int gtid, int NT_) {
    for (int idx = gtid; idx < (T / 16) * 128; idx += NT_) {
        const int g = (idx >> 6) & 3, c8 = 32 * g + (idx & 31), tch = ((idx >> 8) << 1) | ((idx >> 5) & 1), b = tch >> 9, s0 = (tch & 511) * 16;
        if (g == 0) pool_item<1>(XBp, U, b, s0, c8); else if (g == 1) pool_item<2>(XBp, U, b, s0, c8); else if (g == 2) pool_item<4>(XBp, U, b, s0, c8); else pool_item<8>(XBp, U, b, s0, c8);
    }
}

__device__ __forceinline__ void load_row_bf16(float (&v)[16], const bf16* row, int lane) {
#pragma unroll
    for (int j = 0; j < 2; ++j) { const v4u r = *((const GAS v4u*)row + lane + 64 * j);
#pragma unroll
        for (int k = 0; k < 4; ++k) { v[8 * j + 2 * k] = bf_lo(r[k]); v[8 * j + 2 * k + 1] = bf_hi(r[k]); } }
}
__device__ __forceinline__ void ln_row(float (&v)[16], const float* g, const float* bta, int lane) {
    float s = 0.f;
#pragma unroll
    for (int k = 0; k < 16; k += 4) s += (v[k] + v[k + 1]) + (v[k + 2] + v[k + 3]);
    const float mean = wave_sum(s) * (1.f / DM); float s2 = 0.f;
#pragma unroll
    for (int k = 0; k < 16; ++k) { v[k] -= mean; s2 += v[k] * v[k]; }
    const float rstd = 1.f / sqrtf(wave_sum(s2) * (1.f / DM) + LN_EPS);
#pragma unroll
    for (int j = 0; j < 2; ++j)
#pragma unroll
        for (int h = 0; h < 2; ++h) { const f32x4 gg = *(const f32x4*)(g + 512 * j + 8 * lane + 4 * h), bb = *(const f32x4*)(bta + 512 * j + 8 * lane + 4 * h);
#pragma unroll
            for (int c = 0; c < 4; ++c) v[8 * j + 4 * h + c] = v[8 * j + 4 * h + c] * rstd * gg[c] + bb[c]; }
}
__device__ __forceinline__ void store_row_bf16(const float (&v)[16], bf16* row, int lane) {
#pragma unroll
    for (int j = 0; j < 2; ++j) { v4u w;
#pragma unroll
        for (int k = 0; k < 4; ++k) w[k] = cvtpk_s(v[8 * j + 2 * k], v[8 * j + 2 * k + 1]);
        *((GAS v4u*)row + lane + 64 * j) = w; }
}
__device__ __forceinline__ void store_row_f32(const float (&v)[16], float* row, int lane) {
#pragma unroll
    for (int j = 0; j < 2; ++j)
#pragma unroll
        for (int h = 0; h < 2; ++h) *((GAS f32x4*)(row + 512 * j + 8 * lane + 4 * h)) = (f32x4){v[8 * j + 4 * h], v[8 * j + 4 * h + 1], v[8 * j + 4 * h + 2], v[8 * j + 4 * h + 3]};
}

__device__ __forceinline__ float reduce16(float (&v)[16], int lane) {
#pragma unroll
    for (int i = 0; i < 8; ++i) { const bool up = lane & 32; const float send = up ? v[i] : v[i + 8], keep = up ? v[i + 8] : v[i]; v[i] = keep + __shfl_xor(send, 32); }
#pragma unroll
    for (int i = 0; i < 4; ++i) { const bool up = lane & 16; const float send = up ? v[i] : v[i + 4], keep = up ? v[i + 4] : v[i]; v[i] = keep + __shfl_xor(send, 16); }
#pragma unroll
    for (int i = 0; i < 2; ++i) { const bool up = lane & 8; const float send = up ? v[i] : v[i + 2], keep = up ? v[i + 2] : v[i]; v[i] = keep + __shfl_xor(send, 8); }
    { const bool up = lane & 4; const float send = up ? v[0] : v[1], keep = up ? v[1] : v[0]; v[0] = keep + __shfl_xor(send, 4); }
    v[0] += __shfl_xor(v[0], 2); v[0] += __shfl_xor(v[0], 1);
    return v[0];
}

struct TokTabs { int* e; float* g; int* rank; int* pos; };

__device__ __forceinline__ void route_token(const float (&lg)[16], const float* rbias, size_t tok, int tl, const TokTabs& TT, LAS int* lcnt, LAS int* tinfo, int lane) {
    float aff[16], sel[16];
#pragma unroll
    for (int e = 0; e < 16; ++e) { aff[e] = 1.f / (1.f + expf(-lg[e])); sel[e] = aff[e] + rbias[e]; }
    float gs[4];
#pragma unroll
    for (int g = 0; g < 4; ++g) { const float a = sel[4 * g], b = sel[4 * g + 1], c = sel[4 * g + 2], d = sel[4 * g + 3];
        const float h1 = fmaxf(a, b), l1 = fminf(a, b), h2 = fmaxf(c, d), l2 = fminf(c, d);
        gs[g] = fmaxf(h1, h2) + fmaxf(fminf(h1, h2), fmaxf(l1, l2)); }
    int grp = 0; float best = gs[0];
#pragma unroll
    for (int g = 1; g < 4; ++g) if (gs[g] > best) { best = gs[g]; grp = g; }
    float sg[4], ag[4];
#pragma unroll
    for (int k = 0; k < 4; ++k) { sg[k] = grp == 0 ? sel[k] : grp == 1 ? sel[4 + k] : grp == 2 ? sel[8 + k] : sel[12 + k]; ag[k] = grp == 0 ? aff[k] : grp == 1 ? aff[4 + k] : grp == 2 ? aff[8 + k] : aff[12 + k]; }
    int i1 = 0; float b1 = sg[0];
#pragma unroll
    for (int k = 1; k < 4; ++k) if (sg[k] > b1) { b1 = sg[k]; i1 = k; }
    int i2 = -1; float b2 = -INFINITY;
#pragma unroll
    for (int k = 0; k < 4; ++k) if (k != i1 && (i2 < 0 || sg[k] > b2)) { b2 = sg[k]; i2 = k; }
    const float a1 = i1 == 0 ? ag[0] : i1 == 1 ? ag[1] : i1 == 2 ? ag[2] : ag[3];
    const float a2 = i2 == 0 ? ag[0] : i2 == 1 ? ag[1] : i2 == 2 ? ag[2] : ag[3];
    const float den = a1 + a2;
    if (lane == 0) {
        const int e1 = grp * 4 + i1, e2 = grp * 4 + i2;
        const int r1 = __hip_atomic_fetch_add(lcnt + e1, 1, __ATOMIC_RELAXED, __HIP_MEMORY_SCOPE_WORKGROUP);
        const int r2 = __hip_atomic_fetch_add(lcnt + e2, 1, __ATOMIC_RELAXED, __HIP_MEMORY_SCOPE_WORKGROUP);
        tinfo[tl * 4 + 0] = e1; tinfo[tl * 4 + 1] = r1; tinfo[tl * 4 + 2] = e2; tinfo[tl * 4 + 3] = r2;
        TT.e[tok * 2] = e1; TT.e[tok * 2 + 1] = e2; TT.g[tok * 2] = a1 / den; TT.g[tok * 2 + 1] = a2 / den;
    }
}

__device__ __forceinline__ void phase_lnr(bf16* XB, const float* g, const float* bta, const float* router_w, const float* rbias_g,
                                          const TokTabs& TT, int* list, gu32* cnt, LAS unsigned char* lds, int tid, int lane, int wave) {
    LAS float* rw = (LAS float*)lds;
    LAS int* lcnt = (LAS int*)(lds + 65536); LAS int* lbase = lcnt + 16; LAS int* tinfo = lcnt + 32;
    for (int idx = tid; idx < DM * 16; idx += NWAVES * 64) { const int col = idx >> 4, e = idx & 15, j = col >> 9, l = (col & 511) >> 3, c = col & 7, k = 8 * j + c;
        rw[(((k * 4 + (e >> 2)) * 64 + l) << 2) + (e & 3)] = router_w[idx]; }
    float rbias[16];
#pragma unroll
    for (int e = 0; e < 16; ++e) rbias[e] = rbias_g[e];
    for (int chunk = blockIdx.x; chunk < T / 128; chunk += gridDim.x) {
        __syncthreads();
        if (tid < 16) lcnt[tid] = 0;
        __syncthreads();
        for (int pass = 0; pass < 8; ++pass) {
            const int tl0 = wave * 16 + 2 * pass; const size_t tok0 = (size_t)chunk * 128 + tl0;
            float va[16], vb[16];
            load_row_bf16(va, XB + tok0 * DM, lane); load_row_bf16(vb, XB + (tok0 + 1) * DM, lane);
            ln_row(va, g, bta, lane); ln_row(vb, g, bta, lane);
            store_row_bf16(va, XB + tok0 * DM, lane); store_row_bf16(vb, XB + (tok0 + 1) * DM, lane);
            float pa[16], pb[16];
#pragma unroll
            for (int e = 0; e < 16; ++e) { pa[e] = 0.f; pb[e] = 0.f; }
#pragma unroll
            for (int k = 0; k < 16; ++k)
#pragma unroll
                for (int e4 = 0; e4 < 4; ++e4) {
                    const f32x4 w = *(const LAS f32x4*)(rw + (((k * 4 + e4) * 64 + lane) << 2));
#pragma unroll
                    for (int ee = 0; ee < 4; ++ee) { pa[4 * e4 + ee] += va[k] * w[ee]; pb[4 * e4 + ee] += vb[k] * w[ee]; }
                }
            const float ra = reduce16(pa, lane), rb = reduce16(pb, lane);
            float lga[16], lgb[16];
#pragma unroll
            for (int e = 0; e < 16; ++e) { lga[e] = __builtin_bit_cast(float, __builtin_amdgcn_readlane(__builtin_bit_cast(int, ra), 4 * e)); lgb[e] = __builtin_bit_cast(float, __builtin_amdgcn_readlane(__builtin_bit_cast(int, rb), 4 * e)); }
            route_token(lga, rbias, tok0, tl0, TT, lcnt, tinfo, lane);
            route_token(lgb, rbias, tok0 + 1, tl0 + 1, TT, lcnt, tinfo, lane);
        }
        __syncthreads();
        if (tid < 16) lbase[tid] = (int)__hip_atomic_fetch_add(cnt + 64 * tid, (unsigned)lcnt[tid], RLX_AGENT);
        __syncthreads();
        if (tid < 256) { const int tl = tid >> 1, k = tid & 1; const int e = tinfo[tl * 4 + 2 * k], lr = tinfo[tl * 4 + 2 * k + 1];
            const int rk = lbase[e] + lr; TT.rank[((size_t)chunk * 128 + tl) * 2 + k] = rk; list[(size_t)e * T + rk] = chunk * 128 + tl; }
    }
    __syncthreads();
}

__device__ __forceinline__ int build_expert_tables(const gu32* cnt, LAS unsigned char* lds, int tid) {
    LAS int* pstart = (LAS int*)(lds + PSTART_OFF); LAS unsigned char* texp = lds + TEXP_OFF; LAS int* ntl = (LAS int*)(lds + NTL_OFF); LAS int* tstart = (LAS int*)(lds + TSTART_OFF); LAS int* ecnt = (LAS int*)(lds + ECNT_OFF);
    __syncthreads();
    if (tid == 0) {
        int acc = 0;
        for (int e = 0; e < NEXP; ++e) { const int c = (int)__hip_atomic_load(cnt + 64 * e, RLX_AGENT); const int nt = (c + 255) >> 8; pstart[e] = acc * 256; tstart[e] = acc; ecnt[e] = c; for (int i = 0; i < nt; ++i) texp[acc + i] = (unsigned char)e; acc += nt; }
        *ntl = acc;
    }
    __syncthreads();
    return *ntl;
}

__device__ __forceinline__ void phase_combine(bf16* XB, float* out, const bf16* YB, const TokTabs& TT, const LAS int* pstart, const float* g, const float* bta, int gw, int NGW, int lane) {
    for (int tok = gw; tok < T; tok += NGW) {
        const int p0 = pstart[TT.e[tok * 2]] + TT.rank[tok * 2], p1 = pstart[TT.e[tok * 2 + 1]] + TT.rank[tok * 2 + 1]; const float g0 = TT.g[tok * 2], g1 = TT.g[tok * 2 + 1];
        float v[16], y0[16], y1[16];
        load_row_bf16(v, XB + (size_t)tok * DM, lane); load_row_bf16(y0, YB + (size_t)p0 * DM, lane); load_row_bf16(y1, YB + (size_t)p1 * DM, lane);
#pragma unroll
        for (int k = 0; k < 16; ++k) v[k] = v[k] * ALPHA + g0 * y0[k] + g1 * y1[k];
        ln_row(v, g, bta, lane);
        if (out) store_row_f32(v, out + (size_t)tok * DM, lane); else store_row_bf16(v, XB + (size_t)tok * DM, lane);
    }
}

#ifndef DUPMASK
#define DUPMASK 0
#endif
struct Args { InPtrs in; float* out; unsigned char* ws; int layer, pad; };

template <int SLOT>
__device__ __forceinline__ void do_slot(const Args& args, int layer, LAS unsigned char* lds) {
    int tidL = threadIdx.x; asm volatile("" : "+v"(tidL));
    const int tid = tidL, lane = tidL & 63, wave = __builtin_amdgcn_readfirstlane(tidL >> 6);
    const int G = gridDim.x, gw = blockIdx.x * NWAVES + wave, NGW = G * NWAVES, gtid = blockIdx.x * (NWAVES * 64) + tidL, NTH = G * NWAVES * 64;
    size_t zoff = 0; asm volatile("" : "+s"(zoff));
    unsigned char* ws = args.ws + zoff;
    float* X = args.out + zoff;
    const int i2 = layer >> 1;
    TokTabs TT; TT.e = (int*)(ws + WS_TOK); TT.g = (float*)(ws + WS_TOK + 262144); TT.rank = (int*)(ws + WS_TOK + 2 * 262144); TT.pos = (int*)(ws + WS_TOK + 3 * 262144);
    gu32* cnt = (gu32*)(ws + WS_CTL) + CW_CNT + layer * 16 * 64;
    bf16* XB = (bf16*)(ws + WS_XB);
    bf16* Qb = (bf16*)(ws + WS_Q); bf16* Kb = (bf16*)(ws + WS_K); bf16* Vb = (bf16*)(ws + WS_V); bf16* Ob = (bf16*)(ws + WS_O);
    bf16* OP = (bf16*)(ws + WS_OP); float* LSE = (float*)(ws + WS_LSE);
    bf16* Ub = (bf16*)(ws + WS_U); bf16* XS = (bf16*)(ws + WS_XS); bf16* Hb = (bf16*)(ws + WS_H);
    const float* cosT = (const float*)(ws + WS_ROPE); const float* sinT = cosT + SEQ * 32;
    const float* SMp = (const float*)(ws + WS_SMALL);
    LAS int* pstart = (LAS int*)(lds + PSTART_OFF); LAS unsigned char* texp = lds + TEXP_OFF;
    (void)tid; (void)lane; (void)gw; (void)NGW; (void)gtid; (void)NTH; (void)i2; (void)TT; (void)cnt; (void)XB; (void)Qb; (void)Kb; (void)Vb; (void)Ob; (void)OP; (void)LSE; (void)Ub; (void)XS; (void)Hb;
    (void)cosT; (void)sinT; (void)SMp; (void)pstart; (void)texp; (void)X;

    if constexpr (SLOT == 0) { phase_prologue(args.in, ws, lds, gw, NGW, lane, wave, gtid, NTH); }
    if constexpr (SLOT == 1) {
        Sched S{T / 256, 12, (T / 256) * 12, G, (int)blockIdx.x, (const char*)XB, (const char*)(ws + WS_WQKV) + (size_t)i2 * 3072 * DM * 2, (size_t)256 * DM * 2, 0, (size_t)256 * DM * 2, 0, nullptr, nullptr, nullptr, nullptr};
        EpiQKV E{Qb, (size_t)(WS_K - WS_Q) / 2, cosT, sinT};
        pg8::gemm_phase<EpiQKV, Sched, true>(lds, pg8::Gemm{DM, DM, DM}, S, E);
    }
    if constexpr (SLOT == 2) {
        AttnP P{Qb, Kb, Vb, Ob, OP, LSE};
        phase_attention(P, SMp + SM_RPB + (size_t)i2 * 8 * 465, lds, gw, NGW, tid, lane, wave);
    }
    if constexpr (SLOT == 3) { phase_merge(OP, LSE, Ob, gtid, NTH); }
    if constexpr (SLOT == 4) {
        Sched S{T / 256, 4, (T / 256) * 4, G, (int)blockIdx.x, (const char*)Ob, (const char*)(ws + WS_WO) + (size_t)i2 * DM * DM * 2, (size_t)256 * DM * 2, 0, (size_t)256 * DM * 2, 0, nullptr, nullptr, nullptr, nullptr};
        EpiRes E{XB, nullptr};
        pg8::gemm_phase<EpiRes, Sched, true>(lds, pg8::Gemm{DM, DM, DM}, S, E);
    }
    if constexpr (SLOT == 5) { phase_pool(XB, Ub, gtid, NTH); }
    if constexpr (SLOT == 6) {
        Sched S{T / 256, 4, (T / 256) * 4, G, (int)blockIdx.x, (const char*)Ub, (const char*)(ws + WS_WP) + (size_t)i2 * 4 * 65536 * 2, (size_t)256 * DM * 2, (size_t)512, (size_t)65536 * 2, 0, nullptr, nullptr, nullptr, nullptr};
        EpiRes E{XB, SMp + SM_PSC + (size_t)i2 * DM};
        pg8::gemm_phase<EpiRes, Sched, true>(lds, pg8::Gemm{DM, 256, 256}, S, E);
    }
    if constexpr (SLOT == 7) {
        phase_lnr(XB, SMp + SM_LNG + (size_t)(layer * 2) * DM, SMp + SM_LNB + (size_t)(layer * 2) * DM, SMp + SM_RW, SMp + SM_RB, TT, (int*)(ws + WS_LIST), cnt, lds, tid, lane, wave);
    }
    if constexpr (SLOT == 9) {
        const int ntiles = build_expert_tables(cnt, lds, tid);
        Sched S{ntiles, 8, ntiles * 8, G, (int)blockIdx.x, (const char*)XB, (const char*)(ws + WS_W13) + (size_t)layer * NEXP * 2048 * DM * 2, 0, 0, (size_t)256 * DM * 2, (size_t)2048 * DM * 2, texp,
                (const LAS int*)(lds + TSTART_OFF), (const LAS int*)(lds + ECNT_OFF), (const int*)(ws + WS_LIST)};
        EpiSwiGLU E{Hb};
        pg8::gemm_phase<EpiSwiGLU, Sched, true, true>(lds, pg8::Gemm{DM, DM, DM}, S, E);
    }
    if constexpr (SLOT == 10) {
        const int ntiles = build_expert_tables(cnt, lds, tid);
        Sched S{ntiles, 4, ntiles * 4, G, (int)blockIdx.x, (const char*)Hb, (const char*)(ws + WS_W2) + (size_t)layer * NEXP * DM * DM * 2, (size_t)256 * DM * 2, 0, (size_t)256 * DM * 2, (size_t)DM * DM * 2, texp, nullptr, nullptr, nullptr};
        EpiBf16 E{XS};
        pg8::gemm_phase<EpiBf16, Sched, true>(lds, pg8::Gemm{DM, DM, DM}, S, E);
    }
    if constexpr (SLOT == 11) {
        (void)build_expert_tables(cnt, lds, tid);
        phase_combine(XB, layer == DEPTH - 1 ? X : nullptr, XS, TT, pstart, SMp + SM_LNG + (size_t)(layer * 2 + 1) * DM, SMp + SM_LNB + (size_t)(layer * 2 + 1) * DM, gw, NGW, lane);
    }
}

#if MK_MULTI_LAUNCH
template <int SLOT>
__global__ void __launch_bounds__(NWAVES * 64, 2) k_slot(Args args) {
    extern __shared__ __attribute__((aligned(16))) unsigned char lds_raw[];
    LAS unsigned char* lds = (LAS unsigned char*)lds_raw;
    for (int u = threadIdx.x; u < (LDS_BYTES - RING_BYTES) / 4; u += NWAVES * 64) ((LAS unsigned*)(lds + RING_BYTES))[u] = 0u;
    __syncthreads();
    do_slot<SLOT>(args, args.layer, lds);
}
template <int SLOT> static void launch_slot(const Args& a, int grid, hipStream_t stream) {
    static bool attr_set = false;
    if (!attr_set) { (void)hipFuncSetAttribute((const void*)k_slot<SLOT>, hipFuncAttributeMaxDynamicSharedMemorySize, LDS_BYTES); attr_set = true; }
    hipLaunchKernelGGL(k_slot<SLOT>, dim3(grid), dim3(NWAVES * 64), LDS_BYTES, stream, a);
}
#else
__global__ void __launch_bounds__(NWAVES * 64, 2) fwd(Args args) {
    extern __shared__ __attribute__((aligned(16))) unsigned char lds_raw[];
    LAS unsigned char* lds = (LAS unsigned char*)lds_raw;
    volatile LAS unsigned* MISC = (volatile LAS unsigned*)(lds + MISC_OFF);
    for (int u = threadIdx.x; u < (LDS_BYTES - RING_BYTES) / 4; u += NWAVES * 64) ((LAS unsigned*)(lds + RING_BYTES))[u] = 0u;
    __syncthreads();
    const XcdBarrier bar = xcd_barrier_post((unsigned*)((gu32*)(args.ws + WS_CTL) + CW_BAR), MISC + 8);
    do_slot<0>(args, 0, lds);
    if constexpr (DUPMASK & 1) { xcd_barrier(bar); do_slot<0>(args, 0, lds); }
#define RUN(S, L) xcd_barrier(bar); do_slot<S>(args, L, lds); if constexpr ((DUPMASK >> S) & 1) { xcd_barrier(bar); do_slot<S>(args, L, lds); }
#define MOE_SLOTS(L) RUN(7, L) RUN(9, L) RUN(10, L) RUN(11, L)
#define LAYER_ATT(L) RUN(1, L) RUN(2, L) RUN(3, L) RUN(4, L) MOE_SLOTS(L)
#define LAYER_POOL(L) RUN(5, L) RUN(6, L) MOE_SLOTS(L)
    LAYER_ATT(0) LAYER_POOL(1) LAYER_ATT(2) LAYER_POOL(3)
#undef RUN
#undef MOE_SLOTS
#undef LAYER_ATT
#undef LAYER_POOL
}
#endif

extern "C" void kernel_launch(void* const* d_in, const int* in_sizes, int n_in, void* d_out, int out_size, void* d_ws, size_t ws_size, hipStream_t stream) {
    static int grid = 0;
    if (grid == 0) {
        if (n_in != 13 || in_sizes[0] != T * DM || out_size != T * DM || ws_size < WS_END) {
            fprintf(stderr, "kernel_launch: unexpected shapes (n_in %d, in0 %d, out %d, ws %zu; need ws >= %zu); nothing launched\n", n_in, n_in > 0 ? in_sizes[0] : -1, out_size, ws_size, (size_t)WS_END); grid = -1; return; }
        int dev = 0, cus = 0;
        if (hipGetDevice(&dev) != hipSuccess || hipDeviceGetAttribute(&cus, hipDeviceAttributeMultiprocessorCount, dev) != hipSuccess) { fprintf(stderr, "kernel_launch: device query failed\n"); grid = -1; return; }
#if !MK_MULTI_LAUNCH
        int per_cu = 0;
        if (hipFuncSetAttribute((const void*)fwd, hipFuncAttributeMaxDynamicSharedMemorySize, LDS_BYTES) != hipSuccess) { fprintf(stderr, "kernel_launch: hipFuncSetAttribute failed\n"); grid = -1; return; }
        if (hipOccupancyMaxActiveBlocksPerMultiprocessor(&per_cu, (const void*)fwd, NWAVES * 64, LDS_BYTES) != hipSuccess || per_cu < 1)
            fprintf(stderr, "kernel_launch: note: occupancy query reports %d workgroups per CU\n", per_cu);
        (void)hipGetLastError();
#endif
        grid = cus;
    }
    if (grid < 0) return;
    if (hipMemsetAsync((char*)d_ws + WS_CTL, 0, CTL_ZERO_BYTES, stream) != hipSuccess) { fprintf(stderr, "kernel_launch: memset failed\n"); return; }
    Args a{};
    const float** ip = (const float**)&a.in;
    for (int i = 0; i < 13; ++i) ip[i] = (const float*)d_in[i];
    a.out = (float*)d_out; a.ws = (unsigned char*)d_ws; a.layer = 0; a.pad = 0;
#if MK_MULTI_LAUNCH
    launch_slot<0>(a, grid, stream);
    for (int layer = 0; layer < DEPTH; ++layer) {
        a.layer = layer;
        if ((layer & 1) == 0) { launch_slot<1>(a, grid, stream); launch_slot<2>(a, grid, stream); launch_slot<3>(a, grid, stream); launch_slot<4>(a, grid, stream); }
        else { launch_slot<5>(a, grid, stream); launch_slot<6>(a, grid, stream); }
        launch_slot<7>(a, grid, stream); launch_slot<9>(a, grid, stream); launch_slot<10>(a, grid, stream); launch_slot<11>(a, grid, stream);
    }
#else
    hipLaunchKernelGGL(fwd, dim3(grid), dim3(NWAVES * 64), LDS_BYTES, stream, a);
#endif
    const hipError_t le = hipPeekAtLastError();
    if (le != hipSuccess) fprintf(stderr, "kernel_launch: launch failed: %s\n", hipGetErrorName(le));
}
```

```cpp
#include <hip/hip_runtime.h>
#include <cstdio>
#include <cstdint>
#include <cmath>

#ifndef MK_MULTI_LAUNCH
#define MK_MULTI_LAUNCH 0
#endif

namespace pg8 {
#define PG8_LAS __attribute__((address_space(3)))
typedef unsigned short bf16_t;
typedef short bf16x8 __attribute__((ext_vector_type(8)));
typedef float f32x4 __attribute__((ext_vector_type(4)));
typedef unsigned u32x4 __attribute__((ext_vector_type(4)));
constexpr int BM = 256, BK = 64, HALF = 128, HTB = HALF * BK * 2  , STAGE_BYTES = 8 * HTB, NXCD = 8, WGM = 8;

__host__ __device__ __forceinline__ int lds_byte(int r, int c) { const int st = (r >> 4) * 2 + (c >> 5), rr = r & 15, cc = c & 31, ob = rr * 64 + cc * 2; return st * 1024 + (ob ^ (((ob >> 9) & 1) << 5)); }
__host__ __device__ __forceinline__ void stage_rc(int b, int& R, int& C) { const int st = b / 1024, sb = b % 1024, swz = sb ^ (((sb >> 9) & 1) << 5); R = (st >> 1) * 16 + swz / 64; C = (st & 1) * 32 + (swz % 64) / 2; }
__host__ __device__ __forceinline__ int perm32(int rho) { const int n = rho >> 4, i = rho & 15; return 8 * (i >> 2) + 4 * n + (i & 3); }

struct Unit { int pm, pn; };
struct Gemm { int lda, ldb, K; };

typedef _Float16 h16x8 __attribute__((ext_vector_type(8))); typedef _Float16 h16x2 __attribute__((ext_vector_type(2))); typedef float f32x2 __attribute__((ext_vector_type(2)));
__device__ __forceinline__ unsigned cvt_pk16(float lo, float hi) { const f32x2 v = {lo, hi}; const h16x2 b = __builtin_convertvector(v, h16x2); return __builtin_bit_cast(unsigned, b); }

constexpr int GATHER_TAB_OFF = 131072 + 2048;
template <class Epi, class Sched, bool ALIGN_EPI, bool GATHER = false>
__device__ __forceinline__ void gemm_phase(PG8_LAS unsigned char* lds, const Gemm g, const Sched& S, const Epi& E) {
    int tid_ = threadIdx.x; asm volatile("" : "+v"(tid_));
    const int tid = tid_, wid = __builtin_amdgcn_readfirstlane(tid >> 6), lane = tid & 63, wr = wid >> 2, wc = wid & 3, fr = lane & 15, fq = lane >> 4;
    const int K = g.K, nt = K / BK;
    unsigned voffA[2], voffB[2];
#pragma unroll
    for (int i = 0; i < 2; ++i) { int R, C; stage_rc(tid * 16 + i * 8192, R, C); const int Rb = 64 * (R >> 5) + perm32(R & 31);
        voffA[i] = (unsigned)(R * g.lda + C) * 2u; voffB[i] = (unsigned)(Rb * g.ldb + C) * 2u; }
    const size_t kstep = (size_t)(BK * 2);
    const size_t hstepA = (size_t)HALF * g.lda * 2;
    const size_t hstepB = (size_t)32 * g.ldb * 2;
    const unsigned ldsw = (unsigned)wid * 1024u;
    const int aoff = lds_byte(wr * 64 + fr, fq * 8), boff = lds_byte(wc * 32 + fr, fq * 8);
#define PG8_SA(b, h) (((b) * 2 + (h)) * HTB)
#define PG8_SB(b, h) ((4 + (b) * 2 + (h)) * HTB)
#define PG8_STAGE(bufoff, gbase, voff) do { _Pragma("unroll") for (int _i = 0; _i < 2; ++_i) \
        __builtin_amdgcn_global_load_lds((const unsigned*)((const char*)(gbase) + (voff)[_i]), (PG8_LAS unsigned*)(lds + (bufoff) + ldsw + _i * 8192), 16, 0, 0); } while (0)
#define PG8_STAGE_A(bufoff, gbase, h, usenext) do { if constexpr (GATHER) { unsigned _v[2]; _v[0] = (usenext) ? nvA[h][0] : cvA[h][0]; _v[1] = (usenext) ? nvA[h][1] : cvA[h][1]; PG8_STAGE(bufoff, gbase, _v); } \
        else { PG8_STAGE(bufoff, (gbase) + (h) * hstepA, voffA); } } while (0)
#define PG8_LDA(dst, b, h) do { _Pragma("unroll") for (int m = 0; m < 4; ++m) _Pragma("unroll") for (int k = 0; k < 2; ++k) dst[m][k] = *(const PG8_LAS bf16x8*)(lds + PG8_SA(b, h) + aoff + m * 2048 + k * 1024); } while (0)
#define PG8_LDB(dst, b, h) do { _Pragma("unroll") for (int n = 0; n < 2; ++n) _Pragma("unroll") for (int k = 0; k < 2; ++k) dst[n][k] = *(const PG8_LAS bf16x8*)(lds + PG8_SB(b, h) + boff + n * 2048 + k * 1024); } while (0)
#define PG8_MMA(ai, bj, At, Bt) do { __builtin_amdgcn_s_setprio(1); _Pragma("unroll") for (int m = 0; m < 4; ++m) _Pragma("unroll") for (int n = 0; n < 2; ++n) _Pragma("unroll") for (int k = 0; k < 2; ++k) \
        acc[ai][bj][m][n] = __builtin_amdgcn_mfma_f32_16x16x32_f16(__builtin_bit_cast(h16x8, Bt[n][k]), __builtin_bit_cast(h16x8, At[m][k]), acc[ai][bj][m][n], 0, 0, 0); __builtin_amdgcn_s_setprio(0); } while (0)
#define PG8_WAIT_V(n) asm volatile("s_waitcnt vmcnt(" #n ")" ::: "memory")
#define PG8_WAIT_L(n) asm volatile("s_waitcnt lgkmcnt(" #n ")" ::: "memory")
#define PG8_BAR __builtin_amdgcn_s_barrier()
#define PG8_SCHED __builtin_amdgcn_sched_barrier(0)
    Unit cur, nxt; int ui = 0;
    const char* cA; const char* cB; const char* nA; const char* nB;
    if (!S.next(0, cur.pm, cur.pn, cA, cB)) return;
    f32x4 acc[2][2][4][2];
#pragma unroll
    for (int a = 0; a < 2; ++a)
#pragma unroll
        for (int b = 0; b < 2; ++b)
#pragma unroll
            for (int m = 0; m < 4; ++m)
#pragma unroll
                for (int n = 0; n < 2; ++n) acc[a][b][m][n] = (f32x4){0.f, 0.f, 0.f, 0.f};
    bf16x8 At[4][2], B0[2][2], B1[2][2];
    unsigned cvA[2][2] = {{0u, 0u}, {0u, 0u}}, nvA[2][2] = {{0u, 0u}, {0u, 0u}}; int Rl[2], Cl[2], nnv = 0;
#pragma unroll
    for (int i = 0; i < 2; ++i) stage_rc(tid * 16 + i * 8192, Rl[i], Cl[i]);
    if constexpr (GATHER) {
        const int* lp; int nv; S.rows(cur.pm, lp, nv);
        if (wid == 0) __builtin_amdgcn_global_load_lds((const unsigned*)(lp + 4 * lane), (PG8_LAS unsigned*)(lds + GATHER_TAB_OFF), 16, 0, 0);
        PG8_WAIT_V(0); PG8_BAR;
        const PG8_LAS int* tab = (const PG8_LAS int*)(lds + GATHER_TAB_OFF);
#pragma unroll
        for (int h = 0; h < 2; ++h)
#pragma unroll
            for (int i = 0; i < 2; ++i) { const int r = 128 * h + Rl[i]; const int tok = r < nv ? tab[r] : 0; cvA[h][i] = (unsigned)(tok * g.lda + Cl[i]) * 2u; }
    }
    PG8_STAGE(PG8_SB(0, 0), cB, voffB); PG8_STAGE(PG8_SB(0, 1), cB + hstepB, voffB); PG8_STAGE_A(PG8_SA(0, 0), cA, 0, false); PG8_STAGE_A(PG8_SA(0, 1), cA, 1, false);
    if (wr == 1) PG8_BAR;
    PG8_WAIT_V(2); PG8_BAR;
    PG8_STAGE(PG8_SB(1, 0), cB + kstep, voffB); PG8_STAGE_A(PG8_SA(1, 0), cA + kstep, 0, false); PG8_STAGE(PG8_SB(1, 1), cB + hstepB + kstep, voffB);
    PG8_WAIT_V(6); PG8_BAR;
    for (;;) {
        const bool has_next = S.next(ui + 1, nxt.pm, nxt.pn, nA, nB);
        if (!has_next) { nA = cA; nB = cB; }
        if constexpr (GATHER) { if (has_next) { const int* lp; S.rows(nxt.pm, lp, nnv);
            if (wid == 0) __builtin_amdgcn_global_load_lds((const unsigned*)(lp + 4 * lane), (PG8_LAS unsigned*)(lds + GATHER_TAB_OFF + 1024 * ((ui + 1) & 1)), 16, 0, 0); } }
        for (int t = 0; t < nt; t += 2) {
            const bool last = (t == nt - 2);
            if constexpr (GATHER) { if (last) {
                if (has_next) { const PG8_LAS int* tab = (const PG8_LAS int*)(lds + GATHER_TAB_OFF + 1024 * ((ui + 1) & 1));
#pragma unroll
                    for (int h = 0; h < 2; ++h)
#pragma unroll
                        for (int i = 0; i < 2; ++i) { const int r = 128 * h + Rl[i]; const int tok = r < nnv ? tab[r] : 0; nvA[h][i] = (unsigned)(tok * g.lda + Cl[i]) * 2u; } }
                else {
#pragma unroll
                    for (int h = 0; h < 2; ++h)
#pragma unroll
                        for (int i = 0; i < 2; ++i) nvA[h][i] = cvA[h][i]; } } }
            const char* a1 = cA + (size_t)(t + 1) * kstep;
            const char* a2 = last ? nA : cA + (size_t)(t + 2) * kstep; const char* b2 = last ? nB : cB + (size_t)(t + 2) * kstep;
            const char* a3 = a2 + kstep; const char* b3 = b2 + kstep;
            PG8_LDB(B0, 0, 0); PG8_LDB(B1, 0, 1); PG8_SCHED; PG8_LDA(At, 0, 0); PG8_STAGE_A(PG8_SA(1, 1), a1, 1, false);
            PG8_WAIT_V(8); PG8_WAIT_L(0); PG8_BAR; PG8_MMA(0, 0, At, B0); PG8_MMA(0, 1, At, B1); PG8_BAR; PG8_SCHED;
            PG8_LDA(At, 0, 1); PG8_STAGE(PG8_SB(0, 0), b2, voffB); PG8_STAGE(PG8_SB(0, 1), b2 + hstepB, voffB); PG8_STAGE_A(PG8_SA(0, 0), a2, 0, last);
            PG8_WAIT_V(8); PG8_WAIT_L(0); PG8_BAR; PG8_MMA(1, 0, At, B0); PG8_MMA(1, 1, At, B1); PG8_BAR; PG8_SCHED;
            PG8_LDB(B0, 1, 0); PG8_LDB(B1, 1, 1); PG8_SCHED; PG8_LDA(At, 1, 0); PG8_STAGE_A(PG8_SA(0, 1), a2, 1, last);
            PG8_WAIT_V(8); PG8_WAIT_L(0); PG8_BAR; PG8_MMA(0, 0, At, B0); PG8_MMA(0, 1, At, B1); PG8_BAR; PG8_SCHED;
            PG8_LDA(At, 1, 1); PG8_STAGE(PG8_SB(1, 0), b3, voffB); PG8_STAGE(PG8_SB(1, 1), b3 + hstepB, voffB); PG8_STAGE_A(PG8_SA(1, 0), a3, 0, last);
            PG8_WAIT_V(8); PG8_WAIT_L(0); PG8_BAR; PG8_MMA(1, 0, At, B0); PG8_MMA(1, 1, At, B1); PG8_BAR; PG8_SCHED;
        }
        if constexpr (ALIGN_EPI) { if (wr == 0) PG8_BAR; }
        E(acc, cur, wr, wc, fr, fq);
        if (!has_next) break;
#pragma unroll
        for (int a = 0; a < 2; ++a)
#pragma unroll
            for (int b = 0; b < 2; ++b)
#pragma unroll
                for (int m = 0; m < 4; ++m)
#pragma unroll
                    for (int n = 0; n < 2; ++n) acc[a][b][m][n] = (f32x4){0.f, 0.f, 0.f, 0.f};
        cur.pm = nxt.pm; cur.pn = nxt.pn; cA = nA; cB = nB; ++ui;
        if constexpr (GATHER) {
#pragma unroll
            for (int h = 0; h < 2; ++h)
#pragma unroll
                for (int i = 0; i < 2; ++i) cvA[h][i] = nvA[h][i]; }
        if constexpr (ALIGN_EPI) { if (wr == 1) PG8_BAR; }
    }
    PG8_WAIT_V(0);
    if constexpr (!ALIGN_EPI) { if (wr == 0) PG8_BAR; }
    PG8_BAR;
#undef PG8_SA
#undef PG8_SB
#undef PG8_STAGE
#undef PG8_STAGE_A
#undef PG8_LDA
#undef PG8_LDB
#undef PG8_MMA
#undef PG8_WAIT_V
#undef PG8_WAIT_L
#undef PG8_BAR
#undef PG8_SCHED
}
}

constexpr int NWAVES = 8;
constexpr int BATCH = 4, SEQ = 8192, DM = 1024, T = BATCH * SEQ, DEPTH = 4;
constexpr int NEXP = 16;
constexpr int PROWS = 2 * T + NEXP * 256;
constexpr float LN_EPS = 1e-5f;
constexpr float ALPHA = 1.681792830507429f;
constexpr float QSCALE = 0.125f * 1.4426950408889634f;
constexpr float LOG2E = 1.4426950408889634f;

constexpr size_t MiB = 1u << 20;
constexpr size_t WS_CTL = 0, CTL_ZERO_BYTES = 1 * MiB;
constexpr size_t WS_ROPE = 1 * MiB;
constexpr size_t WS_WQKV = 3 * MiB;
constexpr size_t WS_WO = 15 * MiB;
constexpr size_t WS_WP = 19 * MiB;
constexpr size_t WS_W13 = 20 * MiB;
constexpr size_t WS_W2 = 276 * MiB;
constexpr size_t WS_XB = 404 * MiB;
constexpr size_t WS_Y = 468 * MiB;
constexpr size_t WS_OP = WS_Y, WS_LSE = WS_Y + 96 * MiB;
constexpr size_t WS_R = 596 * MiB;
constexpr size_t WS_Q = WS_R, WS_K = WS_R + 64 * MiB, WS_V = WS_R + 128 * MiB, WS_O = WS_R + 192 * MiB;
constexpr size_t WS_U = WS_R;
constexpr size_t WS_XS = WS_R, WS_H = WS_R + 136 * MiB;
constexpr size_t WS_TOK = 868 * MiB;
constexpr size_t WS_SMALL = 869 * MiB;
constexpr int SM_RPB = 0, SM_PSC = 7440, SM_RW = 9488, SM_RB = 25872, SM_LNG = 25888, SM_LNB = 34080, SM_END = 42272;
constexpr size_t WS_LIST = 870 * MiB;
constexpr size_t WS_END = 872 * MiB;
static_assert((size_t)PROWS * DM * 2 <= 136 * MiB && WS_H + 136 * MiB <= WS_TOK, "d_ws map");

constexpr int CW_BAR = 4096;
constexpr int CW_CNT = 16384;

constexpr int RING_BYTES = 131072;
constexpr int MISC_OFF = RING_BYTES + 320;
constexpr int LDS_BYTES = 147456;
constexpr int TEXP_OFF = RING_BYTES + 1024;
constexpr int PSTART_OFF = RING_BYTES + 1536, NTL_OFF = RING_BYTES + 1600;
constexpr int TSTART_OFF = RING_BYTES + 1664, ECNT_OFF = RING_BYTES + 1728;

#define GAS __attribute__((address_space(1)))
#define LAS __attribute__((address_space(3)))
typedef unsigned short bf16;
typedef unsigned v4u __attribute__((ext_vector_type(4)));
typedef unsigned v2u __attribute__((ext_vector_type(2)));
typedef float f32x4 __attribute__((ext_vector_type(4)));
typedef float f32x16 __attribute__((ext_vector_type(16)));
typedef short bf16x8 __attribute__((ext_vector_type(8)));
typedef short s16x4 __attribute__((ext_vector_type(4)));
typedef GAS unsigned gu32;
#define RLX_AGENT __ATOMIC_RELAXED, __HIP_MEMORY_SCOPE_AGENT
#define LDS_WAIT() asm volatile("s_waitcnt lgkmcnt(0)" ::: "memory")
__device__ __forceinline__ unsigned pk2(float lo, float hi) { return pg8::cvt_pk16(lo, hi); }
__device__ __forceinline__ float bf_lo(unsigned u) { return (float)__builtin_bit_cast(pg8::h16x2, u)[0]; }
__device__ __forceinline__ float bf_hi(unsigned u) { return (float)__builtin_bit_cast(pg8::h16x2, u)[1]; }

#define XB_TMO      128
#define XB_XCNT(j)  (256  + 64 * (j))
#define XB_XSUB(j)  (1280 + 64 * (j))
#define XB_XGEN(j)  (2304 + 64 * (j))
#define XB_TOP      3328
#define XB_TOPGEN   3392
#define XCD_BAR_WORDS 3456
#define XB_SPIN_CAP (1u << 18)

__device__ __forceinline__ unsigned xb_ld(unsigned* p)              { return __hip_atomic_load(p, __ATOMIC_RELAXED, __HIP_MEMORY_SCOPE_AGENT); }
__device__ __forceinline__ unsigned xb_add(unsigned* p, unsigned v) { return __hip_atomic_fetch_add(p, v, __ATOMIC_RELAXED, __HIP_MEMORY_SCOPE_AGENT); }
__device__ __forceinline__ unsigned xb_xcc_id() { return (unsigned)__builtin_amdgcn_s_getreg((3 << 11) | 20) & 0xFu; }
#define XB_SPIN(cond, bar) do { unsigned _sp = 0; while (cond) { __builtin_amdgcn_s_sleep(1); \
    if ((++_sp & 255u) == 0u) { if (xb_ld(&(bar)[XB_TMO])) break; if (_sp > XB_SPIN_CAP) { atomicAdd(&(bar)[XB_TMO], 1u); break; } } } } while (0)

struct XcdBarrier { unsigned* bar; unsigned x; volatile LAS unsigned* st; };

__device__ __forceinline__ XcdBarrier xcd_barrier_post(unsigned* bar, volatile LAS unsigned* st) {
    XcdBarrier b; b.bar = bar; b.x = xb_xcc_id(); b.st = st;
    if (threadIdx.x == 0) (void)xb_add(&bar[XB_XCNT(b.x)], 1u);
    return b;
}
__device__ __forceinline__ void xcd_barrier_complete(unsigned* bar, unsigned x, unsigned& nloc, unsigned& nx) {
    const unsigned G = gridDim.x * gridDim.y * gridDim.z;
    unsigned sum, cnt, mine, sp = 0u;
    for (;;) {
        sum = 0u; cnt = 0u; mine = 0u;
#pragma unroll
        for (unsigned j = 0; j < 16; ++j) { const unsigned c = xb_ld(&bar[XB_XCNT(j)]); sum += c; cnt += (c > 0u) ? 1u : 0u; mine = (j == x) ? c : mine; }
        if (sum == G) break;
        __builtin_amdgcn_s_sleep(1);
        if ((++sp & 255u) == 0u) { if (xb_ld(&bar[XB_TMO])) break; if (sp > XB_SPIN_CAP) { atomicAdd(&bar[XB_TMO], 1u); break; } }
    }
    nloc = mine > 0u ? mine : 1u; nx = cnt > 0u ? cnt : 1u;
}
__device__ __forceinline__ void xcd_barrier(const XcdBarrier& b) {
    asm volatile("s_waitcnt vmcnt(0)" ::: "memory");
    __syncthreads();
    int tid_ = threadIdx.x; asm volatile("" : "+v"(tid_));
    if (tid_ == 0) {
        size_t zb = 0; asm volatile("" : "+s"(zb)); unsigned* bar = b.bar + zb;
        __builtin_amdgcn_s_waitcnt(0);
        unsigned nloc = b.st[0], nx = b.st[1];
        if (nloc == 0u) { xcd_barrier_complete(bar, b.x, nloc, nx); b.st[0] = nloc; b.st[1] = nx; }
        const unsigned old = xb_add(&bar[XB_XSUB(b.x)], 1u);
        const unsigned gen = old / nloc;
        if (old + 1u == (gen + 1u) * nloc) {
            __builtin_amdgcn_fence(__ATOMIC_RELEASE, "agent");
            asm volatile("s_waitcnt vmcnt(0)" ::: "memory");
            const unsigned og = xb_add(&bar[XB_TOP], 1u);
            const unsigned tg = og / nx;
            if (og + 1u == (tg + 1u) * nx) xb_add(&bar[XB_TOPGEN], 1u);
            else XB_SPIN(xb_ld(&bar[XB_TOPGEN]) == tg, bar);
            __builtin_amdgcn_fence(__ATOMIC_ACQUIRE, "agent");
            xb_add(&bar[XB_XGEN(b.x)], 1u);
            asm volatile("s_waitcnt vmcnt(0)" ::: "memory");
        } else {
            XB_SPIN(xb_ld(&bar[XB_XGEN(b.x)]) == gen, bar);
            __builtin_amdgcn_fence(__ATOMIC_ACQUIRE, "agent");
            asm volatile("s_waitcnt vmcnt(0)" ::: "memory");
        }
    }
    __syncthreads();
}

struct Sched {
    int nM, nN, nwg, G, c;
    const char* A; const char* B; size_t a_tile, a_pn, b_tile, e_bytes; const LAS unsigned char* texp;
    const LAS int* tstart; const LAS int* ecnt; const int* list;
    __device__ __forceinline__ void rows(int pm, const int*& lp, int& nv) const {
        const int e = __builtin_amdgcn_readfirstlane((int)texp[pm]); const int mt = pm - __builtin_amdgcn_readfirstlane(tstart[e]);
        lp = list + (size_t)e * T + 256 * mt; nv = min(256, max(0, __builtin_amdgcn_readfirstlane(ecnt[e]) - 256 * mt)); }
    __device__ __forceinline__ bool next(int i, int& pm, int& pn, const char*& pa, const char*& pb) const {
        const long L = (long)i * G + c; if (L >= nwg) return false;
        int wgid = (int)L; { const int q = nwg / pg8::NXCD, r = nwg % pg8::NXCD, xcd = wgid % pg8::NXCD, off = wgid / pg8::NXCD; wgid = (xcd < r ? xcd * (q + 1) : r * (q + 1) + (xcd - r) * q) + off; }
        const int nig = pg8::WGM * nN, gid = wgid / nig, fm = gid * pg8::WGM, gsz = (nM - fm) < pg8::WGM ? (nM - fm) : pg8::WGM;
        pm = fm + ((wgid % nig) % gsz); pn = (wgid % nig) / gsz;
        pa = A + (size_t)pm * a_tile + (size_t)pn * a_pn;
        const char* bb = B + (size_t)pn * b_tile;
        if (texp) { const int e = __builtin_amdgcn_readfirstlane((int)texp[pm]); bb += (size_t)e * e_bytes; }
        pb = bb; return true;
    }
};

using pg8::f32x4;

struct EpiQKV {
    bf16* Q; size_t kv_stride; const float* cosT; const float* sinT;
    __device__ __forceinline__ void operator()(const f32x4 (&acc)[2][2][4][2], const pg8::Unit& u, int wr, int wc, int fr, int fq) const {
        const int sel = u.pn >> 2, head = 4 * (u.pn & 3) + wc;
        bf16* base = Q + (size_t)sel * kv_stride;
        const bool rope = (sel < 2) && ((u.pn & 3) < 2);
        const float sc = sel == 0 ? QSCALE : 1.f;
#pragma unroll
        for (int ai = 0; ai < 2; ++ai)
#pragma unroll
            for (int m = 0; m < 4; ++m) {
                const int row = u.pm * 256 + ai * 128 + wr * 64 + m * 16 + fr;
                f32x4 a0 = acc[ai][0][m][0], a1 = acc[ai][0][m][1], b0 = acc[ai][1][m][0], b1 = acc[ai][1][m][1];
                if (rope) {
                    const int s = row & (SEQ - 1);
                    const f32x4 c0 = *(const f32x4*)(cosT + s * 32 + 8 * fq), c1 = *(const f32x4*)(cosT + s * 32 + 8 * fq + 4);
                    const f32x4 s0 = *(const f32x4*)(sinT + s * 32 + 8 * fq), s1 = *(const f32x4*)(sinT + s * 32 + 8 * fq + 4);
                    const f32x4 na0 = a0 * c0 - b0 * s0, nb0 = b0 * c0 + a0 * s0, na1 = a1 * c1 - b1 * s1, nb1 = b1 * c1 + a1 * s1;
                    a0 = na0; b0 = nb0; a1 = na1; b1 = nb1;
                }
                a0 = a0 * sc; a1 = a1 * sc; b0 = b0 * sc; b1 = b1 * sc;
                bf16* rowp = base + (size_t)(row + ((row >> 13) * 15 + head) * SEQ) * 64 + 8 * fq;
                v4u w; w.x = pg8::cvt_pk16(a0[0], a0[1]); w.y = pg8::cvt_pk16(a0[2], a0[3]); w.z = pg8::cvt_pk16(a1[0], a1[1]); w.w = pg8::cvt_pk16(a1[2], a1[3]);
                *(v4u*)rowp = w;
                v4u x; x.x = pg8::cvt_pk16(b0[0], b0[1]); x.y = pg8::cvt_pk16(b0[2], b0[3]); x.z = pg8::cvt_pk16(b1[0], b1[1]); x.w = pg8::cvt_pk16(b1[2], b1[3]);
                *(v4u*)(rowp + 32) = x;
                asm volatile("" ::: "memory");
            }
    }
};
struct EpiRes {
    bf16* XBp; const float* csc;
    __device__ __forceinline__ void operator()(const f32x4 (&acc)[2][2][4][2], const pg8::Unit& u, int wr, int wc, int fr, int fq) const {
        const int col0 = u.pn * 256 + 64 * wc + 8 * fq;
#pragma unroll
        for (int ai = 0; ai < 2; ++ai)
#pragma unroll
            for (int m = 0; m < 4; ++m) {
                const size_t off = (size_t)(u.pm * 256 + ai * 128 + wr * 64 + m * 16 + fr) * DM + col0;
#pragma unroll
                for (int bj = 0; bj < 2; ++bj) {
                    const v4u xr = *(const v4u*)(XBp + off + 32 * bj);
                    f32x4 a0 = acc[ai][bj][m][0], a1 = acc[ai][bj][m][1];
                    if (csc) { a0 = a0 * *(const f32x4*)(csc + col0 + 32 * bj); a1 = a1 * *(const f32x4*)(csc + col0 + 32 * bj + 4); }
                    v4u w;
                    w.x = pg8::cvt_pk16(bf_lo(xr.x) * ALPHA + a0[0], bf_hi(xr.x) * ALPHA + a0[1]); w.y = pg8::cvt_pk16(bf_lo(xr.y) * ALPHA + a0[2], bf_hi(xr.y) * ALPHA + a0[3]);
                    w.z = pg8::cvt_pk16(bf_lo(xr.z) * ALPHA + a1[0], bf_hi(xr.z) * ALPHA + a1[1]); w.w = pg8::cvt_pk16(bf_lo(xr.w) * ALPHA + a1[2], bf_hi(xr.w) * ALPHA + a1[3]);
                    *(v4u*)(XBp + off + 32 * bj) = w;
                }
                asm volatile("" ::: "memory");
            }
    }
};
struct EpiSwiGLU {
    bf16* H;
    __device__ __forceinline__ void operator()(const f32x4 (&acc)[2][2][4][2], const pg8::Unit& u, int wr, int wc, int fr, int fq) const {
        const int col0 = u.pn * 128 + 32 * wc + 8 * fq;
#pragma unroll
        for (int ai = 0; ai < 2; ++ai)
#pragma unroll
            for (int m = 0; m < 4; ++m) {
                const size_t off = (size_t)(u.pm * 256 + ai * 128 + wr * 64 + m * 16 + fr) * DM + col0;
                float h[8];
#pragma unroll
                for (int n = 0; n < 2; ++n)
#pragma unroll
                    for (int e = 0; e < 4; ++e) {
                        const float gt = acc[ai][0][m][n][e], up = acc[ai][1][m][n][e];
                        const float sg = gt * __builtin_amdgcn_rcpf(1.f + __builtin_amdgcn_exp2f(-gt * LOG2E));
                        h[4 * n + e] = sg * up;
                    }
                v4u w; w.x = pg8::cvt_pk16(h[0], h[1]); w.y = pg8::cvt_pk16(h[2], h[3]); w.z = pg8::cvt_pk16(h[4], h[5]); w.w = pg8::cvt_pk16(h[6], h[7]);
                *(v4u*)(H + off) = w;
                asm volatile("" ::: "memory");
            }
    }
};
struct EpiBf16 {
    bf16* O;
    __device__ __forceinline__ void operator()(const f32x4 (&acc)[2][2][4][2], const pg8::Unit& u, int wr, int wc, int fr, int fq) const {
        const int col0 = u.pn * 256 + 64 * wc + 8 * fq;
#pragma unroll
        for (int ai = 0; ai < 2; ++ai)
#pragma unroll
            for (int m = 0; m < 4; ++m) {
                const size_t off = (size_t)(u.pm * 256 + ai * 128 + wr * 64 + m * 16 + fr) * DM + col0;
#pragma unroll
                for (int bj = 0; bj < 2; ++bj) {
                    const f32x4 v0 = acc[ai][bj][m][0], v1 = acc[ai][bj][m][1];
                    v4u w; w.x = pg8::cvt_pk16(v0[0], v0[1]); w.y = pg8::cvt_pk16(v0[2], v0[3]); w.z = pg8::cvt_pk16(v1[0], v1[1]); w.w = pg8::cvt_pk16(v1[2], v1[3]);
                    *(v4u*)(O + off + 32 * bj) = w;
                }
                asm volatile("" ::: "memory");
            }
    }
};

__device__ __forceinline__ float wave_sum(float v) {
#pragma unroll
    for (int o = 1; o < 64; o <<= 1) v += __shfl_xor(v, o);
    return v;
}
__device__ __forceinline__ unsigned cvtpk_s(float lo, float hi) { return pg8::cvt_pk16(lo, hi); }

__device__ __forceinline__ void p0_transpose_item(const float* W, int K, int N, bf16* WT, int k0, int n0, int drow, LAS float* scr, int lane) {
#pragma unroll 8
    for (int i = 0; i < 32; ++i) { const int kk = 2 * i + (lane >> 5); scr[kk * 33 + (lane & 31)] = W[(size_t)(k0 + kk) * N + n0 + (lane & 31)]; }
    LDS_WAIT(); asm volatile("" ::: "memory");
    const int c = lane & 7;
#pragma unroll
    for (int j = 0; j < 4; ++j) { const int n = (lane >> 3) + 8 * j; const LAS float* s = scr + (8 * c) * 33 + n;
        v4u o; o.x = pk2(s[0 * 33], s[1 * 33]); o.y = pk2(s[2 * 33], s[3 * 33]); o.z = pk2(s[4 * 33], s[5 * 33]); o.w = pk2(s[6 * 33], s[7 * 33]);
        *(GAS v4u*)(WT + (size_t)(drow + n) * K + k0 + 8 * c) = o; }
    LDS_WAIT(); asm volatile("" ::: "memory");
}
struct InPtrs { const float *x, *w_in, *w_out, *rpb, *pool_w, *pool_scale, *router_w, *router_bias, *w1, *w3, *w2, *ln_g, *ln_b; };

__device__ __forceinline__ void sincos_d(double a, double& sn, double& cs) {
    const double n = __builtin_rint(a * 0.63661977236758134308);
    double r = __builtin_fma(-n, 1.57079632679489655800e+00, a); r = __builtin_fma(-n, 6.12323399573676603587e-17, r);
    const double z = r * r;
    const double sp = r + r * z * (-1.66666666666666324348e-01 + z * (8.33333333332248946124e-03 + z * (-1.98412698298579493134e-04 + z * (2.75573137070700676789e-06 + z * (-2.50507602534068634195e-08 + z * 1.58969099521155010221e-10)))));
    const double cp = 1.0 - 0.5 * z + z * z * (4.16666666666666019037e-02 + z * (-1.38888888888741095749e-03 + z * (2.48015872894767294178e-05 + z * (-2.75573143513906633035e-07 + z * (2.08757232129817482790e-09 + z * -1.13596475577881948265e-11)))));
    const int q = (int)((long long)n & 3);
    sn = (q == 0) ? sp : (q == 1) ? cp : (q == 2) ? -sp : -cp;
    cs = (q == 0) ? cp : (q == 1) ? -sp : (q == 2) ? -cp : sp;
}

__device__ __forceinline__ void phase_prologue(const InPtrs& in, unsigned char* ws, LAS unsigned char* lds, int gw, int NGW, int lane, int wave, int gtid, int NTH) {
    LAS float* scr = (LAS float*)(lds + wave * 16384);
    constexpr int MOE_ITEMS = DEPTH * NEXP * 3 * 512, IN_ITEMS = 2 * 1536, OUT_ITEMS = 2 * 512, POOL_ITEMS = 8 * 32;
    constexpr int NITEMS = MOE_ITEMS + IN_ITEMS + OUT_ITEMS + POOL_ITEMS;
    for (int it = gw; it < NITEMS; it += NGW) {
        int r = it;
        if (r < MOE_ITEMS) {
            const int mat = r >> 9, loc = r & 511, le = mat / 3, which = mat - 3 * le;
            const int kb = loc >> 5, nb = loc & 31;
            const float* src = (which == 0 ? in.w1 : which == 1 ? in.w3 : in.w2) + (size_t)le * DM * DM;
            if (which < 2) p0_transpose_item(src, DM, DM, (bf16*)(ws + WS_W13) + (size_t)le * 2048 * DM, 64 * kb, 32 * nb, 64 * nb + 32 * which, scr, lane);
            else           p0_transpose_item(src, DM, DM, (bf16*)(ws + WS_W2) + (size_t)le * DM * DM, 64 * kb, 32 * nb, 32 * nb, scr, lane);
            continue;
        }
        r -= MOE_ITEMS;
        if (r < IN_ITEMS) { const int i = r / 1536, loc = r - 1536 * i, kb = loc / 96, nb = loc - 96 * kb;
            p0_transpose_item(in.w_in + (size_t)i * DM * 3072, DM, 3072, (bf16*)(ws + WS_WQKV) + (size_t)i * 3072 * DM, 64 * kb, 32 * nb, 32 * nb, scr, lane); continue; }
        r -= IN_ITEMS;
        if (r < OUT_ITEMS) { const int i = r >> 9, loc = r & 511, kb = loc >> 5, nb = loc & 31;
            p0_transpose_item(in.w_out + (size_t)i * DM * DM, DM, DM, (bf16*)(ws + WS_WO) + (size_t)i * DM * DM, 64 * kb, 32 * nb, 32 * nb, scr, lane); continue; }
        r -= OUT_ITEMS;
        { const int mat = r >> 5, loc = r & 31, kb = loc >> 3, nb = loc & 7;
            p0_transpose_item(in.pool_w + (size_t)mat * 65536, 256, 256, (bf16*)(ws + WS_WP) + (size_t)mat * 65536, 64 * kb, 32 * nb, 32 * nb, scr, lane); }
    }
    bf16* XB = (bf16*)(ws + WS_XB);
    for (int m = gw; m < T; m += NGW) {
        const GAS f32x4* xr = (const GAS f32x4*)(in.x + (size_t)m * DM) + lane;
        GAS unsigned long long* o8 = (GAS unsigned long long*)(XB + (size_t)m * DM) + lane;
#pragma unroll
        for (int j = 0; j < 4; ++j) { const f32x4 v = xr[64 * j]; o8[64 * j] = (unsigned long long)pk2(v.x, v.y) | ((unsigned long long)pk2(v.z, v.w) << 32); }
    }
    { float* sm = (float*)(ws + WS_SMALL);
      for (int i = gtid; i < SM_END; i += NTH) {
          float v;
          if (i < SM_PSC) v = in.rpb[i]; else if (i < SM_RW) v = in.pool_scale[i - SM_PSC]; else if (i < SM_RB) v = in.router_w[i - SM_RW];
          else if (i < SM_LNG) v = in.router_bias[i - SM_RB]; else if (i < SM_LNB) v = in.ln_g[i - SM_LNG]; else v = in.ln_b[i - SM_LNB];
          sm[i] = v; } }
    float* cosT = (float*)(ws + WS_ROPE); float* sinT = cosT + SEQ * 32;
    for (int idx = gw * 64 + lane; idx < SEQ * 32; idx += NGW * 64) {
        const int s = idx >> 5, i = idx & 31;
        double invf = 1.0;
        if (i & 1) invf *= 0.7498942093324559; if (i & 2) invf *= 0.5623413251903491; if (i & 4) invf *= 0.31622776601683794; if (i & 8) invf *= 0.1; if (i & 16) invf *= 0.01;
        double sn, cs; sincos_d((double)s * invf, sn, cs);
        cosT[idx] = (float)cs; sinT[idx] = (float)sn;
    }
}

struct AttnP { const bf16* Q; const bf16* K; const bf16* V; bf16* O; bf16* OP; float* LSE; };
constexpr int V_RS = 144;
constexpr int V_TILE_BYTES = 32 * V_RS;
constexpr int RPB_OFF = 16 * V_TILE_BYTES;

struct AState { float m, lsum; f32x16 o0, o1; };
__device__ __forceinline__ void attn_stage(const v4u (&kr)[4], const v4u (&vr)[4], LAS unsigned char* vbuf, int lane) {
    LAS unsigned char* kbuf = vbuf + V_TILE_BYTES;
#pragma unroll
    for (int ii = 0; ii < 4; ++ii) { *(LAS v4u*)(kbuf + (8 * ii + (lane >> 3)) * V_RS + 16 * (lane & 7)) = kr[ii]; *(LAS v4u*)(vbuf + (8 * ii + (lane >> 3)) * V_RS + 16 * (lane & 7)) = vr[ii]; }
}
template <int MODE>
__device__ __forceinline__ void attn_compute(AState& st, const bf16x8 (&qf)[4], LAS unsigned char* vbuf, LAS unsigned char* trbase, int lane, int q4, int e0, const LAS float* bptr) {
    LAS unsigned char* kbuf = vbuf + V_TILE_BYTES;
    bf16x8 kf[4];
#pragma unroll
    for (int d0 = 0; d0 < 4; ++d0) kf[d0] = *(const LAS bf16x8*)(kbuf + (lane & 31) * V_RS + 32 * d0 + 16 * (lane >> 5));
    f32x16 s = {};
#pragma unroll
    for (int d0 = 0; d0 < 4; ++d0) s = __builtin_amdgcn_mfma_f32_32x32x16_f16(__builtin_bit_cast(pg8::h16x8, kf[d0]), __builtin_bit_cast(pg8::h16x8, qf[d0]), s, 0, 0, 0);
    float mx = -INFINITY;
#pragma unroll
    for (int rr = 0; rr < 16; ++rr) {
        const int keyc = (rr & 3) + 8 * (rr >> 2);
        float sv = s[rr];
        if (MODE == 1) sv = (keyc >= q4) ? sv : -INFINITY;
        if (MODE == 2) sv = (keyc <= q4) ? sv : -INFINITY;
        if (MODE == 3) { const int k15c = (rr & 3) + 8 * ((rr >> 2) & 1); const float bias = bptr[(rr >> 3) * 31 + k15c];
            sv = ((unsigned)(e0 + k15c) < 16u) ? sv + bias : -INFINITY; }
        s[rr] = sv; mx = fmaxf(mx, sv);
    }
    mx = fmaxf(mx, __shfl_xor(mx, 32));
    const float mnew = fmaxf(st.m, mx);
    if (__builtin_amdgcn_ballot_w64(mnew > st.m) != 0ull) {
        const float alpha = __builtin_amdgcn_exp2f(st.m - mnew);
        st.lsum *= alpha;
#pragma unroll
        for (int rr = 0; rr < 16; ++rr) { st.o0[rr] *= alpha; st.o1[rr] *= alpha; }
        st.m = mnew;
    }
    float psum = 0.f;
#pragma unroll
    for (int rr = 0; rr < 16; ++rr) { const float p = __builtin_amdgcn_exp2f(s[rr] - mnew); s[rr] = p; psum += p; }
    st.lsum += psum;
    v4u pw0, pw1;
    pw0.x = cvtpk_s(s[0], s[1]); pw0.y = cvtpk_s(s[2], s[3]); pw0.z = cvtpk_s(s[4], s[5]); pw0.w = cvtpk_s(s[6], s[7]);
    pw1.x = cvtpk_s(s[8], s[9]); pw1.y = cvtpk_s(s[10], s[11]); pw1.z = cvtpk_s(s[12], s[13]); pw1.w = cvtpk_s(s[14], s[15]);
    const bf16x8 pf0 = __builtin_bit_cast(bf16x8, pw0), pf1 = __builtin_bit_cast(bf16x8, pw1);
#pragma unroll
    for (int dblk = 0; dblk < 2; ++dblk) {
#pragma unroll
        for (int s2 = 0; s2 < 2; ++s2) {
            const s16x4 lo = __builtin_bit_cast(s16x4, __builtin_amdgcn_ds_read_tr16_b64_v4i16((LAS s16x4*)(trbase + (16 * s2) * V_RS + 64 * dblk)));
            const s16x4 hh = __builtin_bit_cast(s16x4, __builtin_amdgcn_ds_read_tr16_b64_v4i16((LAS s16x4*)(trbase + (16 * s2 + 8) * V_RS + 64 * dblk)));
            const bf16x8 vf = (bf16x8){lo[0], lo[1], lo[2], lo[3], hh[0], hh[1], hh[2], hh[3]};
            if (dblk == 0) st.o0 = __builtin_amdgcn_mfma_f32_32x32x16_f16(__builtin_bit_cast(pg8::h16x8, vf), __builtin_bit_cast(pg8::h16x8, s2 == 0 ? pf0 : pf1), st.o0, 0, 0, 0);
            else           st.o1 = __builtin_amdgcn_mfma_f32_32x32x16_f16(__builtin_bit_cast(pg8::h16x8, vf), __builtin_bit_cast(pg8::h16x8, s2 == 0 ? pf0 : pf1), st.o1, 0, 0, 0);
        }
    }
}
template <int MODE>
__device__ __forceinline__ float attn_mask(f32x16& s, int q4, int e0, const LAS float* bptr) {
    float mx = -INFINITY;
#pragma unroll
    for (int rr = 0; rr < 16; ++rr) {
        const int keyc = (rr & 3) + 8 * (rr >> 2);
        float sv = s[rr];
        if (MODE == 1) sv = (keyc >= q4) ? sv : -INFINITY;
        if (MODE == 2) sv = (keyc <= q4) ? sv : -INFINITY;
        if (MODE == 3) { const int k15c = (rr & 3) + 8 * ((rr >> 2) & 1); const float bias = bptr[(rr >> 3) * 31 + k15c];
            sv = ((unsigned)(e0 + k15c) < 16u) ? sv + bias : -INFINITY; }
        s[rr] = sv; mx = fmaxf(mx, sv);
    }
    return mx;
}
template <int MA, int MB>
__device__ __forceinline__ void attn_compute2(AState& sA, AState& sB, const bf16x8 (&qfA)[4], const bf16x8 (&qfB)[4], LAS unsigned char* vbuf, LAS unsigned char* trbase, int lane, int q4,
                                              int e0A, const LAS float* bpA, int e0B, const LAS float* bpB) {
    LAS unsigned char* kbuf = vbuf + V_TILE_BYTES;
    bf16x8 kf[4];
#pragma unroll
    for (int d0 = 0; d0 < 4; ++d0) kf[d0] = *(const LAS bf16x8*)(kbuf + (lane & 31) * V_RS + 32 * d0 + 16 * (lane >> 5));
    f32x16 a = {}, b = {};
#pragma unroll
    for (int d0 = 0; d0 < 4; ++d0) { a = __builtin_amdgcn_mfma_f32_32x32x16_f16(__builtin_bit_cast(pg8::h16x8, kf[d0]), __builtin_bit_cast(pg8::h16x8, qfA[d0]), a, 0, 0, 0);
                                     b = __builtin_amdgcn_mfma_f32_32x32x16_f16(__builtin_bit_cast(pg8::h16x8, kf[d0]), __builtin_bit_cast(pg8::h16x8, qfB[d0]), b, 0, 0, 0); }
    float mxA = attn_mask<MA>(a, q4, e0A, bpA), mxB = attn_mask<MB>(b, q4, e0B, bpB);
    mxA = fmaxf(mxA, __shfl_xor(mxA, 32)); mxB = fmaxf(mxB, __shfl_xor(mxB, 32));
    const float mnA = fmaxf(sA.m, mxA), mnB = fmaxf(sB.m, mxB);
    if (__builtin_amdgcn_ballot_w64((mnA > sA.m) || (mnB > sB.m)) != 0ull) {
        const float alA = __builtin_amdgcn_exp2f(sA.m - mnA), alB = __builtin_amdgcn_exp2f(sB.m - mnB);
        sA.lsum *= alA; sB.lsum *= alB;
#pragma unroll
        for (int rr = 0; rr < 16; ++rr) { sA.o0[rr] *= alA; sA.o1[rr] *= alA; sB.o0[rr] *= alB; sB.o1[rr] *= alB; }
        sA.m = mnA; sB.m = mnB;
    }
    float psA = 0.f, psB = 0.f;
#pragma unroll
    for (int rr = 0; rr < 16; ++rr) { const float pa = __builtin_amdgcn_exp2f(a[rr] - mnA), pb = __builtin_amdgcn_exp2f(b[rr] - mnB); a[rr] = pa; b[rr] = pb; psA += pa; psB += pb; }
    sA.lsum += psA; sB.lsum += psB;
    v4u wa0, wa1, wb0, wb1;
    wa0.x = cvtpk_s(a[0], a[1]); wa0.y = cvtpk_s(a[2], a[3]); wa0.z = cvtpk_s(a[4], a[5]); wa0.w = cvtpk_s(a[6], a[7]);
    wa1.x = cvtpk_s(a[8], a[9]); wa1.y = cvtpk_s(a[10], a[11]); wa1.z = cvtpk_s(a[12], a[13]); wa1.w = cvtpk_s(a[14], a[15]);
    wb0.x = cvtpk_s(b[0], b[1]); wb0.y = cvtpk_s(b[2], b[3]); wb0.z = cvtpk_s(b[4], b[5]); wb0.w = cvtpk_s(b[6], b[7]);
    wb1.x = cvtpk_s(b[8], b[9]); wb1.y = cvtpk_s(b[10], b[11]); wb1.z = cvtpk_s(b[12], b[13]); wb1.w = cvtpk_s(b[14], b[15]);
    const pg8::h16x8 pa0 = __builtin_bit_cast(pg8::h16x8, wa0), pa1 = __builtin_bit_cast(pg8::h16x8, wa1), pb0 = __builtin_bit_cast(pg8::h16x8, wb0), pb1 = __builtin_bit_cast(pg8::h16x8, wb1);
#pragma unroll
    for (int dblk = 0; dblk < 2; ++dblk)
#pragma unroll
        for (int s2 = 0; s2 < 2; ++s2) {
            const s16x4 lo = __builtin_bit_cast(s16x4, __builtin_amdgcn_ds_read_tr16_b64_v4i16((LAS s16x4*)(trbase + (16 * s2) * V_RS + 64 * dblk)));
            const s16x4 hh = __builtin_bit_cast(s16x4, __builtin_amdgcn_ds_read_tr16_b64_v4i16((LAS s16x4*)(trbase + (16 * s2 + 8) * V_RS + 64 * dblk)));
            const pg8::h16x8 vf = __builtin_bit_cast(pg8::h16x8, (bf16x8){lo[0], lo[1], lo[2], lo[3], hh[0], hh[1], hh[2], hh[3]});
            if (dblk == 0) { sA.o0 = __builtin_amdgcn_mfma_f32_32x32x16_f16(vf, s2 == 0 ? pa0 : pa1, sA.o0, 0, 0, 0); sB.o0 = __builtin_amdgcn_mfma_f32_32x32x16_f16(vf, s2 == 0 ? pb0 : pb1, sB.o0, 0, 0, 0); }
            else           { sA.o1 = __builtin_amdgcn_mfma_f32_32x32x16_f16(vf, s2 == 0 ? pa0 : pa1, sA.o1, 0, 0, 0); sB.o1 = __builtin_amdgcn_mfma_f32_32x32x16_f16(vf, s2 == 0 ? pb0 : pb1, sB.o1, 0, 0, 0); }
        }
}
__device__ __forceinline__ void attn_load(const bf16* Kp, const bf16* Vp, int tokV0, int vstride8, int hrow, v4u (&kr)[4], v4u (&vr)[4], int lane) {
#pragma unroll
    for (int ii = 0; ii < 4; ++ii) { const size_t off = (size_t)(tokV0 + ii * vstride8 + hrow) * 64 + 8 * (lane & 7); kr[ii] = *(const v4u*)(Kp + off); vr[ii] = *(const v4u*)(Vp + off); }
}
__device__ __forceinline__ void attn_store(const AState& st0, bf16* orow, int hi) {
    float lsum = st0.lsum; lsum += __shfl_xor(lsum, 32);
    const float inv = 1.f / lsum;
#pragma unroll
    for (int g = 0; g < 4; ++g) {
        v2u w0, w1;
        w0.x = cvtpk_s(st0.o0[4 * g] * inv, st0.o0[4 * g + 1] * inv); w0.y = cvtpk_s(st0.o0[4 * g + 2] * inv, st0.o0[4 * g + 3] * inv);
        w1.x = cvtpk_s(st0.o1[4 * g] * inv, st0.o1[4 * g + 1] * inv); w1.y = cvtpk_s(st0.o1[4 * g + 2] * inv, st0.o1[4 * g + 3] * inv);
        *(v2u*)(orow + 8 * g + 4 * hi) = w0;
        *(v2u*)(orow + 32 + 8 * g + 4 * hi) = w1;
    }
}
__device__ __forceinline__ void attn_unit_D(const AttnP& P, int unit, LAS unsigned char* vbuf, LAS unsigned char* trbase, int lane) {
    const int q = lane & 31, hi = lane >> 5;
    const int br = unit >> 12, rem = unit & 4095, b = rem >> 10, hD = (rem >> 7) & 7, qblk = rem & 127;
    const int sh = 2 * br, ph = qblk >> (7 - sh), i0 = 64 * (qblk & ((128 >> sh) - 1)), L = SEQ >> sh;
    const int hrow = (15 * b + hD) * SEQ, base = b * SEQ + ph;
    const int qtokA = base + ((i0 + q) << sh), qtokB = qtokA + (32 << sh);
    bf16x8 qfA[4], qfB[4];
#pragma unroll
    for (int d0 = 0; d0 < 4; ++d0) { qfA[d0] = *(const bf16x8*)(P.Q + (size_t)(qtokA + hrow) * 64 + 16 * d0 + 8 * hi); qfB[d0] = *(const bf16x8*)(P.Q + (size_t)(qtokB + hrow) * 64 + 16 * d0 + 8 * hi); }
    AState sA, sB; sA.m = -1e30f; sA.lsum = 0.f; sA.o0 = (f32x16){}; sA.o1 = (f32x16){}; sB.m = -1e30f; sB.lsum = 0.f; sB.o0 = (f32x16){}; sB.o1 = (f32x16){};
    const int q4 = q - 4 * hi, vs8 = 8 << sh;
    v4u k0[4], k1[4], v0[4], v1[4];
#define D_IN(t) ((i0 - 64 + 32 * (t)) >= 0 && (i0 - 64 + 32 * (t)) < L)
#define D_LOAD(kf, vr, t) do { const int j0 = min(max(i0 - 64 + 32 * (t), 0), L - 32); attn_load(P.K, P.V, base + ((j0 + (lane >> 3)) << sh), vs8, hrow, kf, vr, lane); } while (0)
#define D_STEP(kf, vr, t, MA, MB) do { if (D_IN(t)) { attn_stage(kf, vr, vbuf, lane); if ((t) == 0) attn_compute<MA>(sA, qfA, vbuf, trbase, lane, q4, 0, nullptr); else if ((t) == 5) attn_compute<MB>(sB, qfB, vbuf, trbase, lane, q4, 0, nullptr); \
        else attn_compute2<MA, MB>(sA, sB, qfA, qfB, vbuf, trbase, lane, q4, 0, nullptr, 0, nullptr); } } while (0)
    D_LOAD(k0, v0, 0);
    D_LOAD(k1, v1, 1); D_STEP(k0, v0, 0, 1, 0);
    D_LOAD(k0, v0, 2); D_STEP(k1, v1, 1, 0, 1);
    D_LOAD(k1, v1, 3); D_STEP(k0, v0, 2, 0, 0);
    D_LOAD(k0, v0, 4); D_STEP(k1, v1, 3, 0, 0);
    D_LOAD(k1, v1, 5); D_STEP(k0, v0, 4, 2, 0);
    D_STEP(k1, v1, 5, 0, 2);
#undef D_IN
#undef D_LOAD
#undef D_STEP
    { float lt = sA.lsum; lt += __shfl_xor(lt, 32); const size_t prow = (size_t)br * (8 * T) + qtokA + (7 * b + hD) * SEQ;
      if (hi == 0) P.LSE[prow] = sA.m + __builtin_amdgcn_logf(lt);
      attn_store(sA, P.OP + prow * 64, hi); }
    { float lt = sB.lsum; lt += __shfl_xor(lt, 32); const size_t prow = (size_t)br * (8 * T) + qtokB + (7 * b + hD) * SEQ;
      if (hi == 0) P.LSE[prow] = sB.m + __builtin_amdgcn_logf(lt);
      attn_store(sB, P.OP + prow * 64, hi); }
}
__device__ __forceinline__ void attn_unit_N(const AttnP& P, int unit, LAS unsigned char* vbuf, LAS unsigned char* trbase, const LAS float* rpbt, int lane) {
    const int q = lane & 31, hi = lane >> 5;
    const int b = unit >> 10, hN = (unit >> 7) & 7, r = unit & 127, r0 = min(max(r - 4, 0), 120);
    const int cA = q, cB = 32 + q, csA = min(max(cA - 8, 0), 48), csB = min(max(cB - 8, 0), 48);
    const int qtokA = b * SEQ + 64 * r + q, hrow = (15 * b + 8 + hN) * SEQ;
    bf16x8 qfA[4], qfB[4];
#pragma unroll
    for (int d0 = 0; d0 < 4; ++d0) { qfA[d0] = *(const bf16x8*)(P.Q + (size_t)(qtokA + hrow) * 64 + 16 * d0 + 8 * hi); qfB[d0] = *(const bf16x8*)(P.Q + (size_t)(qtokA + 32 + hrow) * 64 + 16 * d0 + 8 * hi); }
    AState sA, sB; sA.m = -1e30f; sA.lsum = 0.f; sA.o0 = (f32x16){}; sA.o1 = (f32x16){}; sB.m = -1e30f; sB.lsum = 0.f; sB.o0 = (f32x16){}; sB.o1 = (f32x16){};
    v4u k0[4], k1[4], v0[4], v1[4];
#define N_LOAD(kf, vr, rp_, cc_) do { const int rowtok = b * SEQ + 64 * (r0 + 2 * (rp_)) + 16 * (cc_); const int l8 = lane >> 3; \
        _Pragma("unroll") for (int ii = 0; ii < 4; ++ii) { const size_t off_ = (size_t)(rowtok + 64 * (ii >> 1) + 8 * (ii & 1) + l8 + hrow) * 64 + 8 * (lane & 7); kf[ii] = *(const v4u*)(P.K + off_); vr[ii] = *(const v4u*)(P.V + off_); } } while (0)
#define N_STEP(kf, vr, rp_, cc_) do { attn_stage(kf, vr, vbuf, lane); const int rb_ = hN * 465 + (r0 + 2 * (rp_) - r + 7) * 31 + 16 * (cc_) + 15 + 4 * hi; \
        if ((cc_) == 0) attn_compute<3>(sA, qfA, vbuf, trbase, lane, 0, 16 * (cc_) - csA + 4 * hi, rpbt + rb_ - cA); \
        else if ((cc_) == 3) attn_compute<3>(sB, qfB, vbuf, trbase, lane, 0, 16 * (cc_) - csB + 4 * hi, rpbt + rb_ - cB); \
        else attn_compute2<3, 3>(sA, sB, qfA, qfB, vbuf, trbase, lane, 0, 16 * (cc_) - csA + 4 * hi, rpbt + rb_ - cA, 16 * (cc_) - csB + 4 * hi, rpbt + rb_ - cB); } while (0)
    N_LOAD(k0, v0, 0, 0);
    for (int rp = 0; rp < 4; ++rp) {
        N_LOAD(k1, v1, rp, 1); N_STEP(k0, v0, rp, 0);
        N_LOAD(k0, v0, rp, 2); N_STEP(k1, v1, rp, 1);
        N_LOAD(k1, v1, rp, 3); N_STEP(k0, v0, rp, 2);
        if (rp < 3) N_LOAD(k0, v0, rp + 1, 0);
        N_STEP(k1, v1, rp, 3);
    }
#undef N_LOAD
#undef N_STEP
    attn_store(sA, P.O + (size_t)qtokA * DM + 64 * (8 + hN), hi);
    attn_store(sB, P.O + (size_t)(qtokA + 32) * DM + 64 * (8 + hN), hi);
}

__device__ __forceinline__ void phase_attention(const AttnP& P, const float* rpb, LAS unsigned char* lds, int gw, int NGW, int tid, int lane, int wave) {
    LAS float* rpbt = (LAS float*)(lds + RPB_OFF);
    for (int i = tid; i < 8 * 465; i += NWAVES * 64) rpbt[i] = rpb[i] * LOG2E;
    __syncthreads();
    LAS unsigned char* vbuf = lds + wave * (2 * V_TILE_BYTES);
    const int hi = lane >> 5, qp = (lane & 15) >> 2, pp = lane & 3, blk = (lane >> 4) & 1;
    LAS unsigned char* trbase = vbuf + (4 * hi + qp) * V_RS + 32 * blk + 8 * pp;
    constexpr int NUNITS_N = BATCH * 8 * 128, NUNITS_D = 3 * BATCH * 8 * 128;
    const int G = NGW / NWAVES, nxw = (G % 8 == 0) ? G / 8 : G, nx = (G % 8 == 0) ? 8 : 1, xcd = (int)blockIdx.x % nx, jw = (int)blockIdx.x / nx;
    const int csz = nxw * NWAVES;
    for (int k = 0; ; ++k) { const int u = (k * nx + xcd) * csz + jw * NWAVES + wave; if ((k * nx + xcd) * csz >= NUNITS_N) break; if (u < NUNITS_N) attn_unit_N(P, u, vbuf, trbase, rpbt, lane); }
    for (int k = 0; ; ++k) { const int u = (k * nx + xcd) * csz + jw * NWAVES + wave; if ((k * nx + xcd) * csz >= NUNITS_D) break; if (u < NUNITS_D) attn_unit_D(P, u, vbuf, trbase, lane); }
}

__device__ __forceinline__ void phase_merge(const bf16* OP, const float* LSE, bf16* O, int gtid, int NT_) {
    for (int idx = gtid; idx < T * 64; idx += NT_) {
        const int tok = idx >> 6, h = (idx >> 3) & 7, ch = idx & 7;
        const size_t prow = (size_t)tok + (7 * (tok >> 13) + h) * SEQ, pbr = (size_t)8 * T;
        const float l0 = LSE[prow], l1 = LSE[prow + pbr], l2 = LSE[prow + 2 * pbr];
        const float mx = fmaxf(l0, fmaxf(l1, l2));
        float w0 = __builtin_amdgcn_exp2f(l0 - mx), w1 = __builtin_amdgcn_exp2f(l1 - mx), w2 = __builtin_amdgcn_exp2f(l2 - mx);
        const float inv = 1.f / (w0 + w1 + w2); w0 *= inv; w1 *= inv; w2 *= inv;
        const v4u a = *(const v4u*)(OP + prow * 64 + 8 * ch), b = *(const v4u*)(OP + (prow + pbr) * 64 + 8 * ch), c = *(const v4u*)(OP + (prow + 2 * pbr) * 64 + 8 * ch);
        v4u o;
#pragma unroll
        for (int k = 0; k < 4; ++k) {
            const float lo = w0 * bf_lo(a[k]) + w1 * bf_lo(b[k]) + w2 * bf_lo(c[k]);
            const float hi = w0 * bf_hi(a[k]) + w1 * bf_hi(b[k]) + w2 * bf_hi(c[k]);
            o[k] = cvtpk_s(lo, hi);
        }
        *(v4u*)(O + (size_t)tok * DM + 64 * h + 8 * ch) = o;
    }
}

template <int HALF>
__device__ __forceinline__ void pool_item(const bf16* XBp, bf16* U, int b, int s0, int c8) {
    constexpr int R = 16 + 2 * HALF;
    const bf16* xb = XBp + (size_t)b * SEQ * DM + 8 * c8;
    v4u rows[R];
#pragma unroll
    for (int k = 0; k < R; ++k) { const int s = s0 - HALF + k; const int sc = min(max(s, 0), SEQ - 1); rows[k] = *(const v4u*)(xb + (size_t)sc * DM); if (s < 0 || s >= SEQ) rows[k] = (v4u){0u, 0u, 0u, 0u}; }
    float sum[8];
#pragma unroll
    for (int j = 0; j < 8; ++j) sum[j] = 0.f;
#pragma unroll
    for (int k = 0; k < 2 * HALF; ++k)
#pragma unroll
        for (int j = 0; j < 4; ++j) { sum[2 * j] += bf_lo(rows[k][j]); sum[2 * j + 1] += bf_hi(rows[k][j]); }
#pragma unroll
    for (int i = 0; i < 16; ++i) {
        const int s = s0 + i; const int lo = max(s - HALF, 0), hi = min(s + HALF, SEQ);
        const float rc = 1.f / (float)(hi - lo);
        v4u w;
#pragma unroll
        for (int j = 0; j < 4; ++j) w[j] = cvtpk_s(sum[2 * j] * rc - bf_lo(rows[i + HALF][j]), sum[2 * j + 1] * rc - bf_hi(rows[i + HALF][j]));
        *(v4u*)(U + ((size_t)b * SEQ + s) * DM + 8 * c8) = w;
        if (i < 15) {
#pragma unroll
            for (int j = 0; j < 4; ++j) { sum[2 * j] += bf_lo(rows[i + 2 * HALF][j]) - bf_lo(rows[i][j]); sum[2 * j + 1] += bf_hi(rows[i + 2 * HALF][j]) - bf_hi(rows[i][j]); }
        }
    }
}
__device__ __forceinline__ void phase_pool(const bf16* XBp, bf16* U, int gtid, int NT_) {
    for (int idx = gtid; idx < (T / 16) * 128; idx += NT_) {
        const int g = (idx >> 6) & 3, c8 = 32 * g + (idx & 31), tch = ((idx >> 8) << 1) | ((idx >> 5) & 1), b = tch >> 9, s0 = (tch & 511) * 16;
        if (g == 0) pool_item<1>(XBp, U, b, s0, c8); else if (g == 1) pool_item<2>(XBp, U, b, s0, c8); else if (g == 2) pool_item<4>(XBp, U, b, s0, c8); else pool_item<8>(XBp, U, b, s0, c8);
    }
}

__device__ __forceinline__ void load_row_bf16(float (&v)[16], const bf16* row, int lane) {
#pragma unroll
    for (int j = 0; j < 2; ++j) { const v4u r = *((const GAS v4u*)row + lane + 64 * j);
#pragma unroll
        for (int k = 0; k < 4; ++k) { v[8 * j + 2 * k] = bf_lo(r[k]); v[8 * j + 2 * k + 1] = bf_hi(r[k]); } }
}
__device__ __forceinline__ void ln_row(float (&v)[16], const float* g, const float* bta, int lane) {
    float s = 0.f;
#pragma unroll
    for (int k = 0; k < 16; k += 4) s += (v[k] + v[k + 1]) + (v[k + 2] + v[k + 3]);
    const float mean = wave_sum(s) * (1.f / DM); float s2 = 0.f;
#pragma unroll
    for (int k = 0; k < 16; ++k) { v[k] -= mean; s2 += v[k] * v[k]; }
    const float rstd = 1.f / sqrtf(wave_sum(s2) * (1.f / DM) + LN_EPS);
#pragma unroll
    for (int j = 0; j < 2; ++j)
#pragma unroll
        for (int h = 0; h < 2; ++h) { const f32x4 gg = *(const f32x4*)(g + 512 * j + 8 * lane + 4 * h), bb = *(const f32x4*)(bta + 512 * j + 8 * lane + 4 * h);
#pragma unroll
            for (int c = 0; c < 4; ++c) v[8 * j + 4 * h + c] = v[8 * j + 4 * h + c] * rstd * gg[c] + bb[c]; }
}
__device__ __forceinline__ void store_row_bf16(const float (&v)[16], bf16* row, int lane) {
#pragma unroll
    for (int j = 0; j < 2; ++j) { v4u w;
#pragma unroll
        for (int k = 0; k < 4; ++k) w[k] = cvtpk_s(v[8 * j + 2 * k], v[8 * j + 2 * k + 1]);
        *((GAS v4u*)row + lane + 64 * j) = w; }
}
__device__ __forceinline__ void store_row_f32(const float (&v)[16], float* row, int lane) {
#pragma unroll
    for (int j = 0; j < 2; ++j)
#pragma unroll
        for (int h = 0; h < 2; ++h) *((GAS f32x4*)(row + 512 * j + 8 * lane + 4 * h)) = (f32x4){v[8 * j + 4 * h], v[8 * j + 4 * h + 1], v[8 * j + 4 * h + 2], v[8 * j + 4 * h + 3]};
}

__device__ __forceinline__ float reduce16(float (&v)[16], int lane) {
#pragma unroll
    for (int i = 0; i < 8; ++i) { const bool up = lane & 32; const float send = up ? v[i] : v[i + 8], keep = up ? v[i + 8] : v[i]; v[i] = keep + __shfl_xor(send, 32); }
#pragma unroll
    for (int i = 0; i < 4; ++i) { const bool up = lane & 16; const float send = up ? v[i] : v[i + 4], keep = up ? v[i + 4] : v[i]; v[i] = keep + __shfl_xor(send, 16); }
#pragma unroll
    for (int i = 0; i < 2; ++i) { const bool up = lane & 8; const float send = up ? v[i] : v[i + 2], keep = up ? v[i + 2] : v[i]; v[i] = keep + __shfl_xor(send, 8); }
    { const bool up = lane & 4; const float send = up ? v[0] : v[1], keep = up ? v[1] : v[0]; v[0] = keep + __shfl_xor(send, 4); }
    v[0] += __shfl_xor(v[0], 2); v[0] += __shfl_xor(v[0], 1);
    return v[0];
}

struct TokTabs { int* e; float* g; int* rank; int* pos; };

__device__ __forceinline__ void route_token(const float (&lg)[16], const float* rbias, size_t tok, int tl, const TokTabs& TT, LAS int* lcnt, LAS int* tinfo, int lane) {
    float aff[16], sel[16];
#pragma unroll
    for (int e = 0; e < 16; ++e) { aff[e] = 1.f / (1.f + expf(-lg[e])); sel[e] = aff[e] + rbias[e]; }
    float gs[4];
#pragma unroll
    for (int g = 0; g < 4; ++g) { const float a = sel[4 * g], b = sel[4 * g + 1], c = sel[4 * g + 2], d = sel[4 * g + 3];
        const float h1 = fmaxf(a, b), l1 = fminf(a, b), h2 = fmaxf(c, d), l2 = fminf(c, d);
        gs[g] = fmaxf(h1, h2) + fmaxf(fminf(h1, h2), fmaxf(l1, l2)); }
    int grp = 0; float best = gs[0];
#pragma unroll
    for (int g = 1; g < 4; ++g) if (gs[g] > best) { best = gs[g]; grp = g; }
    float sg[4], ag[4];
#pragma unroll
    for (int k = 0; k < 4; ++k) { sg[k] = grp == 0 ? sel[k] : grp == 1 ? sel[4 + k] : grp == 2 ? sel[8 + k] : sel[12 + k]; ag[k] = grp == 0 ? aff[k] : grp == 1 ? aff[4 + k] : grp == 2 ? aff[8 + k] : aff[12 + k]; }
    int i1 = 0; float b1 = sg[0];
#pragma unroll
    for (int k = 1; k < 4; ++k) if (sg[k] > b1) { b1 = sg[k]; i1 = k; }
    int i2 = -1; float b2 = -INFINITY;
#pragma unroll
    for (int k = 0; k < 4; ++k) if (k != i1 && (i2 < 0 || sg[k] > b2)) { b2 = sg[k]; i2 = k; }
    const float a1 = i1 == 0 ? ag[0] : i1 == 1 ? ag[1] : i1 == 2 ? ag[2] : ag[3];
    const float a2 = i2 == 0 ? ag[0] : i2 == 1 ? ag[1] : i2 == 2 ? ag[2] : ag[3];
    const float den = a1 + a2;
    if (lane == 0) {
        const int e1 = grp * 4 + i1, e2 = grp * 4 + i2;
        const int r1 = __hip_atomic_fetch_add(lcnt + e1, 1, __ATOMIC_RELAXED, __HIP_MEMORY_SCOPE_WORKGROUP);
        const int r2 = __hip_atomic_fetch_add(lcnt + e2, 1, __ATOMIC_RELAXED, __HIP_MEMORY_SCOPE_WORKGROUP);
        tinfo[tl * 4 + 0] = e1; tinfo[tl * 4 + 1] = r1; tinfo[tl * 4 + 2] = e2; tinfo[tl * 4 + 3] = r2;
        TT.e[tok * 2] = e1; TT.e[tok * 2 + 1] = e2; TT.g[tok * 2] = a1 / den; TT.g[tok * 2 + 1] = a2 / den;
    }
}

__device__ __forceinline__ void phase_lnr(bf16* XB, const float* g, const float* bta, const float* router_w, const float* rbias_g,
                                          const TokTabs& TT, int* list, gu32* cnt, LAS unsigned char* lds, int tid, int lane, int wave) {
    LAS float* rw = (LAS float*)lds;
    LAS int* lcnt = (LAS int*)(lds + 65536); LAS int* lbase = lcnt + 16; LAS int* tinfo = lcnt + 32;
    for (int idx = tid; idx < DM * 16; idx += NWAVES * 64) { const int col = idx >> 4, e = idx & 15, j = col >> 9, l = (col & 511) >> 3, c = col & 7, k = 8 * j + c;
        rw[(((k * 4 + (e >> 2)) * 64 + l) << 2) + (e & 3)] = router_w[idx]; }
    float rbias[16];
#pragma unroll
    for (int e = 0; e < 16; ++e) rbias[e] = rbias_g[e];
    for (int chunk = blockIdx.x; chunk < T / 128; chunk += gridDim.x) {
        __syncthreads();
        if (tid < 16) lcnt[tid] = 0;
        __syncthreads();
        for (int pass = 0; pass < 8; ++pass) {
            const int tl0 = wave * 16 + 2 * pass; const size_t tok0 = (size_t)chunk * 128 + tl0;
            float va[16], vb[16];
            load_row_bf16(va, XB + tok0 * DM, lane); load_row_bf16(vb, XB + (tok0 + 1) * DM, lane);
            ln_row(va, g, bta, lane); ln_row(vb, g, bta, lane);
            store_row_bf16(va, XB + tok0 * DM, lane); store_row_bf16(vb, XB + (tok0 + 1) * DM, lane);
            float pa[16], pb[16];
#pragma unroll
            for (int e = 0; e < 16; ++e) { pa[e] = 0.f; pb[e] = 0.f; }
#pragma unroll
            for (int k = 0; k < 16; ++k)
#pragma unroll
                for (int e4 = 0; e4 < 4; ++e4) {
                    const f32x4 w = *(const LAS f32x4*)(rw + (((k * 4 + e4) * 64 + lane) << 2));
#pragma unroll
                    for (int ee = 0; ee < 4; ++ee) { pa[4 * e4 + ee] += va[k] * w[ee]; pb[4 * e4 + ee] += vb[k] * w[ee]; }
                }
            const float ra = reduce16(pa, lane), rb = reduce16(pb, lane);
            float lga[16], lgb[16];
#pragma unroll
            for (int e = 0; e < 16; ++e) { lga[e] = __builtin_bit_cast(float, __builtin_amdgcn_readlane(__builtin_bit_cast(int, ra), 4 * e)); lgb[e] = __builtin_bit_cast(float, __builtin_amdgcn_readlane(__builtin_bit_cast(int, rb), 4 * e)); }
            route_token(lga, rbias, tok0, tl0, TT, lcnt, tinfo, lane);
            route_token(lgb, rbias, tok0 + 1, tl0 + 1, TT, lcnt, tinfo, lane);
        }
        __syncthreads();
        if (tid < 16) lbase[tid] = (int)__hip_atomic_fetch_add(cnt + 64 * tid, (unsigned)lcnt[tid], RLX_AGENT);
        __syncthreads();
        if (tid < 256) { const int tl = tid >> 1, k = tid & 1; const int e = tinfo[tl * 4 + 2 * k], lr = tinfo[tl * 4 + 2 * k + 1];
            const int rk = lbase[e] + lr; TT.rank[((size_t)chunk * 128 + tl) * 2 + k] = rk; list[(size_t)e * T + rk] = chunk * 128 + tl; }
    }
    __syncthreads();
}

__device__ __forceinline__ int build_expert_tables(const gu32* cnt, LAS unsigned char* lds, int tid) {
    LAS int* pstart = (LAS int*)(lds + PSTART_OFF); LAS unsigned char* texp = lds + TEXP_OFF; LAS int* ntl = (LAS int*)(lds + NTL_OFF); LAS int* tstart = (LAS int*)(lds + TSTART_OFF); LAS int* ecnt = (LAS int*)(lds + ECNT_OFF);
    __syncthreads();
    if (tid == 0) {
        int acc = 0;
        for (int e = 0; e < NEXP; ++e) { const int c = (int)__hip_atomic_load(cnt + 64 * e, RLX_AGENT); const int nt = (c + 255) >> 8; pstart[e] = acc * 256; tstart[e] = acc; ecnt[e] = c; for (int i = 0; i < nt; ++i) texp[acc + i] = (unsigned char)e; acc += nt; }
        *ntl = acc;
    }
    __syncthreads();
    return *ntl;
}

__device__ __forceinline__ void phase_combine(bf16* XB, float* out, const bf16* YB, const TokTabs& TT, const LAS int* pstart, const float* g, const float* bta, int gw, int NGW, int lane) {
    for (int tok = gw; tok < T; tok += NGW) {
        const int p0 = pstart[TT.e[tok * 2]] + TT.rank[tok * 2], p1 = pstart[TT.e[tok * 2 + 1]] + TT.rank[tok * 2 + 1]; const float g0 = TT.g[tok * 2], g1 = TT.g[tok * 2 + 1];
        float v[16], y0[16], y1[16];
        load_row_bf16(v, XB + (size_t)tok * DM, lane); load_row_bf16(y0, YB + (size_t)p0 * DM, lane); load_row_bf16(y1, YB + (size_t)p1 * DM, lane);
#pragma unroll
        for (int k = 0; k < 16; ++k) v[k] = v[k] * ALPHA + g0 * y0[k] + g1 * y1[k];
        ln_row(v, g, bta, lane);
        if (out) store_row_f32(v, out + (size_t)tok * DM, lane); else store_row_bf16(v, XB + (size_t)tok * DM, lane);
    }
}

#ifndef DUPMASK
#define DUPMASK 0
#endif
struct Args { InPtrs in; float* out; unsigned char* ws; int layer, pad; };

template <int SLOT>
__device__ __forceinline__ void do_slot(const Args& args, int layer, LAS unsigned char* lds) {
    int tidL = threadIdx.x; asm volatile("" : "+v"(tidL));
    const int tid = tidL, lane = tidL & 63, wave = __builtin_amdgcn_readfirstlane(tidL >> 6);
    const int G = gridDim.x, gw = blockIdx.x * NWAVES + wave, NGW = G * NWAVES, gtid = blockIdx.x * (NWAVES * 64) + tidL, NTH = G * NWAVES * 64;
    size_t zoff = 0; asm volatile("" : "+s"(zoff));
    unsigned char* ws = args.ws + zoff;
    float* X = args.out + zoff;
    const int i2 = layer >> 1;
    TokTabs TT; TT.e = (int*)(ws + WS_TOK); TT.g = (float*)(ws + WS_TOK + 262144); TT.rank = (int*)(ws + WS_TOK + 2 * 262144); TT.pos = (int*)(ws + WS_TOK + 3 * 262144);
    gu32* cnt = (gu32*)(ws + WS_CTL) + CW_CNT + layer * 16 * 64;
    bf16* XB = (bf16*)(ws + WS_XB);
    bf16* Qb = (bf16*)(ws + WS_Q); bf16* Kb = (bf16*)(ws + WS_K); bf16* Vb = (bf16*)(ws + WS_V); bf16* Ob = (bf16*)(ws + WS_O);
    bf16* OP = (bf16*)(ws + WS_OP); float* LSE = (float*)(ws + WS_LSE);
    bf16* Ub = (bf16*)(ws + WS_U); bf16* XS = (bf16*)(ws + WS_XS); bf16* Hb = (bf16*)(ws + WS_H);
    const float* cosT = (const float*)(ws + WS_ROPE); const float* sinT = cosT + SEQ * 32;
    const float* SMp = (const float*)(ws + WS_SMALL);
    LAS int* pstart = (LAS int*)(lds + PSTART_OFF); LAS unsigned char* texp = lds + TEXP_OFF;
    (void)tid; (void)lane; (void)gw; (void)NGW; (void)gtid; (void)NTH; (void)i2; (void)TT; (void)cnt; (void)XB; (void)Qb; (void)Kb; (void)Vb; (void)Ob; (void)OP; (void)LSE; (void)Ub; (void)XS; (void)Hb;
    (void)cosT; (void)sinT; (void)SMp; (void)pstart; (void)texp; (void)X;

    if constexpr (SLOT == 0) { phase_prologue(args.in, ws, lds, gw, NGW, lane, wave, gtid, NTH); }
    if constexpr (SLOT == 1) {
        Sched S{T / 256, 12, (T / 256) * 12, G, (int)blockIdx.x, (const char*)XB, (const char*)(ws + WS_WQKV) + (size_t)i2 * 3072 * DM * 2, (size_t)256 * DM * 2, 0, (size_t)256 * DM * 2, 0, nullptr, nullptr, nullptr, nullptr};
        EpiQKV E{Qb, (size_t)(WS_K - WS_Q) / 2, cosT, sinT};
        pg8::gemm_phase<EpiQKV, Sched, true>(lds, pg8::Gemm{DM, DM, DM}, S, E);
    }
    if constexpr (SLOT == 2) {
        AttnP P{Qb, Kb, Vb, Ob, OP, LSE};
        phase_attention(P, SMp + SM_RPB + (size_t)i2 * 8 * 465, lds, gw, NGW, tid, lane, wave);
    }
    if constexpr (SLOT == 3) { phase_merge(OP, LSE, Ob, gtid, NTH); }
#ifdef ATT_EXP
    if constexpr (SLOT == 12) {
        AttnP P{Qb, Kb, Vb, (bf16*)X, (bf16*)X, (float*)((unsigned char*)X + 100 * MiB)};
        phase_attention(P, SMp + SM_RPB + (size_t)i2 * 8 * 465, lds, gw, NGW, tid, lane, wave);
    }
#endif
    if constexpr (SLOT == 4) {
        Sched S{T / 256, 4, (T / 256) * 4, G, (int)blockIdx.x, (const char*)Ob, (const char*)(ws + WS_WO) + (size_t)i2 * DM * DM * 2, (size_t)256 * DM * 2, 0, (size_t)256 * DM * 2, 0, nullptr, nullptr, nullptr, nullptr};
        EpiRes E{XB, nullptr};
        pg8::gemm_phase<EpiRes, Sched, true>(lds, pg8::Gemm{DM, DM, DM}, S, E);
    }
    if constexpr (SLOT == 5) { phase_pool(XB, Ub, gtid, NTH); }
    if constexpr (SLOT == 6) {
        Sched S{T / 256, 4, (T / 256) * 4, G, (int)blockIdx.x, (const char*)Ub, (const char*)(ws + WS_WP) + (size_t)i2 * 4 * 65536 * 2, (size_t)256 * DM * 2, (size_t)512, (size_t)65536 * 2, 0, nullptr, nullptr, nullptr, nullptr};
        EpiRes E{XB, SMp + SM_PSC + (size_t)i2 * DM};
        pg8::gemm_phase<EpiRes, Sched, true>(lds, pg8::Gemm{DM, 256, 256}, S, E);
    }
    if constexpr (SLOT == 7) {
        phase_lnr(XB, SMp + SM_LNG + (size_t)(layer * 2) * DM, SMp + SM_LNB + (size_t)(layer * 2) * DM, SMp + SM_RW, SMp + SM_RB, TT, (int*)(ws + WS_LIST), cnt, lds, tid, lane, wave);
    }
    if constexpr (SLOT == 9) {
        const int ntiles = build_expert_tables(cnt, lds, tid);
        Sched S{ntiles, 8, ntiles * 8, G, (int)blockIdx.x, (const char*)XB, (const char*)(ws + WS_W13) + (size_t)layer * NEXP * 2048 * DM * 2, 0, 0, (size_t)256 * DM * 2, (size_t)2048 * DM * 2, texp,
                (const LAS int*)(lds + TSTART_OFF), (const LAS int*)(lds + ECNT_OFF), (const int*)(ws + WS_LIST)};
        EpiSwiGLU E{Hb};
        pg8::gemm_phase<EpiSwiGLU, Sched, true, true>(lds, pg8::Gemm{DM, DM, DM}, S, E);
    }
    if constexpr (SLOT == 10) {
        const int ntiles = build_expert_tables(cnt, lds, tid);
        Sched S{ntiles, 4, ntiles * 4, G, (int)blockIdx.x, (const char*)Hb, (const char*)(ws + WS_W2) + (size_t)layer * NEXP * DM * DM * 2, (size_t)256 * DM * 2, 0, (size_t)256 * DM * 2, (size_t)DM * DM * 2, texp, nullptr, nullptr, nullptr};
        EpiBf16 E{XS};
        pg8::gemm_phase<EpiBf16, Sched, true>(lds, pg8::Gemm{DM, DM, DM}, S, E);
    }
    if constexpr (SLOT == 11) {
        (void)build_expert_tables(cnt, lds, tid);
        phase_combine(XB, layer == DEPTH - 1 ? X : nullptr, XS, TT, pstart, SMp + SM_LNG + (size_t)(layer * 2 + 1) * DM, SMp + SM_LNB + (size_t)(layer * 2 + 1) * DM, gw, NGW, lane);
    }
}

#if MK_MULTI_LAUNCH
template <int SLOT>
__global__ void __launch_bounds__(NWAVES * 64, 2) k_slot(Args args) {
    extern __shared__ __attribute__((aligned(16))) unsigned char lds_raw[];
    LAS unsigned char* lds = (LAS unsigned char*)lds_raw;
    for (int u = threadIdx.x; u < (LDS_BYTES - RING_BYTES) / 4; u += NWAVES * 64) ((LAS unsigned*)(lds + RING_BYTES))[u] = 0u;
    __syncthreads();
    do_slot<SLOT>(args, args.layer, lds);
}
template <int SLOT> static void launch_slot(const Args& a, int grid, hipStream_t stream) {
    static bool attr_set = false;
    if (!attr_set) { (void)hipFuncSetAttribute((const void*)k_slot<SLOT>, hipFuncAttributeMaxDynamicSharedMemorySize, LDS_BYTES); attr_set = true; }
    hipLaunchKernelGGL(k_slot<SLOT>, dim3(grid), dim3(NWAVES * 64), LDS_BYTES, stream, a);
}
#else
__global__ void __launch_bounds__(NWAVES * 64, 2) fwd(Args args) {
    extern __shared__ __attribute__((aligned(16))) unsigned char lds_raw[];
    LAS unsigned char* lds = (LAS unsigned char*)lds_raw;
    volatile LAS unsigned* MISC = (volatile LAS unsigned*)(lds + MISC_OFF);
    for (int u = threadIdx.x; u < (LDS_BYTES - RING_BYTES) / 4; u += NWAVES * 64) ((LAS unsigned*)(lds + RING_BYTES))[u] = 0u;
    __syncthreads();
    const XcdBarrier bar = xcd_barrier_post((unsigned*)((gu32*)(args.ws + WS_CTL) + CW_BAR), MISC + 8);
    do_slot<0>(args, 0, lds);
    if constexpr (DUPMASK & 1) { xcd_barrier(bar); do_slot<0>(args, 0, lds); }
#define RUN(S, L) xcd_barrier(bar); do_slot<S>(args, L, lds); if constexpr ((DUPMASK >> S) & 1) { xcd_barrier(bar); do_slot<S>(args, L, lds); }
#define MOE_SLOTS(L) RUN(7, L) RUN(9, L) RUN(10, L) RUN(11, L)
#ifdef ATT_EXP
#define LAYER_ATT(L) RUN(1, L) RUN(2, L) RUN(12, L) RUN(3, L) RUN(4, L) MOE_SLOTS(L)
#else
#define LAYER_ATT(L) RUN(1, L) RUN(2, L) RUN(3, L) RUN(4, L) MOE_SLOTS(L)
#endif
#define LAYER_POOL(L) RUN(5, L) RUN(6, L) MOE_SLOTS(L)
    LAYER_ATT(0) LAYER_POOL(1) LAYER_ATT(2) LAYER_POOL(3)
#undef RUN
#undef MOE_SLOTS
#undef LAYER_ATT
#undef LAYER_POOL
}
#endif

extern "C" void kernel_launch(void* const* d_in, const int* in_sizes, int n_in, void* d_out, int out_size, void* d_ws, size_t ws_size, hipStream_t stream) {
    static int grid = 0;
    if (grid == 0) {
        if (n_in != 13 || in_sizes[0] != T * DM || out_size != T * DM || ws_size < WS_END) {
            fprintf(stderr, "kernel_launch: unexpected shapes (n_in %d, in0 %d, out %d, ws %zu; need ws >= %zu); nothing launched\n", n_in, n_in > 0 ? in_sizes[0] : -1, out_size, ws_size, (size_t)WS_END); grid = -1; return; }
        int dev = 0, cus = 0;
        if (hipGetDevice(&dev) != hipSuccess || hipDeviceGetAttribute(&cus, hipDeviceAttributeMultiprocessorCount, dev) != hipSuccess) { fprintf(stderr, "kernel_launch: device query failed\n"); grid = -1; return; }
#if !MK_MULTI_LAUNCH
        int per_cu = 0;
        if (hipFuncSetAttribute((const void*)fwd, hipFuncAttributeMaxDynamicSharedMemorySize, LDS_BYTES) != hipSuccess) { fprintf(stderr, "kernel_launch: hipFuncSetAttribute failed\n"); grid = -1; return; }
        if (hipOccupancyMaxActiveBlocksPerMultiprocessor(&per_cu, (const void*)fwd, NWAVES * 64, LDS_BYTES) != hipSuccess || per_cu < 1)
            fprintf(stderr, "kernel_launch: note: occupancy query reports %d workgroups per CU\n", per_cu);
        (void)hipGetLastError();
#endif
        grid = cus;
    }
    if (grid < 0) return;
    if (hipMemsetAsync((char*)d_ws + WS_CTL, 0, CTL_ZERO_BYTES, stream) != hipSuccess) { fprintf(stderr, "kernel_launch: memset failed\n"); return; }
    Args a{};
    const float** ip = (const float**)&a.in;
    for (int i = 0; i < 13; ++i) ip[i] = (const float*)d_in[i];
    a.out = (float*)d_out; a.ws = (unsigned char*)d_ws; a.layer = 0; a.pad = 0;
#if MK_MULTI_LAUNCH
    launch_slot<0>(a, grid, stream);
    for (int layer = 0; layer < DEPTH; ++layer) {
        a.layer = layer;
        if ((layer & 1) == 0) { launch_slot<1>(a, grid, stream); launch_slot<2>(a, grid, stream); launch_slot<3>(a, grid, stream); launch_slot<4>(a, grid, stream); }
        else { launch_slot<5>(a, grid, stream); launch_slot<6>(a, grid, stream); }
        launch_slot<7>(a, grid, stream); launch_slot<9>(a, grid, stream); launch_slot<10>(a, grid, stream); launch_slot<11>(a, grid, stream);
    }
#else
    hipLaunchKernelGGL(fwd, dim3(grid), dim3(NWAVES * 64), LDS_BYTES, stream, a);
#endif
    const hipError_t le = hipPeekAtLastError();
    if (le != hipSuccess) fprintf(stderr, "kernel_launch: launch failed: %s\n", hipGetErrorName(le));
}
```
